# Optimizing an MI355X kernel written in HIP

```python
import math
import jax, jax.numpy as jnp
from jax import lax
import numpy as np


D_MODEL = 2048
BATCH = 4
SEQ = 4096
DEPTH = 2

A_HEADS = 8
A_HEAD_DIM = 128
A_KV_RANK = 256
IDX_HEADS = 16
IDX_HEAD_DIM = 64
IDX_ROPE_DIM = 32
ROPE_THETA = 10000.0
DSA_TOPK = 256
Q_BLOCK = 128
B_GROUPS = ((128, 1), (512, 4), (2048, 16))
B_HEADS_PER_GROUP = 4
B_HEAD_DIM = 128
B_HEADS = B_HEADS_PER_GROUP * len(B_GROUPS)
BAND_BLOCK = 128
REL_BUCKETS = 32
REL_MAX_DISTANCE = 2048
N_BIAS_HEADS = A_HEADS + B_HEADS
D_FF = -(-8 * D_MODEL // (3 * 256)) * 256
NORM_EPS = 1e-6
NEG_INF = -1e30

A_Q_COLS = A_HEADS * A_HEAD_DIM
A_KV_COLS = A_KV_RANK
IDX_Q_COLS = IDX_HEADS * IDX_HEAD_DIM
IDX_K_COLS = IDX_HEAD_DIM
IDX_W_COLS = IDX_HEADS
B_QKV_COLS = 3 * B_HEADS * B_HEAD_DIM
GATE_COLS = 2 * D_MODEL
IN_SIZES = (A_Q_COLS, A_KV_COLS, IDX_Q_COLS, IDX_K_COLS, IDX_W_COLS, B_QKV_COLS, GATE_COLS)
N_IN = sum(IN_SIZES)
A_OUT = A_HEADS * A_HEAD_DIM
B_OUT = B_HEADS_PER_GROUP * B_HEAD_DIM

kernel_name = 'hybrid_dsa_dilated_gated_block'


def rms_norm(x, g):
    xf = x.astype(jnp.float32)
    y = xf * lax.rsqrt(jnp.mean(xf * xf, axis=-1, keepdims=True) + NORM_EPS)
    return y.astype(x.dtype) * g


def layer_norm(x, g, b):
    xf = x.astype(jnp.float32)
    mu = jnp.mean(xf, axis=-1, keepdims=True)
    var = jnp.mean(jnp.square(xf - mu), axis=-1, keepdims=True)
    return ((xf - mu) * lax.rsqrt(var + NORM_EPS)).astype(x.dtype) * g + b


def rel_bucket(dist):
    n = jnp.maximum(dist, 0)
    exact = REL_BUCKETS // 2
    nf = jnp.maximum(n, 1).astype(jnp.float32)
    large = exact + (jnp.log(nf / exact) / math.log(REL_MAX_DISTANCE / exact)
                     * (REL_BUCKETS - exact)).astype(jnp.int32)
    return jnp.where(n < exact, n, jnp.minimum(large, REL_BUCKETS - 1))


def rope_partial(x, pos):
    half = IDX_ROPE_DIM // 2
    freqs = ROPE_THETA ** (-jnp.arange(half, dtype=jnp.float32) / half)
    ang = pos.astype(jnp.float32)[:, None] * freqs[None, :]
    cos = jnp.cos(ang)[None, :, None, :]
    sin = jnp.sin(ang)[None, :, None, :]
    xr = x[..., :IDX_ROPE_DIM].astype(jnp.float32)
    x1, x2 = xr[..., :half], xr[..., half:]
    rot = jnp.concatenate([x1 * cos - x2 * sin, x1 * sin + x2 * cos], axis=-1).astype(x.dtype)
    return jnp.concatenate([rot, x[..., IDX_ROPE_DIM:]], axis=-1)


def dsa_attention(q, c_kv, q_idx, k_idx, w_idx, w_uk, w_uv, bias_a):
    B, L = q.shape[0], q.shape[1]
    topk = min(DSA_TOPK, L // 4)
    nq = L // Q_BLOCK
    q_lat = jnp.einsum('blhd,hdc->blhc', q, w_uk) * (A_HEAD_DIM ** -0.5)
    key_pos = jnp.arange(L)

    def to_blocks(a):
        return jnp.swapaxes(a.reshape(B, nq, Q_BLOCK, *a.shape[2:]), 0, 1)

    def block(args):
        ql, qi, wi, t0 = args
        qpos = t0 + jnp.arange(Q_BLOCK)
        logits = jnp.einsum('bphd,bsd->bphs', qi, k_idx)
        score = jnp.einsum('bph,bphs->bps', wi, jax.nn.relu(logits)).astype(jnp.float32)
        causal = key_pos[None, :] <= qpos[:, None]
        score = jnp.where(causal[None], score, -jnp.inf)
        _, idx = lax.top_k(score, topk)
        kv_sel = jax.vmap(lambda c, i: c[i])(c_kv, idx)
        s = jnp.einsum('bphc,bpkc->bphk', ql, kv_sel).astype(jnp.float32)
        dist = qpos[None, :, None] - idx
        s = s + jnp.moveaxis(bias_a[rel_bucket(dist)], -1, 2).astype(jnp.float32)
        s = jnp.where((dist >= 0)[:, :, None, :], s, NEG_INF)
        p = jax.nn.softmax(s, axis=-1).astype(kv_sel.dtype)
        return jnp.einsum('bphk,bpkc->bphc', p, kv_sel)

    t0s = jnp.arange(nq, dtype=jnp.int32) * Q_BLOCK
    o_lat = lax.map(block, (to_blocks(q_lat), to_blocks(q_idx), to_blocks(w_idx), t0s))
    o_lat = jnp.swapaxes(o_lat, 0, 1).reshape(B, L, A_HEADS, A_KV_RANK)
    return jnp.einsum('blhc,hcd->blhd', o_lat, w_uv).reshape(B, L, A_OUT)


def dilated_group(q, k, v, bias_g, dilation, window):
    B, L, H, dh = q.shape
    steps = window // dilation
    P = BAND_BLOCK
    M = L // dilation
    nb = -(-M // P)
    Mp = nb * P

    def strided(a):
        return a.reshape(B, M, dilation, H, dh).transpose(0, 2, 1, 3, 4)

    qs = jnp.pad(strided(q), ((0, 0), (0, 0), (0, Mp - M), (0, 0), (0, 0))).reshape(B, dilation, nb, P, H, dh)

    def key_blocks(a):
        a = jnp.pad(strided(a), ((0, 0), (0, 0), (P, Mp - M), (0, 0), (0, 0))).reshape(B, dilation, nb + 1, P, H, dh)
        return jnp.concatenate([a[:, :, :-1], a[:, :, 1:]], axis=3)

    ks, vs = key_blocks(k), key_blocks(v)
    i = jnp.arange(P)[:, None]
    u = jnp.arange(2 * P)[None, :]
    back = i + P - u
    m_key = (jnp.arange(nb) * P)[:, None, None] - P + u[None]
    valid = (back >= 0)[None] & (back <= steps)[None] & (m_key >= 0)
    bias = jnp.transpose(bias_g[rel_bucket(back * dilation)], (2, 0, 1)).astype(jnp.float32)
    s = jnp.einsum('bdnihe,bdnuhe->bdnhiu', qs, ks).astype(jnp.float32) * (dh ** -0.5) + bias
    s = jnp.where(valid[None, None, :, None], s, NEG_INF)
    mx = jnp.max(s, axis=-1, keepdims=True)
    p = jnp.exp(s - mx)
    den = jnp.sum(p, axis=-1, keepdims=True)
    o = jnp.einsum('bdnhiu,bdnuhe->bdnihe', (p / den).astype(v.dtype), vs)
    lse = (mx + jnp.log(den))[..., 0]
    o = o.reshape(B, dilation, Mp, H, dh)[:, :, :M].transpose(0, 2, 1, 3, 4).reshape(B, L, H, dh)
    lse = lse.transpose(0, 1, 2, 4, 3).reshape(B, dilation, Mp, H)[:, :, :M].transpose(0, 2, 1, 3).reshape(B, L, H)
    return o, lse


def dilated_mixture(qkv_b, bias_b):
    B, L = qkv_b.shape[0], qkv_b.shape[1]
    outs, lses = [], []
    for g, (window, dil) in enumerate(B_GROUPS):
        o, lse = dilated_group(qkv_b[:, :, 0, g], qkv_b[:, :, 1, g], qkv_b[:, :, 2, g],
                               bias_b[:, g * B_HEADS_PER_GROUP:(g + 1) * B_HEADS_PER_GROUP], dil, window)
        outs.append(o)
        lses.append(lse)
    alpha = jax.nn.softmax(jnp.stack(lses), axis=0)
    out = jnp.sum(alpha[..., None] * jnp.stack(outs).astype(jnp.float32), axis=0)
    return out.astype(qkv_b.dtype).reshape(B, L, B_OUT)


def hybrid_layer(x, c, rel_bias, w_ada, b_ada, norm1_g, w_in, kv_norm_g, idx_ln_g, idx_ln_b,
                 w_uk, w_uv, w_a_up, w_b_up, w_out, norm2_g, w_ff_gate, w_ff_up, w_ff_down):
    B, L, _ = x.shape
    mod = jax.nn.silu(c) @ w_ada + b_ada
    shift1, scale1, gate1, shift2, scale2, gate2 = [m[:, None, :] for m in jnp.split(mod, 6, axis=-1)]

    h = rms_norm(x, norm1_g) * (1 + scale1) + shift1
    z = h @ w_in
    split_pts = [int(p) for p in np.cumsum(IN_SIZES)[:-1]]
    q_a, ckv, q_i, k_i, w_i, qkv_b, gates = jnp.split(z, split_pts, axis=-1)
    pos = jnp.arange(L)
    q_a = q_a.reshape(B, L, A_HEADS, A_HEAD_DIM)
    ckv = rms_norm(ckv, kv_norm_g)
    q_i = rope_partial(q_i.reshape(B, L, IDX_HEADS, IDX_HEAD_DIM), pos)
    k_i = rope_partial(layer_norm(k_i, idx_ln_g, idx_ln_b)[:, :, None, :], pos)[:, :, 0, :]
    w_i = w_i * (IDX_HEADS ** -0.5 * IDX_HEAD_DIM ** -0.5)
    y_a = dsa_attention(q_a, ckv, q_i, k_i, w_i, w_uk, w_uv, rel_bias[:, :A_HEADS])
    y_b = dilated_mixture(qkv_b.reshape(B, L, 3, len(B_GROUPS), B_HEADS_PER_GROUP, B_HEAD_DIM),
                          rel_bias[:, A_HEADS:])
    g_a, g_b = jnp.split(jax.nn.sigmoid(gates), 2, axis=-1)
    merged = g_a * (y_a @ w_a_up) + g_b * (y_b @ w_b_up)
    x = x + gate1 * (merged @ w_out)

    h2 = rms_norm(x, norm2_g) * (1 + scale2) + shift2
    ff = (jax.nn.silu(h2 @ w_ff_gate) * (h2 @ w_ff_up)) @ w_ff_down
    return x + gate2 * ff


def setup_inputs(seed: int = 0) -> dict:
    key = jax.random.key(seed)
    ks = jax.random.split(key, 22)

    def nrm(k, shape, scale):
        return jax.random.normal(k, shape, jnp.float32) * scale

    return {
        'x': nrm(ks[0], (BATCH, SEQ, D_MODEL), 1.0),
        'c': nrm(ks[1], (BATCH, D_MODEL), 1.0),
        'rel_bias': nrm(ks[2], (REL_BUCKETS, N_BIAS_HEADS), 0.5),
        'w_ada': nrm(ks[3], (DEPTH, D_MODEL, 6 * D_MODEL), 0.5 * D_MODEL ** -0.5),
        'b_ada': nrm(ks[4], (DEPTH, 6 * D_MODEL), 0.02),
        'norm1_g': 1.0 + nrm(ks[5], (DEPTH, D_MODEL), 0.02),
        'w_in': nrm(ks[6], (DEPTH, D_MODEL, N_IN), D_MODEL ** -0.5),
        'kv_norm_g': 1.0 + nrm(ks[7], (DEPTH, A_KV_RANK), 0.02),
        'idx_ln_g': 1.0 + nrm(ks[8], (DEPTH, IDX_HEAD_DIM), 0.02),
        'idx_ln_b': nrm(ks[9], (DEPTH, IDX_HEAD_DIM), 0.02),
        'w_uk': nrm(ks[10], (DEPTH, A_HEADS, A_HEAD_DIM, A_KV_RANK), A_HEAD_DIM ** -0.5),
        'w_uv': nrm(ks[11], (DEPTH, A_HEADS, A_KV_RANK, A_HEAD_DIM), A_KV_RANK ** -0.5),
        'w_a_up': nrm(ks[12], (DEPTH, A_OUT, D_MODEL), A_OUT ** -0.5),
        'w_b_up': nrm(ks[13], (DEPTH, B_OUT, D_MODEL), B_OUT ** -0.5),
        'w_out': nrm(ks[14], (DEPTH, D_MODEL, D_MODEL), D_MODEL ** -0.5),
        'norm2_g': 1.0 + nrm(ks[15], (DEPTH, D_MODEL), 0.02),
        'w_ff_gate': nrm(ks[16], (DEPTH, D_MODEL, D_FF), D_MODEL ** -0.5),
        'w_ff_up': nrm(ks[17], (DEPTH, D_MODEL, D_FF), D_MODEL ** -0.5),
        'w_ff_down': nrm(ks[18], (DEPTH, D_FF, D_MODEL), D_FF ** -0.5),
        'final_g': 1.0 + nrm(ks[19], (D_MODEL,), 0.02),
    }


def reference(x, c, rel_bias, w_ada, b_ada, norm1_g, w_in, kv_norm_g, idx_ln_g, idx_ln_b,
              w_uk, w_uv, w_a_up, w_b_up, w_out, norm2_g, w_ff_gate, w_ff_up, w_ff_down, final_g):
    for l in range(DEPTH):
        x = hybrid_layer(x, c, rel_bias, w_ada[l], b_ada[l], norm1_g[l], w_in[l], kv_norm_g[l],
                         idx_ln_g[l], idx_ln_b[l], w_uk[l], w_uv[l], w_a_up[l], w_b_up[l], w_out[l],
                         norm2_g[l], w_ff_gate[l], w_ff_up[l], w_ff_down[l])
    return rms_norm(x, final_g)
```

```cpp
#include <hip/hip_runtime.h>
#include <cstdio>
#include <cstdint>

#define LAS __attribute__((address_space(3)))
#define GAS __attribute__((address_space(1)))
typedef _Float16 f16;
typedef _Float16 f16x2 __attribute__((ext_vector_type(2)));
typedef _Float16 f16x4 __attribute__((ext_vector_type(4)));
typedef _Float16 f16x8 __attribute__((ext_vector_type(8)));
typedef float f32x2 __attribute__((ext_vector_type(2)));
typedef float f32x4 __attribute__((ext_vector_type(4)));
typedef float f32x16 __attribute__((ext_vector_type(16)));
typedef unsigned u32x2 __attribute__((ext_vector_type(2)));
typedef unsigned u32x4 __attribute__((ext_vector_type(4)));
typedef short s16x4 __attribute__((ext_vector_type(4)));
typedef unsigned short u16x8 __attribute__((ext_vector_type(8)));
typedef unsigned short u16;

__device__ __forceinline__ unsigned pkh(float a, float b) { f32x2 v = {a, b}; return __builtin_bit_cast(unsigned, __builtin_convertvector(v, f16x2)); }
__device__ __forceinline__ u32x4 pkh8(f32x4 a, f32x4 b) { u32x4 w; w.x = pkh(a[0], a[1]); w.y = pkh(a[2], a[3]); w.z = pkh(b[0], b[1]); w.w = pkh(b[2], b[3]); return w; }
__device__ __forceinline__ f32x2 unpk(unsigned w) { return __builtin_convertvector(__builtin_bit_cast(f16x2, w), f32x2); }
__device__ __forceinline__ float sigm(float x) { return __builtin_amdgcn_rcpf(1.0f + __expf(-x)); }
__device__ __forceinline__ float wave_sum(float v) {
#pragma unroll
    for (int o = 1; o < 64; o <<= 1) v += __shfl_xor(v, o);
    return v;
}
namespace pg8 {
#define PG8_LAS __attribute__((address_space(3)))
typedef _Float16 bf16_t;
typedef _Float16 bf16x8 __attribute__((ext_vector_type(8)));
typedef float f32x4 __attribute__((ext_vector_type(4)));
typedef unsigned u32x4 __attribute__((ext_vector_type(4)));
constexpr int BM = 256, BK = 64, HALF = 128, HTB = HALF * BK * 2  , STAGE_BYTES = 8 * HTB, NXCD = 8, WGM = 8;

__host__ __device__ __forceinline__ int lds_byte(int r, int c) { const int st = (r >> 4) * 2 + (c >> 5), rr = r & 15, cc = c & 31, ob = rr * 64 + cc * 2; return st * 1024 + (ob ^ (((ob >> 9) & 1) << 5)); }
__host__ __device__ __forceinline__ void stage_rc(int b, int& R, int& C) { const int st = b / 1024, sb = b % 1024, swz = sb ^ (((sb >> 9) & 1) << 5); R = (st >> 1) * 16 + swz / 64; C = (st & 1) * 32 + (swz % 64) / 2; }
__host__ __device__ __forceinline__ int perm32(int rho) { const int n = rho >> 4, i = rho & 15; return 8 * (i >> 2) + 4 * n + (i & 3); }

struct Unit { int pm, pn; };
struct Gemm { const bf16_t* A; const bf16_t* Bt; int M, N, K; };

struct StaticOrder {
    int nM, nN, nwg, G, c;
    __host__ __device__ void init(int M, int N, int G_, int c_) { nM = M / BM; nN = N / BM; nwg = nM * nN; G = G_; c = c_; }
    __host__ __device__ bool next(int i, Unit& u) const {
        const long L = (long)i * G + c; if (L >= nwg) return false;
        int wgid = (int)L; { const int q = nwg / NXCD, r = nwg % NXCD, xcd = wgid % NXCD, off = wgid / NXCD; wgid = (xcd < r ? xcd * (q + 1) : r * (q + 1) + (xcd - r) * q) + off; }
        const int nig = WGM * nN, gid = wgid / nig, fm = gid * WGM, gsz = (nM - fm) < WGM ? (nM - fm) : WGM;
        u.pm = fm + ((wgid % nig) % gsz); u.pn = (wgid % nig) / gsz; return true;
    }
    __device__ __forceinline__ void a_ready(const Unit&) const {}
    __device__ __forceinline__ void done(const Unit&) const {}
};

struct EpiIn {
    static constexpr bool PERM = true, AFTER_DRAIN = false;
    bf16_t *zA, *zB, *zG;
    __device__ __forceinline__ void operator()(const f32x4 (&acc)[2][2][4][2], const Unit& u, int wr, int wc, int fr, int fq) const {
        const int row0 = u.pm * BM + wr * 64 + fr; bf16_t* base; int ld, colt; bool sg = false;
        if (u.pn < 14) { base = zA; ld = 3584; colt = u.pn * BM; } else if (u.pn < 32) { base = zB; ld = 4608; colt = (u.pn - 14) * BM; } else { base = zG; ld = 4096; colt = (u.pn - 32) * BM; sg = true; }
        const int col0 = colt + wc * 32 + 8 * fq;
#pragma unroll
        for (int ai = 0; ai < 2; ++ai)
#pragma unroll
            for (int m = 0; m < 4; ++m) { bf16_t* rowp = base + (size_t)(row0 + ai * HALF + m * 16) * ld + col0;
#pragma unroll
                for (int bj = 0; bj < 2; ++bj) { f32x4 v0 = acc[ai][bj][m][0], v1 = acc[ai][bj][m][1];
                    if (sg) {
#pragma unroll
                        for (int j = 0; j < 4; ++j) { v0[j] = sigm(v0[j]); v1[j] = sigm(v1[j]); } }
                    *(u32x4*)(rowp + bj * HALF) = pkh8(v0, v1); } }
    }
};
template <int MODE> struct EpiGate {
    static constexpr bool PERM = true, AFTER_DRAIN = false;
    const bf16_t* zG; bf16_t* out;
    __device__ __forceinline__ void operator()(const f32x4 (&acc)[2][2][4][2], const Unit& u, int wr, int wc, int fr, int fq) const {
        const int row0 = u.pm * BM + wr * 64 + fr, col0 = u.pn * BM + wc * 32 + 8 * fq;
#pragma unroll
        for (int ai = 0; ai < 2; ++ai)
#pragma unroll
            for (int m = 0; m < 4; ++m) { const size_t row = (size_t)(row0 + ai * HALF + m * 16);
#pragma unroll
                for (int bj = 0; bj < 2; ++bj) {
                    const u32x4 gw = *(const u32x4*)(zG + row * 4096 + MODE * 2048 + col0 + bj * HALF);
                    const f32x2 g0 = unpk(gw.x), g1 = unpk(gw.y), g2 = unpk(gw.z), g3 = unpk(gw.w);
                    f32x4 v0 = acc[ai][bj][m][0] * (f32x4){g0.x, g0.y, g1.x, g1.y}, v1 = acc[ai][bj][m][1] * (f32x4){g2.x, g2.y, g3.x, g3.y};
                    bf16_t* op = out + row * 2048 + col0 + bj * HALF;
                    if (MODE == 1) { const u32x4 pw = *(const u32x4*)op; const f32x2 p0 = unpk(pw.x), p1 = unpk(pw.y), p2 = unpk(pw.z), p3 = unpk(pw.w);
                        v0 += (f32x4){p0.x, p0.y, p1.x, p1.y}; v1 += (f32x4){p2.x, p2.y, p3.x, p3.y}; }
                    *(u32x4*)op = pkh8(v0, v1);
                    asm volatile("" ::: "memory"); } }
    }
};
struct EpiResid {
    static constexpr bool PERM = false, AFTER_DRAIN = false;
    const float* xi; float* xo; const float* gate;
    __device__ __forceinline__ void operator()(const f32x4 (&acc)[2][2][4][2], const Unit& u, int wr, int wc, int fr, int fq) const {
        const int row0 = u.pm * BM + wr * 64 + fr, col0 = u.pn * BM + wc * 32 + 4 * fq; const float* gp = gate + (size_t)(u.pm >> 4) * 12288 + col0;
        f32x4 gv[2][2];
#pragma unroll
        for (int bj = 0; bj < 2; ++bj)
#pragma unroll
            for (int n = 0; n < 2; ++n) gv[bj][n] = *(const f32x4*)(gp + bj * HALF + n * 16);
#pragma unroll
        for (int ai = 0; ai < 2; ++ai)
#pragma unroll
            for (int m = 0; m < 4; ++m) { const size_t off = (size_t)(row0 + ai * HALF + m * 16) * 2048 + col0;
#pragma unroll
                for (int bj = 0; bj < 2; ++bj)
#pragma unroll
                    for (int n = 0; n < 2; ++n) *(f32x4*)(xo + off + bj * HALF + n * 16) = *(const f32x4*)(xi + off + bj * HALF + n * 16) + gv[bj][n] * acc[ai][bj][m][n];
                asm volatile("" ::: "memory"); }
    }
};
struct EpiSwiGLU {
    static constexpr bool PERM = true, AFTER_DRAIN = false;
    bf16_t* act;
    __device__ __forceinline__ void operator()(const f32x4 (&acc)[2][2][4][2], const Unit& u, int wr, int wc, int fr, int fq) const {
        const int row0 = u.pm * BM + wr * 64 + fr, col0 = u.pn * HALF + wc * 32 + 8 * fq;
#pragma unroll
        for (int ai = 0; ai < 2; ++ai)
#pragma unroll
            for (int m = 0; m < 4; ++m) { f32x4 o[2];
#pragma unroll
                for (int n = 0; n < 2; ++n) { const f32x4 g = acc[ai][0][m][n], up = acc[ai][1][m][n];
#pragma unroll
                    for (int j = 0; j < 4; ++j) o[n][j] = g[j] * sigm(g[j]) * up[j]; }
                *(u32x4*)(act + (size_t)(row0 + ai * HALF + m * 16) * 5632 + col0) = pkh8(o[0], o[1]); }
    }
};
template <class Epi, class Sched, bool ALIGN_EPI = false, bool SP2 = false>
__device__ __forceinline__ void gemm_phase(PG8_LAS unsigned char* lds, const Gemm g, const Sched& S, const Epi& E) {
    int tid_ = threadIdx.x; asm volatile("" : "+v"(tid_));
    const int tid = tid_, wid = __builtin_amdgcn_readfirstlane(tid >> 6), lane = tid & 63, wr = wid >> 2, wc = wid & 3, fr = lane & 15, fq = lane >> 4;
    const int K = g.K, nt = K / BK;
    unsigned voffA[2], voffB[2];
#pragma unroll
    for (int i = 0; i < 2; ++i) { int R, C; stage_rc(tid * 16 + i * 8192, R, C); const int Rb = Epi::PERM ? ((R & ~31) + perm32(R & 31)) : R;
        voffA[i] = (unsigned)(R * K + C) * 2u; voffB[i] = (unsigned)(Rb * K + C) * 2u; }
    const size_t kstep = (size_t)(BK * 2);
    const size_t hstep = (size_t)HALF * K * 2;
    const size_t tstep = 2 * hstep;
    const unsigned ldsw = (unsigned)wid * 1024u;
    const int aoff = lds_byte(wr * 64 + fr, fq * 8), boff = lds_byte(wc * 32 + fr, fq * 8);
#define PG8_SA(b, h) (((b) * 2 + (h)) * HTB)
#define PG8_SB(b, h) ((4 + (b) * 2 + (h)) * HTB)
#define PG8_STAGE(bufoff, gbase, voff) do { _Pragma("unroll") for (int _i = 0; _i < 2; ++_i) \
        __builtin_amdgcn_global_load_lds((const unsigned*)((const char*)(gbase) + (voff)[_i]), (PG8_LAS unsigned*)(lds + (bufoff) + ldsw + _i * 8192), 16, 0, 0); } while (0)
#define PG8_LDA(dst, b, h) do { _Pragma("unroll") for (int m = 0; m < 4; ++m) _Pragma("unroll") for (int k = 0; k < 2; ++k) dst[m][k] = *(const PG8_LAS bf16x8*)(lds + PG8_SA(b, h) + aoff + m * 2048 + k * 1024); } while (0)
#define PG8_LDB(dst, b, h) do { _Pragma("unroll") for (int n = 0; n < 2; ++n) _Pragma("unroll") for (int k = 0; k < 2; ++k) dst[n][k] = *(const PG8_LAS bf16x8*)(lds + PG8_SB(b, h) + boff + n * 2048 + k * 1024); } while (0)
#define PG8_MMA(ai, bj, At, Bt) do { __builtin_amdgcn_s_setprio(1); _Pragma("unroll") for (int m = 0; m < 4; ++m) _Pragma("unroll") for (int n = 0; n < 2; ++n) _Pragma("unroll") for (int k = 0; k < 2; ++k) \
        acc[ai][bj][m][n] = __builtin_amdgcn_mfma_f32_16x16x32_f16(Bt[n][k], At[m][k], acc[ai][bj][m][n], 0, 0, 0); __builtin_amdgcn_s_setprio(0); } while (0)
#define PG8_WAIT_V(n) asm volatile("s_waitcnt vmcnt(" #n ")" ::: "memory")
#define PG8_WAIT_L(n) asm volatile("s_waitcnt lgkmcnt(" #n ")" ::: "memory")
#define PG8_BAR __builtin_amdgcn_s_barrier()
#define PG8_SCHED __builtin_amdgcn_sched_barrier(0)
    Unit cur, nxt; int ui = 0;
    if (!S.next(0, cur)) return;
    f32x4 acc[2][2][4][2];
#pragma unroll
    for (int a = 0; a < 2; ++a)
#pragma unroll
        for (int b = 0; b < 2; ++b)
#pragma unroll
            for (int m = 0; m < 4; ++m)
#pragma unroll
                for (int n = 0; n < 2; ++n) acc[a][b][m][n] = (f32x4){0.f, 0.f, 0.f, 0.f};
    bf16x8 At[4][2], B0[2][2], B1[2][2];
    const char* cA = (const char*)g.A + (size_t)cur.pm * tstep; const char* cB = (const char*)g.Bt + (size_t)cur.pn * tstep;
    S.a_ready(cur);
    if constexpr (SP2) {
        PG8_STAGE(PG8_SB(0, 0), cB, voffB); PG8_STAGE(PG8_SB(0, 1), cB + hstep, voffB); PG8_STAGE(PG8_SA(0, 0), cA, voffA); PG8_STAGE(PG8_SA(0, 1), cA + hstep, voffA);
        if (wr == 1) PG8_BAR;
        PG8_WAIT_V(2); PG8_BAR;
        PG8_STAGE(PG8_SB(1, 0), cB + kstep, voffB); PG8_STAGE(PG8_SA(1, 0), cA + kstep, voffA); PG8_STAGE(PG8_SB(1, 1), cB + hstep + kstep, voffB);
        PG8_WAIT_V(6); PG8_BAR;
    } else {
        PG8_STAGE(PG8_SB(0, 0), cB, voffB); PG8_STAGE(PG8_SA(0, 0), cA, voffA); PG8_STAGE(PG8_SB(0, 1), cB + hstep, voffB); PG8_STAGE(PG8_SA(0, 1), cA + hstep, voffA);
        if (wr == 1) PG8_BAR;
        PG8_WAIT_V(4); PG8_BAR;
        PG8_STAGE(PG8_SB(1, 0), cB + kstep, voffB); PG8_STAGE(PG8_SA(1, 0), cA + kstep, voffA); PG8_STAGE(PG8_SB(1, 1), cB + hstep + kstep, voffB);
        PG8_WAIT_V(6); PG8_BAR;
    }
    for (;;) {
        const bool has_next = S.next(ui + 1, nxt);
        const char* nA = has_next ? (const char*)g.A + (size_t)nxt.pm * tstep : cA; const char* nB = has_next ? (const char*)g.Bt + (size_t)nxt.pn * tstep : cB;
        for (int t = 0; t < nt; t += 2) {
            const bool last = (t == nt - 2);
            const char* a1 = cA + (size_t)(t + 1) * kstep;
            const char* a2 = last ? nA : cA + (size_t)(t + 2) * kstep; const char* b2 = last ? nB : cB + (size_t)(t + 2) * kstep;
            const char* a3 = a2 + kstep; const char* b3 = b2 + kstep;
            if (last && has_next) S.a_ready(nxt);
            if constexpr (SP2) {
            PG8_LDB(B0, 0, 0); PG8_LDB(B1, 0, 1); PG8_SCHED; PG8_LDA(At, 0, 0); PG8_STAGE(PG8_SA(1, 1), a1 + hstep, voffA);
            PG8_WAIT_V(8); PG8_WAIT_L(0); PG8_BAR; PG8_MMA(0, 0, At, B0); PG8_MMA(0, 1, At, B1); PG8_BAR; PG8_SCHED;
            PG8_LDA(At, 0, 1); PG8_STAGE(PG8_SB(0, 0), b2, voffB); PG8_STAGE(PG8_SB(0, 1), b2 + hstep, voffB); PG8_STAGE(PG8_SA(0, 0), a2, voffA);
            PG8_WAIT_V(8); PG8_WAIT_L(0); PG8_BAR; PG8_MMA(1, 0, At, B0); PG8_MMA(1, 1, At, B1); PG8_BAR; PG8_SCHED;
            PG8_LDB(B0, 1, 0); PG8_LDB(B1, 1, 1); PG8_SCHED; PG8_LDA(At, 1, 0); PG8_STAGE(PG8_SA(0, 1), a2 + hstep, voffA);
            PG8_WAIT_V(8); PG8_WAIT_L(0); PG8_BAR; PG8_MMA(0, 0, At, B0); PG8_MMA(0, 1, At, B1); PG8_BAR; PG8_SCHED;
            PG8_LDA(At, 1, 1); PG8_STAGE(PG8_SB(1, 0), b3, voffB); PG8_STAGE(PG8_SB(1, 1), b3 + hstep, voffB); PG8_STAGE(PG8_SA(1, 0), a3, voffA);
            PG8_WAIT_V(8); PG8_WAIT_L(0); PG8_BAR; PG8_MMA(1, 0, At, B0); PG8_MMA(1, 1, At, B1); PG8_BAR; PG8_SCHED;
            } else {
            PG8_LDB(B0, 0, 0); PG8_SCHED; PG8_LDA(At, 0, 0); PG8_STAGE(PG8_SA(1, 1), a1 + hstep, voffA);
            PG8_WAIT_L(8); PG8_BAR; PG8_WAIT_L(0); PG8_MMA(0, 0, At, B0); PG8_BAR; PG8_SCHED;
            PG8_LDB(B1, 0, 1); PG8_STAGE(PG8_SB(0, 0), b2, voffB);
            PG8_BAR; PG8_WAIT_L(0); PG8_MMA(0, 1, At, B1); PG8_BAR;
            PG8_LDA(At, 0, 1); PG8_STAGE(PG8_SA(0, 0), a2, voffA);
            PG8_BAR; PG8_WAIT_L(0); PG8_MMA(1, 0, At, B0); PG8_BAR; PG8_SCHED;
            PG8_STAGE(PG8_SB(0, 1), b2 + hstep, voffB);
            PG8_WAIT_V(6); PG8_BAR; PG8_MMA(1, 1, At, B1); PG8_BAR;
            PG8_LDB(B0, 1, 0); PG8_SCHED; PG8_LDA(At, 1, 0); PG8_STAGE(PG8_SA(0, 1), a2 + hstep, voffA);
            PG8_WAIT_L(8); PG8_BAR; PG8_WAIT_L(0); PG8_MMA(0, 0, At, B0); PG8_BAR; PG8_SCHED;
            PG8_LDB(B1, 1, 1); PG8_STAGE(PG8_SB(1, 0), b3, voffB);
            PG8_BAR; PG8_WAIT_L(0); PG8_MMA(0, 1, At, B1); PG8_BAR;
            PG8_LDA(At, 1, 1); PG8_STAGE(PG8_SA(1, 0), a3, voffA);
            PG8_BAR; PG8_WAIT_L(0); PG8_MMA(1, 0, At, B0); PG8_BAR; PG8_SCHED;
            PG8_STAGE(PG8_SB(1, 1), b3 + hstep, voffB);
            PG8_WAIT_V(6); PG8_BAR; PG8_MMA(1, 1, At, B1); PG8_BAR;
            }
        }
        if constexpr (ALIGN_EPI) { if (wr == 0) PG8_BAR; }
        if constexpr (!Epi::AFTER_DRAIN) { E(acc, cur, wr, wc, fr, fq); S.done(cur); }
        if (!has_next) break;
#pragma unroll
        for (int a = 0; a < 2; ++a)
#pragma unroll
            for (int b = 0; b < 2; ++b)
#pragma unroll
                for (int m = 0; m < 4; ++m)
#pragma unroll
                    for (int n = 0; n < 2; ++n) acc[a][b][m][n] = (f32x4){0.f, 0.f, 0.f, 0.f};
        cur = nxt; cA = nA; cB = nB; ++ui;
        if constexpr (ALIGN_EPI) { if (wr == 1) PG8_BAR; }
    }
    PG8_WAIT_V(0);
    if constexpr (!ALIGN_EPI) { if (wr == 0) PG8_BAR; }
    PG8_BAR;
    if constexpr (Epi::AFTER_DRAIN) { E.fused(acc, cur, wr, wc, fr, fq, lds, wid, lane); S.done(cur); }
#undef PG8_SA
#undef PG8_SB
#undef PG8_STAGE
#undef PG8_LDA
#undef PG8_LDB
#undef PG8_MMA
#undef PG8_WAIT_V
#undef PG8_WAIT_L
#undef PG8_BAR
#undef PG8_SCHED
}
}

constexpr int NB = 4, SEQ = 4096, M = NB * SEQ, D = 2048, DEPTH = 2;
constexpr int N_IN_SRC = 11088;
constexpr int NZA = 3584, NZB = 4608, NZG = 4096, NIN = 12288;
constexpr int ZA_CKV = 2048, ZA_QI = 2304, ZA_KI = 3328, ZA_WI = 3392;
constexpr int DFF = 5632, NGU = 2 * DFF;
constexpr int NWAVES = 8;
constexpr float NORM_EPS = 1e-6f, NEG_INF = -1e30f;
constexpr int SC_BATCH = 8650752;

constexpr size_t MiB = 1u << 20;
constexpr size_t WS_CTL = 0, CTL_ZERO_BYTES = 1 * MiB;
constexpr size_t WS_MOD = 1 * MiB;
constexpr size_t WS_ROPE = 2 * MiB;
constexpr size_t WS_LUT = 2 * MiB + 768 * 1024;
constexpr size_t WS_LSE = 3 * MiB;
constexpr size_t WS_IDX = 4 * MiB;
constexpr size_t WS_W = 12 * MiB;
constexpr size_t WO_IN = 0, WO_GU = 48 * MiB, WO_DOWN = 92 * MiB, WO_OUT = 114 * MiB, WO_AUP = 122 * MiB, WO_BUP = 130 * MiB;
constexpr size_t WS_X = 144 * MiB;
constexpr size_t WS_H = 272 * MiB;
constexpr size_t WS_ZA = 336 * MiB;
constexpr size_t WS_ZB = 448 * MiB;
constexpr size_t WS_ZG = 592 * MiB;
constexpr size_t WS_END = 720 * MiB;
constexpr int CW_BAR = 4096;

constexpr int RING_BYTES = 131072;
constexpr int LDSCTL_OFF = RING_BYTES, MISC_OFF = LDSCTL_OFF + 320;
constexpr int SMALL_OFF = RING_BYTES + 1024;
constexpr int LDS_BYTES = 147456;

__device__ __forceinline__ unsigned off_b(unsigned row, unsigned ch) { return 256u * row + 16u * (ch ^ (((row & 3) << 2) | ((row >> 2) & 3))); }
__device__ __forceinline__ int rel_bucket_of(int n) {
    if (n < 16) return n;
    int b = 16;
    b += (n >= 22) + (n >= 30) + (n >= 40) + (n >= 54) + (n >= 73) + (n >= 99) + (n >= 134) + (n >= 182) + (n >= 246) + (n >= 332) + (n >= 450) + (n >= 609) + (n >= 825) + (n >= 1117) + (n >= 1513);
    return b;
}

struct Ptrs {
    const float *x, *c, *rel_bias, *w_ada, *b_ada, *norm1_g, *w_in, *kv_norm_g, *idx_ln_g, *idx_ln_b, *w_uk, *w_uv, *w_a_up, *w_b_up, *w_out, *norm2_g, *w_ff_gate, *w_ff_up, *w_ff_down, *final_g;
    float* out; unsigned char* ws;
};

template <int MAP> __device__ __forceinline__ int map_row(int n, float& sc) {
    sc = 1.0f;
    if (MAP == 0) {
        if (n < 1280) return 2048 + (n - 1024);
        if (n < 2304) return 2304 + (n - 1280);
        if (n < 2368) return 3328 + (n - 2304);
        if (n < 2384) { sc = 0.03125f; return 3392 + (n - 2368); }
        if (n < 6992) return 3584 + (n - 2384);
        return 8192 + (n - 6992);
    }
    if (MAP == 1) return n;
    if (MAP == 2) return 256 * (n >> 7) + (n & 127);
    return 256 * (n >> 7) + 128 + (n & 127);
}
template <int MAP> __device__ __forceinline__ void transpose_item(const float* W, int ldw, int k0, int n0, int nvalid, f16* WT, int K, LAS float* scr, int lane) {
#pragma unroll 8
    for (int i = 0; i < 32; ++i) { const int kk = 2 * i + (lane >> 5), n = lane & 31; scr[kk * 33 + n] = (n < nvalid) ? W[(size_t)(k0 + kk) * ldw + n0 + n] : 0.0f; }
    asm volatile("s_waitcnt lgkmcnt(0)" ::: "memory");
    const int c = lane & 7;
#pragma unroll
    for (int j = 0; j < 4; ++j) { const int n = (lane >> 3) + 8 * j; const LAS float* s = scr + (8 * c) * 33 + n;
        if (n < nvalid) { float sc; const int row = map_row<MAP>(n0 + n, sc);
            u32x4 o; o.x = pkh(s[0 * 33] * sc, s[1 * 33] * sc); o.y = pkh(s[2 * 33] * sc, s[3 * 33] * sc); o.z = pkh(s[4 * 33] * sc, s[5 * 33] * sc); o.w = pkh(s[6 * 33] * sc, s[7 * 33] * sc);
            *(u32x4*)(WT + (size_t)row * K + k0 + 8 * c) = o; } }
    asm volatile("s_waitcnt lgkmcnt(0)" ::: "memory");
}
__device__ __forceinline__ void minigemm_tile(const float* Asrc, int lda, const float* Bsrc, int ldb, f16* out, int ldo, float scale, LAS unsigned char* lds, int tid) {
    LAS float* As = (LAS float*)lds; LAS float* Bs = (LAS float*)(lds + 32768);
#pragma unroll
    for (int i = 0; i < 4; ++i) { const int q = tid + 512 * i, d = q >> 4, r4 = q & 15; *(LAS f32x4*)(As + d * 64 + 4 * r4) = *(const f32x4*)(Asrc + (size_t)d * lda + 4 * r4); }
#pragma unroll
    for (int i = 0; i < 4; ++i) { const int q = tid + 512 * i, col = q >> 5, d4 = q & 31; const f32x4 v = *(const f32x4*)(Bsrc + (size_t)col * ldb + 4 * d4);
        LAS float* bp = Bs + col * 129 + 4 * d4; bp[0] = v[0]; bp[1] = v[1]; bp[2] = v[2]; bp[3] = v[3]; }
    __syncthreads();
    const int tk = tid & 31, tc = tid >> 5;
    float a0[4] = {0.f, 0.f, 0.f, 0.f}, a1[4] = {0.f, 0.f, 0.f, 0.f};
#pragma unroll 8
    for (int d = 0; d < 128; ++d) { const f32x4 a = *(const LAS f32x4*)(As + d * 64 + 4 * tc); const float b0 = Bs[tk * 129 + d], b1 = Bs[(tk + 32) * 129 + d];
#pragma unroll
        for (int i = 0; i < 4; ++i) { a0[i] += a[i] * b0; a1[i] += a[i] * b1; } }
#pragma unroll
    for (int i = 0; i < 4; ++i) { f16* op = out + (size_t)(4 * tc + i) * ldo + tk; op[0] = (f16)(a0[i] * scale); op[32] = (f16)(a1[i] * scale); }
    __syncthreads();
}
__device__ __forceinline__ void p0_phase(const Ptrs& P, int l, LAS unsigned char* lds, int tid, int lane, int wave, int G, int bx) {
    unsigned char* wsw = P.ws + WS_W;
    f16* Win_t = (f16*)(wsw + WO_IN); f16* Wgu_t = (f16*)(wsw + WO_GU); f16* Wdown_t = (f16*)(wsw + WO_DOWN); f16* Wout_t = (f16*)(wsw + WO_OUT); f16* Waup_t = (f16*)(wsw + WO_AUP); f16* Wbup_t = (f16*)(wsw + WO_BUP);
    const float* w_in = P.w_in + (size_t)l * D * N_IN_SRC; const float* w_uk = P.w_uk + (size_t)l * 8 * 128 * 256; const float* w_uv = P.w_uv + (size_t)l * 8 * 256 * 128;
    const float* w_a_up = P.w_a_up + (size_t)l * 1024 * D; const float* w_b_up = P.w_b_up + (size_t)l * 512 * D; const float* w_out = P.w_out + (size_t)l * D * D;
    const float* w_g = P.w_ff_gate + (size_t)l * D * DFF; const float* w_u = P.w_ff_up + (size_t)l * D * DFF; const float* w_d = P.w_ff_down + (size_t)l * DFF * D;
    if (l == 0 && bx < 192) {
        LAS float* sc = (LAS float*)lds; LAS float* red = (LAS float*)(lds + 32768);
        for (int i = tid; i < NB * D; i += 512) { const float v = P.c[i]; sc[i] = v / (1.0f + __expf(-v)); }
        __syncthreads();
        float* mod = (float*)(P.ws + WS_MOD);
        for (int it = bx; it < 192; it += G) {
            const int ll = it / 96, col0 = (it % 96) * 128;
            const float* wsrc = P.w_ada + (size_t)ll * D * 12288 + col0 + 2 * lane;
            float a[4][2] = {{0.f, 0.f}, {0.f, 0.f}, {0.f, 0.f}, {0.f, 0.f}};
#pragma unroll 8
            for (int kk = 0; kk < 256; ++kk) { const int k = wave * 256 + kk; const f32x2 wv = *(const f32x2*)(wsrc + (size_t)k * 12288);
#pragma unroll
                for (int b = 0; b < 4; ++b) { const float s = sc[b * D + k]; a[b][0] += s * wv.x; a[b][1] += s * wv.y; } }
#pragma unroll
            for (int b = 0; b < 4; ++b) { red[(wave * 4 + b) * 128 + 2 * lane] = a[b][0]; red[(wave * 4 + b) * 128 + 2 * lane + 1] = a[b][1]; }
            __syncthreads();
            { const int b = tid >> 7, col = tid & 127; float s = 0.f;
#pragma unroll
              for (int w = 0; w < 8; ++w) s += red[(w * 4 + b) * 128 + col];
              mod[(size_t)(ll * 4 + b) * 12288 + col0 + col] = s + P.b_ada[(size_t)ll * 12288 + col0 + col]; }
            __syncthreads();
        }
    }
    for (int it = bx; it < 2048; it += G) {
        const int idx = it & 1023, h = idx >> 7, rem = idx & 127;
        if (it < 1024) { const int c0 = (rem >> 5) * 64, k0 = (rem & 31) * 64;
            minigemm_tile(w_uk + (size_t)(h * 128) * 256 + c0, 256, w_in + (size_t)k0 * N_IN_SRC + h * 128, N_IN_SRC, Win_t + (size_t)(h * 256 + c0) * D + k0, D, 0.08838834764831845f, lds, tid); }
        else { const int n0 = (rem >> 2) * 64, c0 = (rem & 3) * 64;
            minigemm_tile(w_a_up + (size_t)(h * 128) * D + n0, D, w_uv + (size_t)(h * 256 + c0) * 128, 128, Waup_t + (size_t)n0 * D + h * 256 + c0, D, 1.0f, lds, tid); }
    }
    LAS float* scr = (LAS float*)(lds + wave * 16384);
    const int gw = bx * NWAVES + wave, NGW = G * NWAVES;
    constexpr int I_IN = 32 * 315, I_B = 8 * 64, I_O = 32 * 64, I_G = 32 * 176, I_D = 88 * 64;
    constexpr int NITEMS = I_IN + I_B + I_O + 2 * I_G + I_D;
    for (int it = gw; it < NITEMS; it += NGW) {
        int r = it;
        if (r < I_IN) { const int kb = r / 315, nb = r % 315, n0 = 1024 + 32 * nb; const int nv = (N_IN_SRC - n0) < 32 ? (N_IN_SRC - n0) : 32; transpose_item<0>(w_in, N_IN_SRC, 64 * kb, n0, nv, Win_t, D, scr, lane); continue; } r -= I_IN;
        if (r < I_B) { transpose_item<1>(w_b_up, D, 64 * (r / 64), 32 * (r % 64), 32, Wbup_t, 512, scr, lane); continue; } r -= I_B;
        if (r < I_O) { transpose_item<1>(w_out, D, 64 * (r / 64), 32 * (r % 64), 32, Wout_t, D, scr, lane); continue; } r -= I_O;
        if (r < I_G) { transpose_item<2>(w_g, DFF, 64 * (r / 176), 32 * (r % 176), 32, Wgu_t, D, scr, lane); continue; } r -= I_G;
        if (r < I_G) { transpose_item<3>(w_u, DFF, 64 * (r / 176), 32 * (r % 176), 32, Wgu_t, D, scr, lane); continue; } r -= I_G;
        transpose_item<1>(w_d, D, 64 * (r / 64), 32 * (r % 64), 32, Wdown_t, DFF, scr, lane);
    }
    const int gt = bx * 512 + tid, NGT = G * 512;
    { u32x4* pz = (u32x4*)(Win_t + (size_t)3408 * D); for (int i = gt; i < 176 * D / 8; i += NGT) pz[i] = (u32x4){0u, 0u, 0u, 0u}; }
    if (l == 0) {
        f32x2* rope = (f32x2*)(P.ws + WS_ROPE);
        for (int e = gt; e < SEQ * 16; e += NGT) {
            const int pos = e >> 4, j = e & 15, a = j >> 2, b = j & 3;
            const double fa = a == 0 ? 1.0 : a == 1 ? 0.1 : a == 2 ? 0.01 : 0.001;
            const double fb = b == 0 ? 1.0 : b == 1 ? 0.5623413251903491 : b == 2 ? 0.31622776601683794 : 0.1778279410038923;
            const double ang = (double)pos * (fa * fb);
            const double q = __builtin_rint(ang * 0.15915494309189535);
            const double rr = __builtin_fma(-q, 2.4492935982947064e-16, __builtin_fma(-q, 6.283185307179586, ang));
            const float rf = (float)rr;
            rope[e] = (f32x2){cosf(rf), sinf(rf)};
        }
        unsigned char* lut = P.ws + WS_LUT;
        for (int n = gt; n < SEQ; n += NGT) lut[n] = (unsigned char)rel_bucket_of(n);
    }
}

__device__ __forceinline__ void norm_mod_phase(const float* x, const float* g, const float* shift, const float* scale, f16* out, int lane, int wave, int G, int bx) {
    const int gw = bx * NWAVES + wave, NGW = G * NWAVES;
    for (int blk = gw; blk < M / 8; blk += NGW) {
        const int row0 = blk * 8, b = row0 >> 12;
        f32x4 ca[8], cs[8];
#pragma unroll
        for (int j = 0; j < 8; ++j) { const int col = 4 * lane + 256 * j; const f32x4 gg = *(const f32x4*)(g + col), sc = *(const f32x4*)(scale + (size_t)b * 12288 + col); ca[j] = gg * (sc + 1.0f); cs[j] = *(const f32x4*)(shift + (size_t)b * 12288 + col); }
        for (int r = 0; r < 8; ++r) {
            const float* xr = x + (size_t)(row0 + r) * D + 4 * lane; f32x4 v[8]; float ss = 0.f;
#pragma unroll
            for (int j = 0; j < 8; ++j) { v[j] = *(const f32x4*)(xr + 256 * j); ss += (v[j].x * v[j].x + v[j].y * v[j].y) + (v[j].z * v[j].z + v[j].w * v[j].w); }
            const float rstd = 1.0f / sqrtf(wave_sum(ss) * (1.0f / D) + NORM_EPS);
            f16* orow = out + (size_t)(row0 + r) * D + 4 * lane;
#pragma unroll
            for (int j = 0; j < 8; ++j) { const f32x4 o = v[j] * rstd * ca[j] + cs[j]; u32x2 w; w.x = pkh(o.x, o.y); w.y = pkh(o.z, o.w); *(u32x2*)(orow + 256 * j) = w; }
        }
    }
}
__device__ __forceinline__ void final_norm_phase(float* xo, const float* g, int lane, int wave, int G, int bx) {
    const int gw = bx * NWAVES + wave, NGW = G * NWAVES;
    f32x4 cg[8];
#pragma unroll
    for (int j = 0; j < 8; ++j) cg[j] = *(const f32x4*)(g + 4 * lane + 256 * j);
    for (int row = gw; row < M; row += NGW) {
        float* xr = xo + (size_t)row * D + 4 * lane; f32x4 v[8]; float ss = 0.f;
#pragma unroll
        for (int j = 0; j < 8; ++j) { v[j] = *(const f32x4*)(xr + 256 * j); ss += (v[j].x * v[j].x + v[j].y * v[j].y) + (v[j].z * v[j].z + v[j].w * v[j].w); }
        const float rstd = 1.0f / sqrtf(wave_sum(ss) * (1.0f / D) + NORM_EPS);
#pragma unroll
        for (int j = 0; j < 8; ++j) *(f32x4*)(xr + 256 * j) = v[j] * rstd * cg[j];
    }
}

__device__ __forceinline__ void zfix_phase(f16* zA, const float* kvg, const float* lng, const float* lnb, const f32x2* rope, int lane, int wave, int G, int bx) {
    const int gw = bx * NWAVES + wave, NGW = G * NWAVES;
    const f32x4 g4 = *(const f32x4*)(kvg + 4 * lane); const float lg = lng[lane], lb = lnb[lane];
    for (int blk = gw; blk < M / 8; blk += NGW)
        for (int r = 0; r < 8; ++r) {
            const int row = blk * 8 + r, pos = row & (SEQ - 1); f16* z = zA + (size_t)row * NZA;
            { const u32x2 w = *(const u32x2*)(z + ZA_CKV + 4 * lane); const f32x2 a = unpk(w.x), b = unpk(w.y);
              const float ss = wave_sum((a.x * a.x + a.y * a.y) + (b.x * b.x + b.y * b.y)); const float rstd = 1.0f / sqrtf(ss * (1.0f / 256.0f) + NORM_EPS);
              u32x2 o; o.x = pkh(a.x * rstd * g4.x, a.y * rstd * g4.y); o.y = pkh(b.x * rstd * g4.z, b.y * rstd * g4.w); *(u32x2*)(z + ZA_CKV + 4 * lane) = o; }
            { const u32x4 w0 = *(const u32x4*)(z + ZA_QI + 16 * lane), w1 = *(const u32x4*)(z + ZA_QI + 16 * lane + 8);
              const unsigned mine[8] = {w0.x, w0.y, w0.z, w0.w, w1.x, w1.y, w1.z, w1.w}; unsigned res[8]; const int seg = lane & 3;
#pragma unroll
              for (int i = 0; i < 8; ++i) { const unsigned oth = (unsigned)__shfl_xor((int)mine[i], 1); const f32x2 me = unpk(mine[i]), ot = unpk(oth);
                  const f32x2 cs0 = rope[pos * 16 + 2 * i], cs1 = rope[pos * 16 + 2 * i + 1];
                  float r0, r1;
                  if (seg == 0) { r0 = me.x * cs0.x - ot.x * cs0.y; r1 = me.y * cs1.x - ot.y * cs1.y; }
                  else          { r0 = ot.x * cs0.y + me.x * cs0.x; r1 = ot.y * cs1.y + me.y * cs1.x; }
                  res[i] = seg < 2 ? pkh(r0, r1) : mine[i]; }
              *(u32x4*)(z + ZA_QI + 16 * lane) = (u32x4){res[0], res[1], res[2], res[3]}; *(u32x4*)(z + ZA_QI + 16 * lane + 8) = (u32x4){res[4], res[5], res[6], res[7]}; }
            { const float xv = (float)z[ZA_KI + lane]; const float mu = wave_sum(xv) * (1.0f / 64.0f); const float dv = xv - mu; const float var = wave_sum(dv * dv) * (1.0f / 64.0f);
              const float y = dv * (1.0f / sqrtf(var + NORM_EPS)) * lg + lb; const float oth = __shfl_xor(y, 16); const f32x2 cs = rope[pos * 16 + (lane & 15)];
              float o = y; if (lane < 16) o = y * cs.x - oth * cs.y; else if (lane < 32) o = oth * cs.y + y * cs.x;
              z[ZA_KI + lane] = (f16)o; }
        }
}

__device__ __forceinline__ void battn_phase(const f16* zB, const float* rel_bias, const unsigned char* lut, f16* ob, float* lse, LAS unsigned char* lds, int tid, int lane, int wave, int G, int bx) {
    LAS unsigned char* Kimg = lds; LAS unsigned char* Vimg = lds + 65536; LAS float* tb = (LAS float*)(lds + SMALL_OFF);
    const int g4 = lane >> 4, q15 = lane & 15;
    for (int uid = bx; uid < NB * 3 * 4 * 32; uid += G) {
        const int s = uid & 31, j = (uid >> 5) & 3, grp = (uid >> 7) % 3, b = uid / 384;
        const int dsh = 2 * grp, r = s & ((1 << dsh) - 1), n = s >> dsh;
        const f16* zb = zB + (size_t)b * SEQ * NZB; const int colQ = (grp * 4 + j) * 128, colK = ((3 + grp) * 4 + j) * 128, colV = ((6 + grp) * 4 + j) * 128;
#pragma unroll
        for (int i = 0; i < 8; ++i) { const int cidx = tid + 512 * i, u = cidx >> 4, ch = cidx & 15, mk = (n - 1) * 128 + u;
            u32x4 kv = {0u, 0u, 0u, 0u}, vv = {0u, 0u, 0u, 0u};
            if (mk >= 0) { const f16* rp = zb + (size_t)((mk << dsh) + r) * NZB + ch * 8; kv = *(const u32x4*)(rp + colK); vv = *(const u32x4*)(rp + colV); }
            *(LAS u32x4*)(Kimg + off_b(u, ch)) = kv; *(LAS u32x4*)(Vimg + off_b(u, ch)) = vv; }
        if (tid <= 128) tb[tid] = rel_bias[(int)lut[tid << dsh] * 20 + 8 + grp * 4 + j];
        __syncthreads();
        const int iq = 16 * wave + q15, tq = ((n * 128 + iq) << dsh) + r;
        const f16* qp = zb + (size_t)tq * NZB + colQ + 8 * g4;
        f16x8 qf[4];
#pragma unroll
        for (int k = 0; k < 4; ++k) qf[k] = *(const f16x8*)(qp + 32 * k);
        const int kstart = 32 * (wave >> 1);
        const int back0 = iq + 128 - (kstart + 8 * g4); const unsigned bmax = n > 0 ? 128u : (unsigned)iq;
        f32x4 sreg[5][2]; float mx = NEG_INF;
#pragma unroll
        for (int T = 0; T < 5; ++T)
#pragma unroll
            for (int hf = 0; hf < 2; ++hf) {
                const int krow = kstart + 32 * T + 8 * (q15 >> 2) + 4 * hf + (q15 & 3);
                f32x4 acc = {0.f, 0.f, 0.f, 0.f};
#pragma unroll
                for (int k = 0; k < 4; ++k) { const f16x8 kf = *(const LAS f16x8*)(Kimg + off_b(krow, 4 * k + g4)); acc = __builtin_amdgcn_mfma_f32_16x16x32_f16(kf, qf[k], acc, 0, 0, 0); }
#pragma unroll
                for (int e = 0; e < 4; ++e) { const unsigned back = (unsigned)(back0 - (32 * T + 4 * hf + e));
                    const bool valid = back <= bmax; const unsigned bi = back < 128u ? back : 128u;
                    const float sv = valid ? acc[e] * 0.08838834764831845f + tb[bi] : NEG_INF; acc[e] = sv; mx = fmaxf(mx, sv); }
                sreg[T][hf] = acc; }
        mx = fmaxf(mx, __shfl_xor(mx, 16)); mx = fmaxf(mx, __shfl_xor(mx, 32));
        float den = 0.f; f16x8 pf[5];
#pragma unroll
        for (int T = 0; T < 5; ++T) { float p[8];
#pragma unroll
            for (int e = 0; e < 8; ++e) { p[e] = __expf(sreg[T][e >> 2][e & 3] - mx); den += p[e]; }
            const u32x4 w = pkh8((f32x4){p[0], p[1], p[2], p[3]}, (f32x4){p[4], p[5], p[6], p[7]}); pf[T] = __builtin_bit_cast(f16x8, w); }
        den += __shfl_xor(den, 16); den += __shfl_xor(den, 32);
        const float rden = 1.0f / den;
        f16* op = ob + ((size_t)grp * M + (size_t)b * SEQ + tq) * 512 + j * 128 + 4 * g4;
        const unsigned trq = (unsigned)(q15 >> 2), trp = (unsigned)(lane & 3);
#pragma unroll
        for (int c = 0; c < 8; ++c) { f32x4 acc = {0.f, 0.f, 0.f, 0.f};
#pragma unroll
            for (int T = 0; T < 5; ++T) {
                const unsigned r0 = (unsigned)(kstart + 32 * T + 8 * g4) + trq;
                const s16x4 t0 = __builtin_amdgcn_ds_read_tr16_b64_v4i16((LAS s16x4*)(Vimg + off_b(r0, 2 * c + (trp >> 1)) + 8 * (trp & 1)));
                const s16x4 t1 = __builtin_amdgcn_ds_read_tr16_b64_v4i16((LAS s16x4*)(Vimg + off_b(r0 + 4, 2 * c + (trp >> 1)) + 8 * (trp & 1)));
                const f16x8 vf = __builtin_bit_cast(f16x8, __builtin_shufflevector(t0, t1, 0, 1, 2, 3, 4, 5, 6, 7));
                acc = __builtin_amdgcn_mfma_f32_16x16x32_f16(vf, pf[T], acc, 0, 0, 0); }
            u32x2 w; w.x = pkh(acc[0] * rden, acc[1] * rden); w.y = pkh(acc[2] * rden, acc[3] * rden); *(u32x2*)(op + 16 * c) = w; }
        if (lane < 16) lse[((size_t)grp * M + (size_t)b * SEQ + tq) * 4 + j] = mx + __logf(den);
        __syncthreads();
    }
}

__device__ __forceinline__ void score_phase(const f16* zA, float* S, int lane, int wave, int G, int bx) {
    const int wq = wave & 3, wk = wave >> 2, l31 = lane & 31, lh = lane >> 5;
    for (int uid = bx; uid < NB * 272; uid += G) {
        const int b = uid / 272; int rem = uid % 272, qb = 0;
        for (;;) { const int cnt = (qb + 2) >> 1; if (rem < cnt) break; rem -= cnt; ++qb; }
        const int kb = 2 * rem + wk;
        if (kb > qb) continue;
        const f16* zb = zA + (size_t)b * SEQ * NZA;
        const int t = qb * 128 + 32 * wq + l31; const f16* zq = zb + (size_t)t * NZA;
        f16x8 kf[4][4];
#pragma unroll
        for (int tl = 0; tl < 4; ++tl) { const f16* kp = zb + (size_t)(kb * 128 + 32 * tl + l31) * NZA + ZA_KI + 8 * lh;
#pragma unroll
            for (int k = 0; k < 4; ++k) kf[tl][k] = *(const f16x8*)(kp + 16 * k); }
        f32x16 sc[4];
#pragma unroll
        for (int tl = 0; tl < 4; ++tl)
#pragma unroll
            for (int e = 0; e < 16; ++e) sc[tl][e] = 0.f;
#pragma nounroll
        for (int hd = 0; hd < 16; ++hd) {
            f16x8 qf[4];
#pragma unroll
            for (int k = 0; k < 4; ++k) qf[k] = *(const f16x8*)(zq + ZA_QI + hd * 64 + 16 * k + 8 * lh);
            const float wh = (float)zq[ZA_WI + hd];
#pragma unroll
            for (int pr = 0; pr < 2; ++pr) {
                f32x16 a0, a1;
#pragma unroll
                for (int e = 0; e < 16; ++e) { a0[e] = 0.f; a1[e] = 0.f; }
#pragma unroll
                for (int k = 0; k < 4; ++k) { a0 = __builtin_amdgcn_mfma_f32_32x32x16_f16(kf[2 * pr][k], qf[k], a0, 0, 0, 0); a1 = __builtin_amdgcn_mfma_f32_32x32x16_f16(kf[2 * pr + 1][k], qf[k], a1, 0, 0, 0); }
#pragma unroll
                for (int e = 0; e < 16; ++e) { sc[2 * pr][e] += wh * fmaxf(a0[e], 0.f); sc[2 * pr + 1][e] += wh * fmaxf(a1[e], 0.f); }
            }
        }
        float* sp = S + (size_t)b * SC_BATCH + (size_t)16384 * (qb * (qb + 1) / 2) + (size_t)(32 * wq + l31) * ((qb + 1) * 128) + kb * 128 + 4 * lh;
#pragma unroll
        for (int tl = 0; tl < 4; ++tl)
#pragma unroll
            for (int a = 0; a < 4; ++a) *(f32x4*)(sp + 32 * tl + 8 * a) = (f32x4){sc[tl][4 * a], sc[tl][4 * a + 1], sc[tl][4 * a + 2], sc[tl][4 * a + 3]};
    }
}

__device__ __forceinline__ unsigned ord_key(float x) { const unsigned u = __builtin_bit_cast(unsigned, x); return u ^ ((unsigned)((int)u >> 31) | 0x80000000u); }
__device__ __forceinline__ void select_phase(const float* S, u16* idx, int lane, int wave, int G, int bx) {
    const int gw = bx * NWAVES + wave, NGW = G * NWAVES;
    for (int row = gw; row < M; row += NGW) {
        const int b = row >> 12, t = row & (SEQ - 1), qb = t >> 7, n = t + 1;
        u16* orow = idx + (size_t)row * 256;
        if (n <= 256) { u32x2 w; const int k = 4 * lane;
            w.x = (unsigned)(k < n ? k : 0xFFFF) | ((unsigned)(k + 1 < n ? k + 1 : 0xFFFF) << 16); w.y = (unsigned)(k + 2 < n ? k + 2 : 0xFFFF) | ((unsigned)(k + 3 < n ? k + 3 : 0xFFFF) << 16);
            *(u32x2*)(orow + k) = w; continue; }
        const float* src = S + (size_t)b * SC_BATCH + (size_t)16384 * (qb * (qb + 1) / 2) + (size_t)(t & 127) * ((qb + 1) * 128);
        unsigned key[64];
#pragma unroll
        for (int j = 0; j < 16; ++j) {
            if (256 * j < n) { const int base = 256 * j + 4 * lane; const f32x4 v = *(const f32x4*)(src + base);
#pragma unroll
                for (int e = 0; e < 4; ++e) key[4 * j + e] = ord_key(v[e]) & (unsigned)((base + e - n) >> 31); }
            else {
#pragma unroll
                for (int e = 0; e < 4; ++e) key[4 * j + e] = 0u; } }
        unsigned tau = 0u;
        for (int bit = 31; bit >= 0; --bit) { const unsigned cand = tau | (1u << bit); int cnt = 0;
#pragma unroll
            for (int m = 0; m < 64; ++m) cnt += (key[m] >= cand) ? 1 : 0;
#pragma unroll
            for (int o = 1; o < 64; o <<= 1) cnt += __shfl_xor(cnt, o);
            if (cnt >= 256) tau = cand; }
        int cgt = 0;
#pragma unroll
        for (int m = 0; m < 64; ++m) cgt += (key[m] > tau) ? 1 : 0;
#pragma unroll
        for (int o = 1; o < 64; o <<= 1) cgt += __shfl_xor(cgt, o);
        const int need = 256 - cgt; int og = 0, oe = 0;
        asm volatile("" : "+v"(tau));
#pragma unroll
        for (int m = 0; m < 64; ++m) {
            const unsigned kidx = (unsigned)(256 * (m >> 2) + 4 * lane + (m & 3));
            const bool isg = key[m] > tau, ise = key[m] == tau;
            const unsigned long long bg = __ballot(isg), be = __ballot(ise);
            const unsigned lo_g = __builtin_amdgcn_mbcnt_hi((unsigned)(bg >> 32), __builtin_amdgcn_mbcnt_lo((unsigned)bg, 0u));
            const unsigned lo_e = __builtin_amdgcn_mbcnt_hi((unsigned)(be >> 32), __builtin_amdgcn_mbcnt_lo((unsigned)be, 0u));
            if (isg) orow[og + (int)lo_g] = (u16)kidx;
            else if (ise && (oe + (int)lo_e) < need) orow[cgt + oe + (int)lo_e] = (u16)kidx;
            og += __popcll(bg); oe += __popcll(be);
            __builtin_amdgcn_sched_barrier(0);
        }
    }
}
__device__ __forceinline__ void bmerge_phase(const f16* ob, const float* lse, f16* yb, int lane, int wave, int G, int bx) {
    const int gw = bx * NWAVES + wave, NGW = G * NWAVES; const int js = lane >> 4, e0 = (lane & 15) * 8;
    for (int row = gw; row < M; row += NGW) {
        const float l0 = lse[((size_t)0 * M + row) * 4 + js], l1 = lse[((size_t)1 * M + row) * 4 + js], l2 = lse[((size_t)2 * M + row) * 4 + js];
        const float mx = fmaxf(l0, fmaxf(l1, l2)); float w0 = __expf(l0 - mx), w1 = __expf(l1 - mx), w2 = __expf(l2 - mx); const float inv = 1.0f / (w0 + w1 + w2); w0 *= inv; w1 *= inv; w2 *= inv;
        const size_t o = (size_t)row * 512 + js * 128 + e0;
        const u32x4 a = *(const u32x4*)(ob + o), bq = *(const u32x4*)(ob + (size_t)M * 512 + o), cq = *(const u32x4*)(ob + (size_t)2 * M * 512 + o);
        const unsigned aw[4] = {a.x, a.y, a.z, a.w}, bw[4] = {bq.x, bq.y, bq.z, bq.w}, cw[4] = {cq.x, cq.y, cq.z, cq.w}; unsigned rw[4];
#pragma unroll
        for (int i = 0; i < 4; ++i) { const f32x2 x0 = unpk(aw[i]), x1 = unpk(bw[i]), x2 = unpk(cw[i]); rw[i] = pkh(w0 * x0.x + w1 * x1.x + w2 * x2.x, w0 * x0.y + w1 * x1.y + w2 * x2.y); }
        *(u32x4*)(yb + o) = (u32x4){rw[0], rw[1], rw[2], rw[3]};
    }
}

__device__ __forceinline__ void dsa_phase(const f16* zA, const u16* idx, const float* rel_bias, const unsigned char* lut, f16* olat, LAS unsigned char* lds, int tid, int lane, int wave, int G, int bx) {
    LAS unsigned char* lutS = lds + SMALL_OFF; LAS float* biasS = (LAS float*)(lds + SMALL_OFF + 4096);
    for (int i = tid; i < SEQ / 4; i += 512) ((LAS unsigned*)lutS)[i] = ((const unsigned*)lut)[i];
    if (tid < 256) biasS[tid] = rel_bias[(tid >> 3) * 20 + (tid & 7)];
    __syncthreads();
    LAS unsigned char* kv = lds + wave * 16384;
    const int g4 = lane >> 4, head = lane & 15, hq = head & 7;
    const unsigned trq = (unsigned)(head >> 2), trp = (unsigned)(lane & 3);
    int tok0, tstride, ntok;
    if (G == 256) { const int bsel = (bx & 7) >> 1, wib = (((bx & 7) & 1) + 2 * (bx >> 3)) * NWAVES + wave; tok0 = bsel * SEQ + wib; tstride = 512; ntok = 8; }
    else { tok0 = bx * NWAVES + wave; tstride = G * NWAVES; ntok = (M - tok0 + tstride - 1) / tstride; }
    for (int it = 0; it < ntok; ++it) {
        const int row = tok0 + it * tstride, b = row >> 12, t = row & (SEQ - 1);
        const f16* zb = zA + (size_t)b * SEQ * NZA; const f16* zq = zb + (size_t)t * NZA;
        f16x8 qf[8];
#pragma unroll
        for (int s = 0; s < 8; ++s) { const u32x4 w = *(const u32x4*)(zq + hq * 256 + 32 * s + 8 * g4); qf[s] = head < 8 ? __builtin_bit_cast(f16x8, w) : (f16x8){0, 0, 0, 0, 0, 0, 0, 0}; }
        const int nvalid = t + 1 < 256 ? t + 1 : 256, nch = (nvalid + 31) >> 5;
        f32x4 oacc[16];
#pragma unroll
        for (int c = 0; c < 16; ++c) oacc[c] = (f32x4){0.f, 0.f, 0.f, 0.f};
        float mrun = NEG_INF, lrun = 0.f;
        const u16* irow = idx + (size_t)row * 256;
        for (int ch = 0; ch < nch; ++ch) {
            const u16x8 my8 = *(const u16x8*)(irow + 32 * ch + 8 * g4);
            const int idxr = (int)irow[32 * ch + (lane & 31)];
#pragma unroll
            for (int p = 0; p < 16; ++p) { const int rr = 2 * p + (lane >> 5); int ir = __shfl(idxr, rr); ir = ir == 0xFFFF ? 0 : ir;
                const u32x4 v = *(const u32x4*)(zb + (size_t)ir * NZA + ZA_CKV + 8 * (lane & 31));
                *(LAS u32x4*)(kv + ((lane & 31) >> 4) * 8192 + off_b((unsigned)rr, (unsigned)(lane & 15))) = v; }
            asm volatile("s_waitcnt lgkmcnt(0)" ::: "memory");
            f32x4 st[2];
#pragma unroll
            for (int hf = 0; hf < 2; ++hf) { const unsigned krow = 8u * (unsigned)(head >> 2) + 4u * hf + (unsigned)(head & 3); f32x4 acc = {0.f, 0.f, 0.f, 0.f};
#pragma unroll
                for (int s = 0; s < 8; ++s) { const f16x8 kf = *(const LAS f16x8*)(kv + (s >> 2) * 8192 + off_b(krow, 4u * (s & 3) + (unsigned)g4)); acc = __builtin_amdgcn_mfma_f32_16x16x32_f16(kf, qf[s], acc, 0, 0, 0); }
                st[hf] = acc; }
            float sv[8], cmax = NEG_INF;
#pragma unroll
            for (int e = 0; e < 8; ++e) { const int kidx = (int)my8[e]; const bool valid = kidx != 0xFFFF; const int dist = valid ? t - kidx : 0;
                const int bk = (int)lutS[dist]; const float s = valid ? st[e >> 2][e & 3] + biasS[bk * 8 + hq] : NEG_INF; sv[e] = s; cmax = fmaxf(cmax, s); }
            cmax = fmaxf(cmax, __shfl_xor(cmax, 16)); cmax = fmaxf(cmax, __shfl_xor(cmax, 32));
            const float mnew = fmaxf(mrun, cmax), alpha = __expf(mrun - mnew); float p[8], ps = 0.f;
#pragma unroll
            for (int e = 0; e < 8; ++e) { p[e] = __expf(sv[e] - mnew); ps += p[e]; }
            ps += __shfl_xor(ps, 16); ps += __shfl_xor(ps, 32);
            lrun = lrun * alpha + ps; mrun = mnew;
            const f16x8 pf = __builtin_bit_cast(f16x8, pkh8((f32x4){p[0], p[1], p[2], p[3]}, (f32x4){p[4], p[5], p[6], p[7]}));
#pragma unroll
            for (int ct = 0; ct < 16; ++ct) {
                const unsigned r0 = 8u * (unsigned)g4 + trq, cch = 2u * (ct & 7) + (trp >> 1);
                LAS unsigned char* img = kv + (ct >> 3) * 8192;
                const s16x4 t0 = __builtin_amdgcn_ds_read_tr16_b64_v4i16((LAS s16x4*)(img + off_b(r0, cch) + 8 * (trp & 1)));
                const s16x4 t1 = __builtin_amdgcn_ds_read_tr16_b64_v4i16((LAS s16x4*)(img + off_b(r0 + 4, cch) + 8 * (trp & 1)));
                const f16x8 vf = __builtin_bit_cast(f16x8, __builtin_shufflevector(t0, t1, 0, 1, 2, 3, 4, 5, 6, 7));
                oacc[ct] = __builtin_amdgcn_mfma_f32_16x16x32_f16(vf, pf, oacc[ct] * alpha, 0, 0, 0); }
            asm volatile("s_waitcnt lgkmcnt(0)" ::: "memory");
        }
        const float rl = 1.0f / lrun;
        if (head < 8) { f16* op = olat + (size_t)row * 2048 + head * 256 + 4 * g4;
#pragma unroll
            for (int ct = 0; ct < 16; ++ct) { u32x2 w; w.x = pkh(oacc[ct][0] * rl, oacc[ct][1] * rl); w.y = pkh(oacc[ct][2] * rl, oacc[ct][3] * rl); *(u32x2*)(op + 16 * ct) = w; } }
    }
}
#define XB_TMO      128
#define XB_XCNT(j)  (256  + 64 * (j))
#define XB_XSUB(j)  (1280 + 64 * (j))
#define XB_XGEN(j)  (2304 + 64 * (j))
#define XB_TOP      3328
#define XB_TOPGEN   3392
#define XCD_BAR_WORDS 3456
#define XB_SPIN_CAP (1u << 18)

__device__ __forceinline__ unsigned xb_ld(unsigned* p)              { return __hip_atomic_load(p, __ATOMIC_RELAXED, __HIP_MEMORY_SCOPE_AGENT); }
__device__ __forceinline__ unsigned xb_add(unsigned* p, unsigned v) { return __hip_atomic_fetch_add(p, v, __ATOMIC_RELAXED, __HIP_MEMORY_SCOPE_AGENT); }
__device__ __forceinline__ unsigned xb_xcc_id() { return (unsigned)__builtin_amdgcn_s_getreg((3 << 11) | 20) & 0xFu; }
#define XB_SPIN(cond, bar) do { unsigned _sp = 0; while (cond) { __builtin_amdgcn_s_sleep(1); \
    if ((++_sp & 255u) == 0u) { if (xb_ld(&(bar)[XB_TMO])) break; if (_sp > XB_SPIN_CAP) { atomicAdd(&(bar)[XB_TMO], 1u); break; } } } } while (0)

struct XcdBarrier {
    unsigned* bar; unsigned x;
    volatile LAS unsigned* st;
};

__device__ __forceinline__ XcdBarrier xcd_barrier_post(unsigned* bar, volatile LAS unsigned* st) {
    XcdBarrier b; b.bar = bar; b.x = xb_xcc_id(); b.st = st;
    if (threadIdx.x == 0) (void)xb_add(&bar[XB_XCNT(b.x)], 1u);
    return b;
}
__device__ __forceinline__ void xcd_barrier_complete(unsigned* bar, unsigned x, unsigned& nloc, unsigned& nx) {
    const unsigned G = gridDim.x * gridDim.y * gridDim.z;
    unsigned sum, cnt, mine, sp = 0u;
    for (;;) {
        sum = 0u; cnt = 0u; mine = 0u;
#pragma unroll
        for (unsigned j = 0; j < 16; ++j) { const unsigned c = xb_ld(&bar[XB_XCNT(j)]); sum += c; cnt += (c > 0u) ? 1u : 0u; mine = (j == x) ? c : mine; }
        if (sum == G) break;
        __builtin_amdgcn_s_sleep(1);
        if ((++sp & 255u) == 0u) { if (xb_ld(&bar[XB_TMO])) break; if (sp > XB_SPIN_CAP) { atomicAdd(&bar[XB_TMO], 1u); break; } }
    }
    nloc = mine > 0u ? mine : 1u; nx = cnt > 0u ? cnt : 1u;
}

__device__ __forceinline__ void xcd_barrier(const XcdBarrier& b) {
    asm volatile("s_waitcnt vmcnt(0)" ::: "memory");
    __syncthreads();
    if (threadIdx.x == 0) {
        unsigned* bar = b.bar;
        __builtin_amdgcn_s_waitcnt(0);
        unsigned nloc = b.st[0], nx = b.st[1];
        if (nloc == 0u) { xcd_barrier_complete(bar, b.x, nloc, nx); b.st[0] = nloc; b.st[1] = nx; }
        const unsigned old = xb_add(&bar[XB_XSUB(b.x)], 1u);
        const unsigned gen = old / nloc;
        if (old + 1u == (gen + 1u) * nloc) {
            __builtin_amdgcn_fence(__ATOMIC_RELEASE, "agent");
            asm volatile("s_waitcnt vmcnt(0)" ::: "memory");
            const unsigned og = xb_add(&bar[XB_TOP], 1u);
            const unsigned tg = og / nx;
            if (og + 1u == (tg + 1u) * nx) xb_add(&bar[XB_TOPGEN], 1u);
            else XB_SPIN(xb_ld(&bar[XB_TOPGEN]) == tg, bar);
            __builtin_amdgcn_fence(__ATOMIC_ACQUIRE, "agent");
            xb_add(&bar[XB_XGEN(b.x)], 1u);
            asm volatile("s_waitcnt vmcnt(0)" ::: "memory");
        } else {
            XB_SPIN(xb_ld(&bar[XB_XGEN(b.x)]) == gen, bar);
            __builtin_amdgcn_fence(__ATOMIC_ACQUIRE, "agent");
            asm volatile("s_waitcnt vmcnt(0)" ::: "memory");
        }
    }
    __syncthreads();
}

#ifndef MK_PER_PHASE
#define MK_PER_PHASE 0
#endif
constexpr int N_PHASES = 12 * DEPTH + 1;
struct Args { const float* in[20]; float* out; unsigned char* ws; int ph_lo, ph_hi; };
#ifndef ONLY_PHASE
#define ONLY_PHASE -1
#endif
#define IN(k) ((ONLY_PHASE < 0 || ((k) == 12 * DEPTH ? 12 : (k) % 12) == ONLY_PHASE) && lo <= (k) && (k) < hi)
#define SEAM(k) do { if (IN(k) && IN((k) + 1)) { XcdBarrier bb = bar; asm volatile("" : "+s"(bb.bar), "+s"(bb.x)); xcd_barrier(bb); } } while (0)
#define CAS __attribute__((address_space(4)))
#define PH_IDS int tid = tid0; asm volatile("" : "+v"(tid)); const int lane = tid & 63, wave = __builtin_amdgcn_readfirstlane(tid >> 6); (void)lane; (void)wave; \
    int G = (int)gridDim.x, bx = (int)blockIdx.x; asm volatile("" : "+s"(G), "+s"(bx)); \
    const CAS Args* ap = (const CAS Args*)__builtin_amdgcn_kernarg_segment_ptr(); asm volatile("" : "+s"(ap)); unsigned char* ws = ap->ws
#define W_IN_T ((f16*)(ws + WS_W + WO_IN))
#define W_GU_T ((f16*)(ws + WS_W + WO_GU))
#define W_DOWN_T ((f16*)(ws + WS_W + WO_DOWN))
#define W_OUT_T ((f16*)(ws + WS_W + WO_OUT))
#define W_AUP_T ((f16*)(ws + WS_W + WO_AUP))
#define W_BUP_T ((f16*)(ws + WS_W + WO_BUP))
#define B_XA ((float*)(ws + WS_X))
#define B_H ((f16*)(ws + WS_H))
#define B_OB ((f16*)(ws + WS_H))
#define B_YB ((f16*)(ws + WS_H + 48 * MiB))
#define B_ZA ((f16*)(ws + WS_ZA))
#define B_ZB ((f16*)(ws + WS_ZB))
#define B_ZG ((f16*)(ws + WS_ZG))
#define B_SC ((float*)(ws + WS_ZB))
#define B_OLAT ((f16*)(ws + WS_ZB))
#define B_MERGED ((f16*)(ws + WS_ZB + 64 * MiB))
#define B_ACT ((f16*)(ws + WS_ZA))
#define B_LSE ((float*)(ws + WS_LSE))
#define B_IDX ((u16*)(ws + WS_IDX))
#define B_ROPE ((const f32x2*)(ws + WS_ROPE))
#define B_LUT ((const unsigned char*)(ws + WS_LUT))
#define B_MOD ((const float*)(ws + WS_MOD) + (size_t)l * NB * 12288)
#define X_IN (l == 0 ? ap->in[0] : (const float*)ap->out)
template <int l> __device__ __forceinline__ void layer_body(LAS unsigned char* lds, const int tid0, const int lo, const int hi, const XcdBarrier& bar) {
        const int pb = 12 * l;
        if (IN(pb + 0)) { PH_IDS; Ptrs P;
            P.x = ap->in[0]; P.c = ap->in[1]; P.rel_bias = ap->in[2]; P.w_ada = ap->in[3]; P.b_ada = ap->in[4]; P.norm1_g = ap->in[5]; P.w_in = ap->in[6]; P.kv_norm_g = ap->in[7];
            P.idx_ln_g = ap->in[8]; P.idx_ln_b = ap->in[9]; P.w_uk = ap->in[10]; P.w_uv = ap->in[11]; P.w_a_up = ap->in[12]; P.w_b_up = ap->in[13]; P.w_out = ap->in[14]; P.norm2_g = ap->in[15];
            P.w_ff_gate = ap->in[16]; P.w_ff_up = ap->in[17]; P.w_ff_down = ap->in[18]; P.final_g = ap->in[19]; P.out = ap->out; P.ws = ws;
            p0_phase(P, l, lds, tid, lane, wave, G, bx); SEAM(pb + 0); }
        if (IN(pb + 1)) { PH_IDS; norm_mod_phase(X_IN, ap->in[5] + (size_t)l * D, B_MOD, B_MOD + D, B_H, lane, wave, G, bx); SEAM(pb + 1); }
        if (IN(pb + 2)) { PH_IDS; pg8::Gemm g{B_H, W_IN_T, M, NIN, D}; pg8::StaticOrder S; S.init(M, NIN, G, bx); pg8::EpiIn E{B_ZA, B_ZB, B_ZG};
            pg8::gemm_phase<pg8::EpiIn, pg8::StaticOrder, true, true>(lds, g, S, E); SEAM(pb + 2); }
        if (IN(pb + 3)) { PH_IDS; zfix_phase(B_ZA, ap->in[7] + (size_t)l * 256, ap->in[8] + (size_t)l * 64, ap->in[9] + (size_t)l * 64, B_ROPE, lane, wave, G, bx);
            battn_phase(B_ZB, ap->in[2], B_LUT, B_OB, B_LSE, lds, tid, lane, wave, G, bx); SEAM(pb + 3); }
        if (IN(pb + 4)) { PH_IDS; score_phase(B_ZA, B_SC, lane, wave, G, bx); SEAM(pb + 4); }
        if (IN(pb + 5)) { PH_IDS; select_phase(B_SC, B_IDX, lane, wave, G, bx); bmerge_phase(B_OB, B_LSE, B_YB, lane, wave, G, bx); SEAM(pb + 5); }
        if (IN(pb + 6)) { PH_IDS; dsa_phase(B_ZA, B_IDX, ap->in[2], B_LUT, B_OLAT, lds, tid, lane, wave, G, bx); SEAM(pb + 6); }
        if (IN(pb + 7)) {
            { PH_IDS; pg8::Gemm g{B_OLAT, W_AUP_T, M, D, D}; pg8::StaticOrder S; S.init(M, D, G, bx); pg8::EpiGate<0> E{B_ZG, B_MERGED};
              pg8::gemm_phase<pg8::EpiGate<0>, pg8::StaticOrder, true, true>(lds, g, S, E); }
            __syncthreads();
            { PH_IDS; pg8::Gemm g{B_YB, W_BUP_T, M, D, 512}; pg8::StaticOrder S; S.init(M, D, G, bx); pg8::EpiGate<1> E{B_ZG, B_MERGED};
              pg8::gemm_phase<pg8::EpiGate<1>, pg8::StaticOrder, true, true>(lds, g, S, E); }
            SEAM(pb + 7); }
        if (IN(pb + 8)) { PH_IDS; pg8::Gemm g{B_MERGED, W_OUT_T, M, D, D}; pg8::StaticOrder S; S.init(M, D, G, bx); pg8::EpiResid E{X_IN, B_XA, B_MOD + 2 * D};
            pg8::gemm_phase<pg8::EpiResid, pg8::StaticOrder, true, true>(lds, g, S, E); SEAM(pb + 8); }
        if (IN(pb + 9)) { PH_IDS; norm_mod_phase(B_XA, ap->in[15] + (size_t)l * D, B_MOD + 3 * D, B_MOD + 4 * D, B_H, lane, wave, G, bx); SEAM(pb + 9); }
        if (IN(pb + 10)) { PH_IDS; pg8::Gemm g{B_H, W_GU_T, M, NGU, D}; pg8::StaticOrder S; S.init(M, NGU, G, bx); pg8::EpiSwiGLU E{B_ACT};
            pg8::gemm_phase<pg8::EpiSwiGLU, pg8::StaticOrder, true, true>(lds, g, S, E); SEAM(pb + 10); }
        if (IN(pb + 11)) { PH_IDS; pg8::Gemm g{B_ACT, W_DOWN_T, M, D, DFF}; pg8::StaticOrder S; S.init(M, D, G, bx); pg8::EpiResid E{B_XA, ap->out, B_MOD + 5 * D};
            pg8::gemm_phase<pg8::EpiResid, pg8::StaticOrder, true, true>(lds, g, S, E); SEAM(pb + 11); }
    }
__global__ void __launch_bounds__(NWAVES * 64, 2) fwd(Args args) {
    extern __shared__ __attribute__((aligned(16))) unsigned char lds_raw[];
    LAS unsigned char* lds = (LAS unsigned char*)lds_raw;
    const int tid0 = threadIdx.x;
    for (int u = tid0; u < (LDS_BYTES - LDSCTL_OFF) / 4; u += NWAVES * 64) ((LAS unsigned*)(lds + LDSCTL_OFF))[u] = 0u;
    __syncthreads();
    const int lo = args.ph_lo, hi = args.ph_hi;
    XcdBarrier bar; bar.bar = (unsigned*)(args.ws + WS_CTL) + CW_BAR; bar.x = 0; bar.st = nullptr;
    if (hi - lo > 1) bar = xcd_barrier_post((unsigned*)(args.ws + WS_CTL) + CW_BAR, (volatile LAS unsigned*)(lds + MISC_OFF) + 8);
    layer_body<0>(lds, tid0, lo, hi, bar);
    layer_body<1>(lds, tid0, lo, hi, bar);
    if (IN(12 * DEPTH)) { PH_IDS; final_norm_phase(ap->out, ap->in[19], lane, wave, G, bx); }
#undef IN
#undef SEAM
}

extern "C" void kernel_launch(void* const* d_in, const int* in_sizes, int n_in, void* d_out, int out_size, void* d_ws, size_t ws_size, hipStream_t stream) {
    static int grid = 0;
    if (grid == 0) {
        if (n_in != 20 || in_sizes[0] != M * D || out_size != M * D || ws_size < WS_END) { fprintf(stderr, "kernel_launch: built for 20 inputs, x/out of %d floats, >= %zu bytes of workspace; got n_in %d, in0 %d, out %d, ws %zu; nothing launched\n", M * D, (size_t)WS_END, n_in, n_in > 0 ? in_sizes[0] : -1, out_size, ws_size); grid = -1; return; }
        int dev = 0, cus = 0, per_cu = 0;
        if (hipGetDevice(&dev) != hipSuccess || hipDeviceGetAttribute(&cus, hipDeviceAttributeMultiprocessorCount, dev) != hipSuccess) { fprintf(stderr, "kernel_launch: device query failed\n"); grid = -1; return; }
        if (hipFuncSetAttribute((const void*)fwd, hipFuncAttributeMaxDynamicSharedMemorySize, LDS_BYTES) != hipSuccess) { fprintf(stderr, "kernel_launch: hipFuncSetAttribute failed\n"); grid = -1; return; }
        if (hipOccupancyMaxActiveBlocksPerMultiprocessor(&per_cu, (const void*)fwd, NWAVES * 64, LDS_BYTES) != hipSuccess || per_cu < 1)
            fprintf(stderr, "kernel_launch: note: occupancy query reports %d workgroups per CU\n", per_cu);
        (void)hipGetLastError();
        grid = cus;
    }
    if (grid < 0) return;
    if (hipMemsetAsync((char*)d_ws + WS_CTL, 0, CTL_ZERO_BYTES, stream) != hipSuccess) { fprintf(stderr, "kernel_launch: memset failed\n"); return; }
    Args a{};
    for (int i = 0; i < 20; ++i) a.in[i] = (const float*)d_in[i];
    a.out = (float*)d_out; a.ws = (unsigned char*)d_ws;
#if MK_PER_PHASE
    for (int p = 0; p < N_PHASES; ++p) { a.ph_lo = p; a.ph_hi = p + 1; hipLaunchKernelGGL(fwd, dim3(grid), dim3(NWAVES * 64), LDS_BYTES, stream, a); }
#else
    a.ph_lo = 0; a.ph_hi = N_PHASES;
    hipLaunchKernelGGL(fwd, dim3(grid), dim3(NWAVES * 64), LDS_BYTES, stream, a);
#endif
    const hipError_t le = hipPeekAtLastError();
    if (le != hipSuccess) fprintf(stderr, "kernel_launch: launch failed: %s\n", hipGetErrorName(le));
}
```

```cpp
#include <hip/hip_runtime.h>
#include <cstdio>
#include <cstdint>

#define LAS __attribute__((address_space(3)))
#define GAS __attribute__((address_space(1)))
typedef _Float16 f16;
typedef _Float16 f16x2 __attribute__((ext_vector_type(2)));
typedef _Float16 f16x4 __attribute__((ext_vector_type(4)));
typedef _Float16 f16x8 __attribute__((ext_vector_type(8)));
typedef float f32x2 __attribute__((ext_vector_type(2)));
typedef float f32x4 __attribute__((ext_vector_type(4)));
typedef float f32x16 __attribute__((ext_vector_type(16)));
typedef unsigned u32x2 __attribute__((ext_vector_type(2)));
typedef unsigned u32x4 __attribute__((ext_vector_type(4)));
typedef short s16x4 __attribute__((ext_vector_type(4)));
typedef unsigned short u16x8 __attribute__((ext_vector_type(8)));
typedef unsigned short u16;

__device__ __forceinline__ unsigned pkh(float a, float b) { f32x2 v = {a, b}; return __builtin_bit_cast(unsigned, __builtin_convertvector(v, f16x2)); }
__device__ __forceinline__ u32x4 pkh8(f32x4 a, f32x4 b) { u32x4 w; w.x = pkh(a[0], a[1]); w.y = pkh(a[2], a[3]); w.z = pkh(b[0], b[1]); w.w = pkh(b[2], b[3]); return w; }
__device__ __forceinline__ f32x2 unpk(unsigned w) { return __builtin_convertvector(__builtin_bit_cast(f16x2, w), f32x2); }
__device__ __forceinline__ float sigm(float x) { return __builtin_amdgcn_rcpf(1.0f + __expf(-x)); }
__device__ __forceinline__ float wave_sum(float v) {
#pragma unroll
    for (int o = 1; o < 64; o <<= 1) v += __shfl_xor(v, o);
    return v;
}
namespace pg8 {
#define PG8_LAS __attribute__((address_space(3)))
typedef _Float16 bf16_t;
typedef _Float16 bf16x8 __attribute__((ext_vector_type(8)));
typedef float f32x4 __attribute__((ext_vector_type(4)));
typedef unsigned u32x4 __attribute__((ext_vector_type(4)));
constexpr int BM = 256, BK = 64, HALF = 128, HTB = HALF * BK * 2  , STAGE_BYTES = 8 * HTB, NXCD = 8, WGM = 8;

__host__ __device__ __forceinline__ int lds_byte(int r, int c) { const int st = (r >> 4) * 2 + (c >> 5), rr = r & 15, cc = c & 31, ob = rr * 64 + cc * 2; return st * 1024 + (ob ^ (((ob >> 9) & 1) << 5)); }
__host__ __device__ __forceinline__ void stage_rc(int b, int& R, int& C) { const int st = b / 1024, sb = b % 1024, swz = sb ^ (((sb >> 9) & 1) << 5); R = (st >> 1) * 16 + swz / 64; C = (st & 1) * 32 + (swz % 64) / 2; }
__host__ __device__ __forceinline__ int perm32(int rho) { const int n = rho >> 4, i = rho & 15; return 8 * (i >> 2) + 4 * n + (i & 3); }

struct Unit { int pm, pn; };
struct Gemm { const bf16_t* A; const bf16_t* Bt; int M, N, K; };
typedef int i32x4v __attribute__((ext_vector_type(4)));

struct StaticOrder {
    int nM, nN, nwg, G, c;
    __host__ __device__ void init(int M, int N, int G_, int c_) { nM = M / BM; nN = N / BM; nwg = nM * nN; G = G_; c = c_; }
    __host__ __device__ bool next(int i, Unit& u) const {
        const long L = (long)i * G + c; if (L >= nwg) return false;
        int wgid = (int)L; { const int q = nwg / NXCD, r = nwg % NXCD, xcd = wgid % NXCD, off = wgid / NXCD; wgid = (xcd < r ? xcd * (q + 1) : r * (q + 1) + (xcd - r) * q) + off; }
        const int nig = WGM * nN, gid = wgid / nig, fm = gid * WGM, gsz = (nM - fm) < WGM ? (nM - fm) : WGM;
        u.pm = fm + ((wgid % nig) % gsz); u.pn = (wgid % nig) / gsz; return true;
    }
    __device__ __forceinline__ void a_ready(const Unit&) const {}
    __device__ __forceinline__ void done(const Unit&) const {}
};

__device__ __forceinline__ f32x4 i2f4(f32x4 a) { const i32x4v v = __builtin_bit_cast(i32x4v, a); return (f32x4){(float)v[0], (float)v[1], (float)v[2], (float)v[3]}; }
struct EpiInQ {
    static constexpr bool PERM = true, AFTER_DRAIN = false;
    bf16_t *zA, *zB, *zG; const float* rs; const float* cs;
    __device__ __forceinline__ void operator()(const f32x4 (&acc)[2][2][4][2], const Unit& u, int wr, int wc, int fr, int fq) const {
        const int row0 = u.pm * BM + wr * 64 + fr; bf16_t* base; int ld, colt; bool sg = false;
        if (u.pn < 1) { base = zA; ld = 3584; colt = 2048; } else if (u.pn < 19) { base = zB; ld = 4608; colt = (u.pn - 1) * BM; } else { base = zG; ld = 4096; colt = (u.pn - 19) * BM; sg = true; }
        const int col0 = colt + wc * 32 + 8 * fq; const float* csp = cs + u.pn * BM + wc * 32 + 8 * fq;
        f32x4 cv[2][2];
#pragma unroll
        for (int bj = 0; bj < 2; ++bj)
#pragma unroll
            for (int n = 0; n < 2; ++n) cv[bj][n] = *(const f32x4*)(csp + bj * HALF + 4 * n);
#pragma unroll
        for (int ai = 0; ai < 2; ++ai)
#pragma unroll
            for (int m = 0; m < 4; ++m) { const int row = row0 + ai * HALF + m * 16; const float r = rs[row]; bf16_t* rowp = base + (size_t)row * ld + col0;
#pragma unroll
                for (int bj = 0; bj < 2; ++bj) { f32x4 v0 = i2f4(acc[ai][bj][m][0]) * cv[bj][0] * r, v1 = i2f4(acc[ai][bj][m][1]) * cv[bj][1] * r;
                    if (sg) {
#pragma unroll
                        for (int j = 0; j < 4; ++j) { v0[j] = sigm(v0[j]); v1[j] = sigm(v1[j]); } }
                    *(u32x4*)(rowp + bj * HALF) = pkh8(v0, v1); } }
    }
};
struct EpiInF {
    static constexpr bool PERM = true, AFTER_DRAIN = false;
    bf16_t* zA;
    __device__ __forceinline__ void operator()(const f32x4 (&acc)[2][2][4][2], const Unit& u, int wr, int wc, int fr, int fq) const {
        const int row0 = u.pm * BM + wr * 64 + fr, col0 = (u.pn < 8 ? u.pn * BM : 2304 + (u.pn - 8) * BM) + wc * 32 + 8 * fq;
#pragma unroll
        for (int ai = 0; ai < 2; ++ai)
#pragma unroll
            for (int m = 0; m < 4; ++m) { bf16_t* rowp = zA + (size_t)(row0 + ai * HALF + m * 16) * 3584 + col0;
#pragma unroll
                for (int bj = 0; bj < 2; ++bj) *(u32x4*)(rowp + bj * HALF) = pkh8(acc[ai][bj][m][0], acc[ai][bj][m][1]); }
    }
};
template <int MODE> struct EpiGate {
    static constexpr bool PERM = true, AFTER_DRAIN = false;
    const bf16_t* zG; bf16_t* out;
    __device__ __forceinline__ void operator()(const f32x4 (&acc)[2][2][4][2], const Unit& u, int wr, int wc, int fr, int fq) const {
        const int row0 = u.pm * BM + wr * 64 + fr, col0 = u.pn * BM + wc * 32 + 8 * fq;
#pragma unroll
        for (int ai = 0; ai < 2; ++ai)
#pragma unroll
            for (int m = 0; m < 4; ++m) { const size_t row = (size_t)(row0 + ai * HALF + m * 16);
#pragma unroll
                for (int bj = 0; bj < 2; ++bj) {
                    const u32x4 gw = *(const u32x4*)(zG + row * 4096 + MODE * 2048 + col0 + bj * HALF);
                    const f32x2 g0 = unpk(gw.x), g1 = unpk(gw.y), g2 = unpk(gw.z), g3 = unpk(gw.w);
                    f32x4 v0 = acc[ai][bj][m][0] * (f32x4){g0.x, g0.y, g1.x, g1.y}, v1 = acc[ai][bj][m][1] * (f32x4){g2.x, g2.y, g3.x, g3.y};
                    bf16_t* op = out + row * 2048 + col0 + bj * HALF;
                    if (MODE == 1) { const u32x4 pw = *(const u32x4*)op; const f32x2 p0 = unpk(pw.x), p1 = unpk(pw.y), p2 = unpk(pw.z), p3 = unpk(pw.w);
                        v0 += (f32x4){p0.x, p0.y, p1.x, p1.y}; v1 += (f32x4){p2.x, p2.y, p3.x, p3.y}; }
                    *(u32x4*)op = pkh8(v0, v1);
                    asm volatile("" ::: "memory"); } }
    }
};
struct EpiResid {
    static constexpr bool PERM = false, AFTER_DRAIN = false;
    const float* xi; float* xo; const float* gate;
    __device__ __forceinline__ void operator()(const f32x4 (&acc)[2][2][4][2], const Unit& u, int wr, int wc, int fr, int fq) const {
        const int row0 = u.pm * BM + wr * 64 + fr, col0 = u.pn * BM + wc * 32 + 4 * fq; const float* gp = gate + (size_t)(u.pm >> 4) * 12288 + col0;
        f32x4 gv[2][2];
#pragma unroll
        for (int bj = 0; bj < 2; ++bj)
#pragma unroll
            for (int n = 0; n < 2; ++n) gv[bj][n] = *(const f32x4*)(gp + bj * HALF + n * 16);
#pragma unroll
        for (int ai = 0; ai < 2; ++ai)
#pragma unroll
            for (int m = 0; m < 4; ++m) { const size_t off = (size_t)(row0 + ai * HALF + m * 16) * 2048 + col0;
#pragma unroll
                for (int bj = 0; bj < 2; ++bj)
#pragma unroll
                    for (int n = 0; n < 2; ++n) *(f32x4*)(xo + off + bj * HALF + n * 16) = *(const f32x4*)(xi + off + bj * HALF + n * 16) + gv[bj][n] * acc[ai][bj][m][n];
                asm volatile("" ::: "memory"); }
    }
};
struct EpiSwiGLU {
    static constexpr bool PERM = true, AFTER_DRAIN = false;
    bf16_t* act; const float* rs; const float* cs;
    __device__ __forceinline__ void operator()(const f32x4 (&acc)[2][2][4][2], const Unit& u, int wr, int wc, int fr, int fq) const {
        const int row0 = u.pm * BM + wr * 64 + fr, col0 = u.pn * HALF + wc * 32 + 8 * fq; const float* csp = cs + u.pn * BM + wc * 32 + 8 * fq;
        f32x4 cv[2][2];
#pragma unroll
        for (int bj = 0; bj < 2; ++bj)
#pragma unroll
            for (int n = 0; n < 2; ++n) cv[bj][n] = *(const f32x4*)(csp + bj * HALF + 4 * n);
#pragma unroll
        for (int ai = 0; ai < 2; ++ai)
#pragma unroll
            for (int m = 0; m < 4; ++m) { f32x4 o[2]; const int row = row0 + ai * HALF + m * 16; const float r = rs[row];
#pragma unroll
                for (int n = 0; n < 2; ++n) { const f32x4 g = i2f4(acc[ai][0][m][n]) * cv[0][n] * r, up = i2f4(acc[ai][1][m][n]) * cv[1][n] * r;
#pragma unroll
                    for (int j = 0; j < 4; ++j) o[n][j] = g[j] * sigm(g[j]) * up[j]; }
                *(u32x4*)(act + (size_t)row * 5632 + col0) = pkh8(o[0], o[1]); }
    }
};
template <class Epi, class Sched, bool ALIGN_EPI = false, bool SP2 = false, bool I8 = false>
__device__ __forceinline__ void gemm_phase(PG8_LAS unsigned char* lds, const Gemm g, const Sched& S, const Epi& E) {
    int tid_ = threadIdx.x; asm volatile("" : "+v"(tid_));
    const int tid = tid_, wid = __builtin_amdgcn_readfirstlane(tid >> 6), lane = tid & 63, wr = wid >> 2, wc = wid & 3, fr = lane & 15, fq = lane >> 4;
    const int K = g.K, nt = K / BK;
    unsigned voffA[2], voffB[2];
#pragma unroll
    for (int i = 0; i < 2; ++i) { int R, C; stage_rc(tid * 16 + i * 8192, R, C); const int Rb = Epi::PERM ? ((R & ~31) + perm32(R & 31)) : R;
        voffA[i] = (unsigned)(R * K + C) * 2u; voffB[i] = (unsigned)(Rb * K + C) * 2u; }
    const size_t kstep = (size_t)(BK * 2);
    const size_t hstep = (size_t)HALF * K * 2;
    const size_t tstep = 2 * hstep;
    const unsigned ldsw = (unsigned)wid * 1024u;
    const int aoff = lds_byte(wr * 64 + fr, fq * 8), boff = lds_byte(wc * 32 + fr, fq * 8);
#define PG8_SA(b, h) (((b) * 2 + (h)) * HTB)
#define PG8_SB(b, h) ((4 + (b) * 2 + (h)) * HTB)
#define PG8_STAGE(bufoff, gbase, voff) do { _Pragma("unroll") for (int _i = 0; _i < 2; ++_i) \
        __builtin_amdgcn_global_load_lds((const unsigned*)((const char*)(gbase) + (voff)[_i]), (PG8_LAS unsigned*)(lds + (bufoff) + ldsw + _i * 8192), 16, 0, 0); } while (0)
#define PG8_LDA(dst, b, h) do { _Pragma("unroll") for (int m = 0; m < 4; ++m) _Pragma("unroll") for (int k = 0; k < 2; ++k) dst[m][k] = *(const PG8_LAS bf16x8*)(lds + PG8_SA(b, h) + aoff + m * 2048 + k * 1024); } while (0)
#define PG8_LDB(dst, b, h) do { _Pragma("unroll") for (int n = 0; n < 2; ++n) _Pragma("unroll") for (int k = 0; k < 2; ++k) dst[n][k] = *(const PG8_LAS bf16x8*)(lds + PG8_SB(b, h) + boff + n * 2048 + k * 1024); } while (0)
#define PG8_MMA(ai, bj, At, Bt) do { __builtin_amdgcn_s_setprio(1); _Pragma("unroll") for (int m = 0; m < 4; ++m) _Pragma("unroll") for (int n = 0; n < 2; ++n) _Pragma("unroll") for (int k = 0; k < 2; ++k) { \
        if constexpr (I8) acc[ai][bj][m][n] = __builtin_bit_cast(f32x4, __builtin_amdgcn_mfma_i32_16x16x64_i8(__builtin_bit_cast(i32x4v, Bt[n][k]), __builtin_bit_cast(i32x4v, At[m][k]), __builtin_bit_cast(i32x4v, acc[ai][bj][m][n]), 0, 0, 0)); \
        else acc[ai][bj][m][n] = __builtin_amdgcn_mfma_f32_16x16x32_f16(Bt[n][k], At[m][k], acc[ai][bj][m][n], 0, 0, 0); } __builtin_amdgcn_s_setprio(0); } while (0)
#define PG8_WAIT_V(n) asm volatile("s_waitcnt vmcnt(" #n ")" ::: "memory")
#define PG8_WAIT_L(n) asm volatile("s_waitcnt lgkmcnt(" #n ")" ::: "memory")
#define PG8_BAR __builtin_amdgcn_s_barrier()
#define PG8_SCHED __builtin_amdgcn_sched_barrier(0)
    Unit cur, nxt; int ui = 0;
    if (!S.next(0, cur)) return;
    f32x4 acc[2][2][4][2];
#pragma unroll
    for (int a = 0; a < 2; ++a)
#pragma unroll
        for (int b = 0; b < 2; ++b)
#pragma unroll
            for (int m = 0; m < 4; ++m)
#pragma unroll
                for (int n = 0; n < 2; ++n) acc[a][b][m][n] = (f32x4){0.f, 0.f, 0.f, 0.f};
    bf16x8 At[4][2], B0[2][2], B1[2][2];
    const char* cA = (const char*)g.A + (size_t)cur.pm * tstep; const char* cB = (const char*)g.Bt + (size_t)cur.pn * tstep;
    S.a_ready(cur);
    if constexpr (SP2) {
        PG8_STAGE(PG8_SB(0, 0), cB, voffB); PG8_STAGE(PG8_SB(0, 1), cB + hstep, voffB); PG8_STAGE(PG8_SA(0, 0), cA, voffA); PG8_STAGE(PG8_SA(0, 1), cA + hstep, voffA);
        if (wr == 1) PG8_BAR;
        PG8_WAIT_V(2); PG8_BAR;
        PG8_STAGE(PG8_SB(1, 0), cB + kstep, voffB); PG8_STAGE(PG8_SA(1, 0), cA + kstep, voffA); PG8_STAGE(PG8_SB(1, 1), cB + hstep + kstep, voffB);
        PG8_WAIT_V(6); PG8_BAR;
    } else {
        PG8_STAGE(PG8_SB(0, 0), cB, voffB); PG8_STAGE(PG8_SA(0, 0), cA, voffA); PG8_STAGE(PG8_SB(0, 1), cB + hstep, voffB); PG8_STAGE(PG8_SA(0, 1), cA + hstep, voffA);
        if (wr == 1) PG8_BAR;
        PG8_WAIT_V(4); PG8_BAR;
        PG8_STAGE(PG8_SB(1, 0), cB + kstep, voffB); PG8_STAGE(PG8_SA(1, 0), cA + kstep, voffA); PG8_STAGE(PG8_SB(1, 1), cB + hstep + kstep, voffB);
        PG8_WAIT_V(6); PG8_BAR;
    }
    for (;;) {
        const bool has_next = S.next(ui + 1, nxt);
        const char* nA = has_next ? (const char*)g.A + (size_t)nxt.pm * tstep : cA; const char* nB = has_next ? (const char*)g.Bt + (size_t)nxt.pn * tstep : cB;
        for (int t = 0; t < nt; t += 2) {
            const bool last = (t == nt - 2);
            const char* a1 = cA + (size_t)(t + 1) * kstep;
            const char* a2 = last ? nA : cA + (size_t)(t + 2) * kstep; const char* b2 = last ? nB : cB + (size_t)(t + 2) * kstep;
            const char* a3 = a2 + kstep; const char* b3 = b2 + kstep;
            if (last && has_next) S.a_ready(nxt);
            if constexpr (SP2) {
            PG8_LDB(B0, 0, 0); PG8_LDB(B1, 0, 1); PG8_SCHED; PG8_LDA(At, 0, 0); PG8_STAGE(PG8_SA(1, 1), a1 + hstep, voffA);
            PG8_WAIT_V(8); PG8_WAIT_L(0); PG8_BAR; PG8_MMA(0, 0, At, B0); PG8_MMA(0, 1, At, B1); PG8_BAR; PG8_SCHED;
            PG8_LDA(At, 0, 1); PG8_STAGE(PG8_SB(0, 0), b2, voffB); PG8_STAGE(PG8_SB(0, 1), b2 + hstep, voffB); PG8_STAGE(PG8_SA(0, 0), a2, voffA);
            PG8_WAIT_V(8); PG8_WAIT_L(0); PG8_BAR; PG8_MMA(1, 0, At, B0); PG8_MMA(1, 1, At, B1); PG8_BAR; PG8_SCHED;
            PG8_LDB(B0, 1, 0); PG8_LDB(B1, 1, 1); PG8_SCHED; PG8_LDA(At, 1, 0); PG8_STAGE(PG8_SA(0, 1), a2 + hstep, voffA);
            PG8_WAIT_V(8); PG8_WAIT_L(0); PG8_BAR; PG8_MMA(0, 0, At, B0); PG8_MMA(0, 1, At, B1); PG8_BAR; PG8_SCHED;
            PG8_LDA(At, 1, 1); PG8_STAGE(PG8_SB(1, 0), b3, voffB); PG8_STAGE(PG8_SB(1, 1), b3 + hstep, voffB); PG8_STAGE(PG8_SA(1, 0), a3, voffA);
            PG8_WAIT_V(8); PG8_WAIT_L(0); PG8_BAR; PG8_MMA(1, 0, At, B0); PG8_MMA(1, 1, At, B1); PG8_BAR; PG8_SCHED;
            } else {
            PG8_LDB(B0, 0, 0); PG8_SCHED; PG8_LDA(At, 0, 0); PG8_STAGE(PG8_SA(1, 1), a1 + hstep, voffA);
            PG8_WAIT_L(8); PG8_BAR; PG8_WAIT_L(0); PG8_MMA(0, 0, At, B0); PG8_BAR; PG8_SCHED;
            PG8_LDB(B1, 0, 1); PG8_STAGE(PG8_SB(0, 0), b2, voffB);
            PG8_BAR; PG8_WAIT_L(0); PG8_MMA(0, 1, At, B1); PG8_BAR;
            PG8_LDA(At, 0, 1); PG8_STAGE(PG8_SA(0, 0), a2, voffA);
            PG8_BAR; PG8_WAIT_L(0); PG8_MMA(1, 0, At, B0); PG8_BAR; PG8_SCHED;
            PG8_STAGE(PG8_SB(0, 1), b2 + hstep, voffB);
            PG8_WAIT_V(6); PG8_BAR; PG8_MMA(1, 1, At, B1); PG8_BAR;
            PG8_LDB(B0, 1, 0); PG8_SCHED; PG8_LDA(At, 1, 0); PG8_STAGE(PG8_SA(0, 1), a2 + hstep, voffA);
            PG8_WAIT_L(8); PG8_BAR; PG8_WAIT_L(0); PG8_MMA(0, 0, At, B0); PG8_BAR; PG8_SCHED;
            PG8_LDB(B1, 1, 1); PG8_STAGE(PG8_SB(1, 0), b3, voffB);
            PG8_BAR; PG8_WAIT_L(0); PG8_MMA(0, 1, At, B1); PG8_BAR;
            PG8_LDA(At, 1, 1); PG8_STAGE(PG8_SA(1, 0), a3, voffA);
            PG8_BAR; PG8_WAIT_L(0); PG8_MMA(1, 0, At, B0); PG8_BAR; PG8_SCHED;
            PG8_STAGE(PG8_SB(1, 1), b3 + hstep, voffB);
            PG8_WAIT_V(6); PG8_BAR; PG8_MMA(1, 1, At, B1); PG8_BAR;
            }
        }
        if constexpr (ALIGN_EPI) { if (wr == 0) PG8_BAR; }
        if constexpr (!Epi::AFTER_DRAIN) { E(acc, cur, wr, wc, fr, fq); S.done(cur); }
        if (!has_next) break;
#pragma unroll
        for (int a = 0; a < 2; ++a)
#pragma unroll
            for (int b = 0; b < 2; ++b)
#pragma unroll
                for (int m = 0; m < 4; ++m)
#pragma unroll
                    for (int n = 0; n < 2; ++n) acc[a][b][m][n] = (f32x4){0.f, 0.f, 0.f, 0.f};
        cur = nxt; cA = nA; cB = nB; ++ui;
        if constexpr (ALIGN_EPI) { if (wr == 1) PG8_BAR; }
    }
    PG8_WAIT_V(0);
    if constexpr (!ALIGN_EPI) { if (wr == 0) PG8_BAR; }
    PG8_BAR;
    if constexpr (Epi::AFTER_DRAIN) { E.fused(acc, cur, wr, wc, fr, fq, lds, wid, lane); S.done(cur); }
#undef PG8_SA
#undef PG8_SB
#undef PG8_STAGE
#undef PG8_LDA
#undef PG8_LDB
#undef PG8_MMA
#undef PG8_WAIT_V
#undef PG8_WAIT_L
#undef PG8_BAR
#undef PG8_SCHED
}
}

constexpr int NB = 4, SEQ = 4096, M = NB * SEQ, D = 2048, DEPTH = 2;
constexpr int N_IN_SRC = 11088, NQ = 8960  , NF = 3328  ;
constexpr int NZA = 3584, NZB = 4608, NZG = 4096, NIN = 12288;
constexpr int ZA_CKV = 2048, ZA_QI = 2304, ZA_KI = 3328, ZA_WI = 3392;
constexpr int DFF = 5632, NGU = 2 * DFF;
constexpr int NWAVES = 8;
constexpr float NORM_EPS = 1e-6f, NEG_INF = -1e30f;
constexpr int SC_BATCH = 8650752;

constexpr size_t MiB = 1u << 20;
constexpr size_t WS_CTL = 0, CTL_ZERO_BYTES = 1 * MiB;
constexpr size_t WS_MOD = 1 * MiB;
constexpr size_t WS_ROPE = 2 * MiB;
constexpr size_t WS_LUT = 2 * MiB + 768 * 1024;
constexpr size_t WS_LSE = 3 * MiB;
constexpr size_t WS_IDX = 4 * MiB;
constexpr size_t WS_W = 12 * MiB;
constexpr size_t WO_INQ = 0  , WO_INF = 24 * MiB  , WO_GU   = 48 * MiB, WO_DOWN = 92 * MiB, WO_OUT = 114 * MiB, WO_AUP = 122 * MiB, WO_BUP = 130 * MiB;
constexpr size_t WS_X = 144 * MiB;
constexpr size_t WS_H = 272 * MiB;
constexpr size_t WS_ZA = 336 * MiB;
constexpr size_t WS_ZB = 448 * MiB;
constexpr size_t WS_ZG = 592 * MiB;
constexpr size_t WS_H8 = 720 * MiB;
constexpr size_t WS_SCL = 2 * MiB + 512 * 1024;
constexpr size_t WS_END = 752 * MiB;
constexpr int CW_BAR = 4096;

constexpr int RING_BYTES = 131072;
constexpr int LDSCTL_OFF = RING_BYTES, MISC_OFF = LDSCTL_OFF + 320;
constexpr int SMALL_OFF = RING_BYTES + 1024;
constexpr int LDS_BYTES = 147456;

__device__ __forceinline__ unsigned off_b(unsigned row, unsigned ch) { return 256u * row + 16u * (ch ^ (((row & 3) << 2) | ((row >> 2) & 3))); }
__device__ __forceinline__ int rel_bucket_of(int n) {
    if (n < 16) return n;
    int b = 16;
    b += (n >= 22) + (n >= 30) + (n >= 40) + (n >= 54) + (n >= 73) + (n >= 99) + (n >= 134) + (n >= 182) + (n >= 246) + (n >= 332) + (n >= 450) + (n >= 609) + (n >= 825) + (n >= 1117) + (n >= 1513);
    return b;
}

struct Ptrs {
    const float *x, *c, *rel_bias, *w_ada, *b_ada, *norm1_g, *w_in, *kv_norm_g, *idx_ln_g, *idx_ln_b, *w_uk, *w_uv, *w_a_up, *w_b_up, *w_out, *norm2_g, *w_ff_gate, *w_ff_up, *w_ff_down, *final_g;
    float* out; unsigned char* ws;
};

__device__ __forceinline__ unsigned pkq4(float a, float b, float c, float d) {
    const int q0 = (int)__builtin_rintf(a), q1 = (int)__builtin_rintf(b), q2 = (int)__builtin_rintf(c), q3 = (int)__builtin_rintf(d);
    return (unsigned)(q0 & 255) | ((unsigned)(q1 & 255) << 8) | ((unsigned)(q2 & 255) << 16) | ((unsigned)q3 << 24); }
template <int MAP> __device__ __forceinline__ int map_row(int n, float& sc) {
    sc = 1.0f;
    if (MAP == 0) {
        if (n < 2304) return 2048 + (n - 1280);
        if (n < 2368) return 3072 + (n - 2304);
        sc = 0.03125f; return 3136 + (n - 2368);
    }
    return n;
}
template <int MAP> __device__ __forceinline__ void transpose_item(const float* W, int ldw, int k0, int n0, int nvalid, f16* WT, int K, LAS float* scr, int lane) {
#pragma unroll 8
    for (int i = 0; i < 32; ++i) { const int kk = 2 * i + (lane >> 5), n = lane & 31; scr[kk * 33 + n] = (n < nvalid) ? W[(size_t)(k0 + kk) * ldw + n0 + n] : 0.0f; }
    asm volatile("s_waitcnt lgkmcnt(0)" ::: "memory");
    const int c = lane & 7;
#pragma unroll
    for (int j = 0; j < 4; ++j) { const int n = (lane >> 3) + 8 * j; const LAS float* s = scr + (8 * c) * 33 + n;
        if (n < nvalid) { float sc; const int row = map_row<MAP>(n0 + n, sc);
            u32x4 o; o.x = pkh(s[0 * 33] * sc, s[1 * 33] * sc); o.y = pkh(s[2 * 33] * sc, s[3 * 33] * sc); o.z = pkh(s[4 * 33] * sc, s[5 * 33] * sc); o.w = pkh(s[6 * 33] * sc, s[7 * 33] * sc);
            *(u32x4*)(WT + (size_t)row * K + k0 + 8 * c) = o; } }
    asm volatile("s_waitcnt lgkmcnt(0)" ::: "memory");
}
__device__ __forceinline__ void quant_item(const float* W, int ldw, int K, int n0, signed char* dst, int r0, float* sw, LAS float* scr, int lane) {
    const int col = lane & 15, kq = lane >> 4; const float* wp = W + n0 + col;
    float mx = 0.f;
#pragma unroll 16
    for (int k = kq; k < K; k += 4) mx = fmaxf(mx, __builtin_fabsf(wp[(size_t)k * ldw]));
    mx = fmaxf(mx, __shfl_xor(mx, 16)); mx = fmaxf(mx, __shfl_xor(mx, 32));
    const float inv = mx > 0.f ? 127.0f / mx : 0.f;
    if (lane < 16) sw[r0 + col] = mx > 0.f ? mx * (1.0f / 127.0f) : 1.0f;
    for (int kb = 0; kb < K; kb += 64) {
#pragma unroll
        for (int i = 0; i < 16; ++i) { const int kk = 4 * i + kq; scr[kk * 17 + col] = wp[(size_t)(kb + kk) * ldw] * inv; }
        asm volatile("s_waitcnt lgkmcnt(0)" ::: "memory");
        const LAS float* sp = scr + (16 * kq) * 17 + col; u32x4 o;
        o.x = pkq4(sp[0 * 17], sp[1 * 17], sp[2 * 17], sp[3 * 17]); o.y = pkq4(sp[4 * 17], sp[5 * 17], sp[6 * 17], sp[7 * 17]);
        o.z = pkq4(sp[8 * 17], sp[9 * 17], sp[10 * 17], sp[11 * 17]); o.w = pkq4(sp[12 * 17], sp[13 * 17], sp[14 * 17], sp[15 * 17]);
        *(u32x4*)(dst + (size_t)(r0 + col) * K + kb + 16 * kq) = o;
        asm volatile("s_waitcnt lgkmcnt(0)" ::: "memory");
    }
}
__device__ __forceinline__ void minigemm_tile(const float* Asrc, int lda, const float* Bsrc, int ldb, f16* out, int ldo, float scale, LAS unsigned char* lds, int tid) {
    LAS float* As = (LAS float*)lds; LAS float* Bs = (LAS float*)(lds + 32768);
#pragma unroll
    for (int i = 0; i < 4; ++i) { const int q = tid + 512 * i, d = q >> 4, r4 = q & 15; *(LAS f32x4*)(As + d * 64 + 4 * r4) = *(const f32x4*)(Asrc + (size_t)d * lda + 4 * r4); }
#pragma unroll
    for (int i = 0; i < 4; ++i) { const int q = tid + 512 * i, col = q >> 5, d4 = q & 31; const f32x4 v = *(const f32x4*)(Bsrc + (size_t)col * ldb + 4 * d4);
        LAS float* bp = Bs + col * 129 + 4 * d4; bp[0] = v[0]; bp[1] = v[1]; bp[2] = v[2]; bp[3] = v[3]; }
    __syncthreads();
    const int tk = tid & 31, tc = tid >> 5;
    float a0[4] = {0.f, 0.f, 0.f, 0.f}, a1[4] = {0.f, 0.f, 0.f, 0.f};
#pragma unroll 8
    for (int d = 0; d < 128; ++d) { const f32x4 a = *(const LAS f32x4*)(As + d * 64 + 4 * tc); const float b0 = Bs[tk * 129 + d], b1 = Bs[(tk + 32) * 129 + d];
#pragma unroll
        for (int i = 0; i < 4; ++i) { a0[i] += a[i] * b0; a1[i] += a[i] * b1; } }
#pragma unroll
    for (int i = 0; i < 4; ++i) { f16* op = out + (size_t)(4 * tc + i) * ldo + tk; op[0] = (f16)(a0[i] * scale); op[32] = (f16)(a1[i] * scale); }
    __syncthreads();
}
__device__ __forceinline__ void p0_phase(const Ptrs& P, int l, LAS unsigned char* lds, int tid, int lane, int wave, int G, int bx) {
    __syncthreads();
    unsigned char* wsw = P.ws + WS_W;
    signed char* Winq = (signed char*)(wsw + WO_INQ); f16* Winf_t = (f16*)(wsw + WO_INF); signed char* Wguq = (signed char*)(wsw + WO_GU);
    float* sw_in = (float*)(P.ws + WS_SCL) + 16384; float* sw_gu = (float*)(P.ws + WS_SCL) + 32768; f16* Wdown_t = (f16*)(wsw + WO_DOWN); f16* Wout_t = (f16*)(wsw + WO_OUT); f16* Waup_t = (f16*)(wsw + WO_AUP); f16* Wbup_t = (f16*)(wsw + WO_BUP);
    const float* w_in = P.w_in + (size_t)l * D * N_IN_SRC; const float* w_uk = P.w_uk + (size_t)l * 8 * 128 * 256; const float* w_uv = P.w_uv + (size_t)l * 8 * 256 * 128;
    const float* w_a_up = P.w_a_up + (size_t)l * 1024 * D; const float* w_b_up = P.w_b_up + (size_t)l * 512 * D; const float* w_out = P.w_out + (size_t)l * D * D;
    const float* w_g = P.w_ff_gate + (size_t)l * D * DFF; const float* w_u = P.w_ff_up + (size_t)l * D * DFF; const float* w_d = P.w_ff_down + (size_t)l * DFF * D;
    if (l == 0 && bx < 192) {
        LAS float* sc = (LAS float*)lds; LAS float* red = (LAS float*)(lds + 32768);
        for (int i = tid; i < NB * D; i += 512) { const float v = P.c[i]; sc[i] = v / (1.0f + __expf(-v)); }
        __syncthreads();
        float* mod = (float*)(P.ws + WS_MOD);
        for (int it = bx; it < 192; it += G) {
            const int ll = it / 96, col0 = (it % 96) * 128;
            const float* wsrc = P.w_ada + (size_t)ll * D * 12288 + col0 + 2 * lane;
            float a[4][2] = {{0.f, 0.f}, {0.f, 0.f}, {0.f, 0.f}, {0.f, 0.f}};
#pragma unroll 8
            for (int kk = 0; kk < 256; ++kk) { const int k = wave * 256 + kk; const f32x2 wv = *(const f32x2*)(wsrc + (size_t)k * 12288);
#pragma unroll
                for (int b = 0; b < 4; ++b) { const float s = sc[b * D + k]; a[b][0] += s * wv.x; a[b][1] += s * wv.y; } }
#pragma unroll
            for (int b = 0; b < 4; ++b) { red[(wave * 4 + b) * 128 + 2 * lane] = a[b][0]; red[(wave * 4 + b) * 128 + 2 * lane + 1] = a[b][1]; }
            __syncthreads();
            { const int b = tid >> 7, col = tid & 127; float s = 0.f;
#pragma unroll
              for (int w = 0; w < 8; ++w) s += red[(w * 4 + b) * 128 + col];
              mod[(size_t)(ll * 4 + b) * 12288 + col0 + col] = s + P.b_ada[(size_t)ll * 12288 + col0 + col]; }
            __syncthreads();
        }
    }
    for (int it = bx; it < 2048; it += G) {
        const int idx = it & 1023, h = idx >> 7, rem = idx & 127;
        if (it < 1024) { const int c0 = (rem >> 5) * 64, k0 = (rem & 31) * 64;
            minigemm_tile(w_uk + (size_t)(h * 128) * 256 + c0, 256, w_in + (size_t)k0 * N_IN_SRC + h * 128, N_IN_SRC, Winf_t + (size_t)(h * 256 + c0) * D + k0, D, 0.08838834764831845f, lds, tid); }
        else { const int n0 = (rem >> 2) * 64, c0 = (rem & 3) * 64;
            minigemm_tile(w_a_up + (size_t)(h * 128) * D + n0, D, w_uv + (size_t)(h * 256 + c0) * 128, 128, Waup_t + (size_t)n0 * D + h * 256 + c0, D, 1.0f, lds, tid); }
    }
    LAS float* scr = (LAS float*)(lds + wave * 16384);
    const int gw = bx * NWAVES + wave, NGW = G * NWAVES;
    constexpr int Q_CKV = 16, Q_QKV = 288, Q_GATES = 256, Q_FF = 352, NQITEMS = Q_CKV + Q_QKV + Q_GATES + 2 * Q_FF;
    for (int it = gw; it < NQITEMS; it += NGW) {
        int r = it;
        if (r < Q_CKV) { quant_item(w_in, N_IN_SRC, D, 1024 + 16 * r, Winq, 16 * r, sw_in, scr, lane); continue; } r -= Q_CKV;
        if (r < Q_QKV) { quant_item(w_in, N_IN_SRC, D, 2384 + 16 * r, Winq, 256 + 16 * r, sw_in, scr, lane); continue; } r -= Q_QKV;
        if (r < Q_GATES) { quant_item(w_in, N_IN_SRC, D, 6992 + 16 * r, Winq, 4864 + 16 * r, sw_in, scr, lane); continue; } r -= Q_GATES;
        if (r < Q_FF) { const int j0 = 16 * r; quant_item(w_g, DFF, D, j0, Wguq, 256 * (j0 >> 7) + (j0 & 127), sw_gu, scr, lane); continue; } r -= Q_FF;
        { const int j0 = 16 * r; quant_item(w_u, DFF, D, j0, Wguq, 256 * (j0 >> 7) + 128 + (j0 & 127), sw_gu, scr, lane); }
    }
    constexpr int I_IDX = 32 * 35, I_B = 8 * 64, I_O = 32 * 64, I_D = 88 * 64;
    constexpr int NITEMS = I_IDX + I_B + I_O + I_D;
    const int t0 = NGW > NQITEMS + 256 ? gw - NQITEMS : gw, tstep = NGW > NQITEMS + 256 ? NGW - NQITEMS : NGW;
    for (int it = t0; it >= 0 && it < NITEMS; it += tstep) {
        int r = it;
        if (r < I_IDX) { const int kb = r / 35, nb = r % 35, n0 = 1280 + 32 * nb; const int nv = (2384 - n0) < 32 ? (2384 - n0) : 32; transpose_item<0>(w_in, N_IN_SRC, 64 * kb, n0, nv, Winf_t, D, scr, lane); continue; } r -= I_IDX;
        if (r < I_B) { transpose_item<1>(w_b_up, D, 64 * (r / 64), 32 * (r % 64), 32, Wbup_t, 512, scr, lane); continue; } r -= I_B;
        if (r < I_O) { transpose_item<1>(w_out, D, 64 * (r / 64), 32 * (r % 64), 32, Wout_t, D, scr, lane); continue; } r -= I_O;
        transpose_item<1>(w_d, D, 64 * (r / 64), 32 * (r % 64), 32, Wdown_t, DFF, scr, lane);
    }
    const int gt = bx * 512 + tid, NGT = G * 512;
    { u32x4* pz = (u32x4*)(Winf_t + (size_t)3152 * D); for (int i = gt; i < 176 * D / 8; i += NGT) pz[i] = (u32x4){0u, 0u, 0u, 0u}; }
    if (l == 0) {
        f32x2* rope = (f32x2*)(P.ws + WS_ROPE);
        for (int e = gt; e < SEQ * 16; e += NGT) {
            const int pos = e >> 4, j = e & 15, a = j >> 2, b = j & 3;
            const double fa = a == 0 ? 1.0 : a == 1 ? 0.1 : a == 2 ? 0.01 : 0.001;
            const double fb = b == 0 ? 1.0 : b == 1 ? 0.5623413251903491 : b == 2 ? 0.31622776601683794 : 0.1778279410038923;
            const double ang = (double)pos * (fa * fb);
            const double q = __builtin_rint(ang * 0.15915494309189535);
            const double rr = __builtin_fma(-q, 2.4492935982947064e-16, __builtin_fma(-q, 6.283185307179586, ang));
            const float rf = (float)rr;
            rope[e] = (f32x2){cosf(rf), sinf(rf)};
        }
        unsigned char* lut = P.ws + WS_LUT;
        for (int n = gt; n < SEQ; n += NGT) lut[n] = (unsigned char)rel_bucket_of(n);
    }
}

template <bool F16OUT> __device__ __forceinline__ void norm_mod_phase(const float* x, const float* g, const float* shift, const float* scale, f16* out, signed char* out8, float* rs, int lane, int wave, int G, int bx) {
    const int gw = bx * NWAVES + wave, NGW = G * NWAVES;
    for (int blk = gw; blk < M / 8; blk += NGW) {
        const int row0 = blk * 8, b = row0 >> 12;
        f32x4 ca[8], cs[8];
#pragma unroll
        for (int j = 0; j < 8; ++j) { const int col = 4 * lane + 256 * j; const f32x4 gg = *(const f32x4*)(g + col), sc = *(const f32x4*)(scale + (size_t)b * 12288 + col); ca[j] = gg * (sc + 1.0f); cs[j] = *(const f32x4*)(shift + (size_t)b * 12288 + col); }
        for (int r = 0; r < 8; ++r) {
            const float* xr = x + (size_t)(row0 + r) * D + 4 * lane; f32x4 v[8]; float ss = 0.f;
#pragma unroll
            for (int j = 0; j < 8; ++j) { v[j] = *(const f32x4*)(xr + 256 * j); ss += (v[j].x * v[j].x + v[j].y * v[j].y) + (v[j].z * v[j].z + v[j].w * v[j].w); }
            const float rstd = 1.0f / sqrtf(wave_sum(ss) * (1.0f / D) + NORM_EPS);
            f16* orow = out + (size_t)(row0 + r) * D + 4 * lane; float mx = 0.f;
#pragma unroll
            for (int j = 0; j < 8; ++j) { const f32x4 o = v[j] * rstd * ca[j] + cs[j]; v[j] = o; mx = fmaxf(fmaxf(mx, fmaxf(__builtin_fabsf(o.x), __builtin_fabsf(o.y))), fmaxf(__builtin_fabsf(o.z), __builtin_fabsf(o.w)));
                if (F16OUT) { u32x2 w; w.x = pkh(o.x, o.y); w.y = pkh(o.z, o.w); *(u32x2*)(orow + 256 * j) = w; } }
#pragma unroll
            for (int o = 1; o < 64; o <<= 1) mx = fmaxf(mx, __shfl_xor(mx, o));
            const float inv = mx > 0.f ? 127.0f / mx : 0.f;
            if (lane == 0) rs[row0 + r] = mx > 0.f ? mx * (1.0f / 127.0f) : 1.0f;
            signed char* qrow = out8 + (size_t)(row0 + r) * D + 4 * lane;
#pragma unroll
            for (int j = 0; j < 8; ++j) *(unsigned*)(qrow + 256 * j) = pkq4(v[j].x * inv, v[j].y * inv, v[j].z * inv, v[j].w * inv);
        }
    }
}
__device__ __forceinline__ void final_norm_phase(float* xo, const float* g, int lane, int wave, int G, int bx) {
    const int gw = bx * NWAVES + wave, NGW = G * NWAVES;
    f32x4 cg[8];
#pragma unroll
    for (int j = 0; j < 8; ++j) cg[j] = *(const f32x4*)(g + 4 * lane + 256 * j);
    for (int row = gw; row < M; row += NGW) {
        float* xr = xo + (size_t)row * D + 4 * lane; f32x4 v[8]; float ss = 0.f;
#pragma unroll
        for (int j = 0; j < 8; ++j) { v[j] = *(const f32x4*)(xr + 256 * j); ss += (v[j].x * v[j].x + v[j].y * v[j].y) + (v[j].z * v[j].z + v[j].w * v[j].w); }
        const float rstd = 1.0f / sqrtf(wave_sum(ss) * (1.0f / D) + NORM_EPS);
#pragma unroll
        for (int j = 0; j < 8; ++j) *(f32x4*)(xr + 256 * j) = v[j] * rstd * cg[j];
    }
}

__device__ __forceinline__ void zfix_phase(f16* zA, const float* kvg, const float* lng, const float* lnb, const f32x2* rope, int lane, int wave, int G, int bx) {
    const int gw = bx * NWAVES + wave, NGW = G * NWAVES;
    const f32x4 g4 = *(const f32x4*)(kvg + 4 * lane); const float lg = lng[lane], lb = lnb[lane];
    for (int blk = gw; blk < M / 8; blk += NGW)
        for (int r = 0; r < 8; ++r) {
            const int row = blk * 8 + r, pos = row & (SEQ - 1); f16* z = zA + (size_t)row * NZA;
            { const u32x2 w = *(const u32x2*)(z + ZA_CKV + 4 * lane); const f32x2 a = unpk(w.x), b = unpk(w.y);
              const float ss = wave_sum((a.x * a.x + a.y * a.y) + (b.x * b.x + b.y * b.y)); const float rstd = 1.0f / sqrtf(ss * (1.0f / 256.0f) + NORM_EPS);
              u32x2 o; o.x = pkh(a.x * rstd * g4.x, a.y * rstd * g4.y); o.y = pkh(b.x * rstd * g4.z, b.y * rstd * g4.w); *(u32x2*)(z + ZA_CKV + 4 * lane) = o; }
            { const u32x4 w0 = *(const u32x4*)(z + ZA_QI + 16 * lane), w1 = *(const u32x4*)(z + ZA_QI + 16 * lane + 8);
              const unsigned mine[8] = {w0.x, w0.y, w0.z, w0.w, w1.x, w1.y, w1.z, w1.w}; unsigned res[8]; const int seg = lane & 3;
#pragma unroll
              for (int i = 0; i < 8; ++i) { const unsigned oth = (unsigned)__shfl_xor((int)mine[i], 1); const f32x2 me = unpk(mine[i]), ot = unpk(oth);
                  const f32x2 cs0 = rope[pos * 16 + 2 * i], cs1 = rope[pos * 16 + 2 * i + 1];
                  float r0, r1;
                  if (seg == 0) { r0 = me.x * cs0.x - ot.x * cs0.y; r1 = me.y * cs1.x - ot.y * cs1.y; }
                  else          { r0 = ot.x * cs0.y + me.x * cs0.x; r1 = ot.y * cs1.y + me.y * cs1.x; }
                  res[i] = seg < 2 ? pkh(r0, r1) : mine[i]; }
              *(u32x4*)(z + ZA_QI + 16 * lane) = (u32x4){res[0], res[1], res[2], res[3]}; *(u32x4*)(z + ZA_QI + 16 * lane + 8) = (u32x4){res[4], res[5], res[6], res[7]}; }
            { const float xv = (float)z[ZA_KI + lane]; const float mu = wave_sum(xv) * (1.0f / 64.0f); const float dv = xv - mu; const float var = wave_sum(dv * dv) * (1.0f / 64.0f);
              const float y = dv * (1.0f / sqrtf(var + NORM_EPS)) * lg + lb; const float oth = __shfl_xor(y, 16); const f32x2 cs = rope[pos * 16 + (lane & 15)];
              float o = y; if (lane < 16) o = y * cs.x - oth * cs.y; else if (lane < 32) o = oth * cs.y + y * cs.x;
              z[ZA_KI + lane] = (f16)o; }
        }
}

__device__ __forceinline__ void battn_phase(const f16* zB, const float* rel_bias, const unsigned char* lut, f16* ob, float* lse, LAS unsigned char* lds, int tid, int lane, int wave, int G, int bx) {
    LAS unsigned char* Kimg = lds; LAS unsigned char* Vimg = lds + 65536; LAS float* tb = (LAS float*)(lds + SMALL_OFF);
    const int g4 = lane >> 4, q15 = lane & 15;
    for (int uid = bx; uid < NB * 3 * 4 * 32; uid += G) {
        const int s = uid & 31, j = (uid >> 5) & 3, grp = (uid >> 7) % 3, b = uid / 384;
        const int dsh = 2 * grp, r = s & ((1 << dsh) - 1), n = s >> dsh;
        const f16* zb = zB + (size_t)b * SEQ * NZB; const int colQ = (grp * 4 + j) * 128, colK = ((3 + grp) * 4 + j) * 128, colV = ((6 + grp) * 4 + j) * 128;
#pragma unroll
        for (int i = 0; i < 8; ++i) { const int cidx = tid + 512 * i, u = cidx >> 4, ch = cidx & 15, mk = (n - 1) * 128 + u;
            u32x4 kv = {0u, 0u, 0u, 0u}, vv = {0u, 0u, 0u, 0u};
            if (mk >= 0) { const f16* rp = zb + (size_t)((mk << dsh) + r) * NZB + ch * 8; kv = *(const u32x4*)(rp + colK); vv = *(const u32x4*)(rp + colV); }
            *(LAS u32x4*)(Kimg + off_b(u, ch)) = kv; *(LAS u32x4*)(Vimg + off_b(u, ch)) = vv; }
        if (tid <= 128) tb[tid] = rel_bias[(int)lut[tid << dsh] * 20 + 8 + grp * 4 + j];
        __syncthreads();
        const int iq = 16 * wave + q15, tq = ((n * 128 + iq) << dsh) + r;
        const f16* qp = zb + (size_t)tq * NZB + colQ + 8 * g4;
        f16x8 qf[4];
#pragma unroll
        for (int k = 0; k < 4; ++k) qf[k] = *(const f16x8*)(qp + 32 * k);
        const int kstart = 32 * (wave >> 1);
        const int back0 = iq + 128 - (kstart + 8 * g4); const unsigned bmax = n > 0 ? 128u : (unsigned)iq;
        f32x4 sreg[5][2]; float mx = NEG_INF;
#pragma unroll
        for (int T = 0; T < 5; ++T)
#pragma unroll
            for (int hf = 0; hf < 2; ++hf) {
                const int krow = kstart + 32 * T + 8 * (q15 >> 2) + 4 * hf + (q15 & 3);
                f32x4 acc = {0.f, 0.f, 0.f, 0.f};
#pragma unroll
                for (int k = 0; k < 4; ++k) { const f16x8 kf = *(const LAS f16x8*)(Kimg + off_b(krow, 4 * k + g4)); acc = __builtin_amdgcn_mfma_f32_16x16x32_f16(kf, qf[k], acc, 0, 0, 0); }
#pragma unroll
                for (int e = 0; e < 4; ++e) { const unsigned back = (unsigned)(back0 - (32 * T + 4 * hf + e));
                    const bool valid = back <= bmax; const unsigned bi = back < 128u ? back : 128u;
                    const float sv = valid ? acc[e] * 0.08838834764831845f + tb[bi] : NEG_INF; acc[e] = sv; mx = fmaxf(mx, sv); }
                sreg[T][hf] = acc; }
        mx = fmaxf(mx, __shfl_xor(mx, 16)); mx = fmaxf(mx, __shfl_xor(mx, 32));
        float den = 0.f; f16x8 pf[5];
#pragma unroll
        for (int T = 0; T < 5; ++T) { float p[8];
#pragma unroll
            for (int e = 0; e < 8; ++e) { p[e] = __expf(sreg[T][e >> 2][e & 3] - mx); den += p[e]; }
            const u32x4 w = pkh8((f32x4){p[0], p[1], p[2], p[3]}, (f32x4){p[4], p[5], p[6], p[7]}); pf[T] = __builtin_bit_cast(f16x8, w); }
        den += __shfl_xor(den, 16); den += __shfl_xor(den, 32);
        const float rden = 1.0f / den;
        f16* op = ob + ((size_t)grp * M + (size_t)b * SEQ + tq) * 512 + j * 128 + 4 * g4;
        const unsigned trq = (unsigned)(q15 >> 2), trp = (unsigned)(lane & 3);
#pragma unroll
        for (int c = 0; c < 8; ++c) { f32x4 acc = {0.f, 0.f, 0.f, 0.f};
#pragma unroll
            for (int T = 0; T < 5; ++T) {
                const unsigned r0 = (unsigned)(kstart + 32 * T + 8 * g4) + trq;
                const s16x4 t0 = __builtin_amdgcn_ds_read_tr16_b64_v4i16((LAS s16x4*)(Vimg + off_b(r0, 2 * c + (trp >> 1)) + 8 * (trp & 1)));
                const s16x4 t1 = __builtin_amdgcn_ds_read_tr16_b64_v4i16((LAS s16x4*)(Vimg + off_b(r0 + 4, 2 * c + (trp >> 1)) + 8 * (trp & 1)));
                const f16x8 vf = __builtin_bit_cast(f16x8, __builtin_shufflevector(t0, t1, 0, 1, 2, 3, 4, 5, 6, 7));
                acc = __builtin_amdgcn_mfma_f32_16x16x32_f16(vf, pf[T], acc, 0, 0, 0); }
            u32x2 w; w.x = pkh(acc[0] * rden, acc[1] * rden); w.y = pkh(acc[2] * rden, acc[3] * rden); *(u32x2*)(op + 16 * c) = w; }
        if (lane < 16) lse[((size_t)grp * M + (size_t)b * SEQ + tq) * 4 + j] = mx + __logf(den);
        __syncthreads();
    }
}

__device__ __forceinline__ void score_phase(const f16* zA, float* S, int lane, int wave, int G, int bx) {
    const int wq = wave & 3, wk = wave >> 2, l31 = lane & 31, lh = lane >> 5;
    for (int uid = bx; uid < NB * 272; uid += G) {
        const int b = uid / 272; int rem = uid % 272, qb = 0;
        for (;;) { const int cnt = (qb + 2) >> 1; if (rem < cnt) break; rem -= cnt; ++qb; }
        const int kb = 2 * rem + wk;
        if (kb > qb) continue;
        const f16* zb = zA + (size_t)b * SEQ * NZA;
        const int t = qb * 128 + 32 * wq + l31; const f16* zq = zb + (size_t)t * NZA;
        f16x8 kf[4][4];
#pragma unroll
        for (int tl = 0; tl < 4; ++tl) { const f16* kp = zb + (size_t)(kb * 128 + 32 * tl + l31) * NZA + ZA_KI + 8 * lh;
#pragma unroll
            for (int k = 0; k < 4; ++k) kf[tl][k] = *(const f16x8*)(kp + 16 * k); }
        f32x16 sc[4];
#pragma unroll
        for (int tl = 0; tl < 4; ++tl)
#pragma unroll
            for (int e = 0; e < 16; ++e) sc[tl][e] = 0.f;
#pragma nounroll
        for (int hd = 0; hd < 16; ++hd) {
            f16x8 qf[4];
#pragma unroll
            for (int k = 0; k < 4; ++k) qf[k] = *(const f16x8*)(zq + ZA_QI + hd * 64 + 16 * k + 8 * lh);
            const float wh = (float)zq[ZA_WI + hd];
#pragma unroll
            for (int pr = 0; pr < 2; ++pr) {
                f32x16 a0, a1;
#pragma unroll
                for (int e = 0; e < 16; ++e) { a0[e] = 0.f; a1[e] = 0.f; }
#pragma unroll
                for (int k = 0; k < 4; ++k) { a0 = __builtin_amdgcn_mfma_f32_32x32x16_f16(kf[2 * pr][k], qf[k], a0, 0, 0, 0); a1 = __builtin_amdgcn_mfma_f32_32x32x16_f16(kf[2 * pr + 1][k], qf[k], a1, 0, 0, 0); }
#pragma unroll
                for (int e = 0; e < 16; ++e) { sc[2 * pr][e] += wh * fmaxf(a0[e], 0.f); sc[2 * pr + 1][e] += wh * fmaxf(a1[e], 0.f); }
            }
        }
        float* sp = S + (size_t)b * SC_BATCH + (size_t)16384 * (qb * (qb + 1) / 2) + (size_t)(32 * wq + l31) * ((qb + 1) * 128) + kb * 128 + 4 * lh;
#pragma unroll
        for (int tl = 0; tl < 4; ++tl)
#pragma unroll
            for (int a = 0; a < 4; ++a) *(f32x4*)(sp + 32 * tl + 8 * a) = (f32x4){sc[tl][4 * a], sc[tl][4 * a + 1], sc[tl][4 * a + 2], sc[tl][4 * a + 3]};
    }
}

__device__ __forceinline__ unsigned ord_key(float x) { const unsigned u = __builtin_bit_cast(unsigned, x); return u ^ ((unsigned)((int)u >> 31) | 0x80000000u); }
__device__ __forceinline__ int wave_total(int v) {
    v += __builtin_amdgcn_update_dpp(0, v, 0x111, 0xf, 0xf, true);
    v += __builtin_amdgcn_update_dpp(0, v, 0x112, 0xf, 0xf, true);
    v += __builtin_amdgcn_update_dpp(0, v, 0x114, 0xf, 0xf, true);
    v += __builtin_amdgcn_update_dpp(0, v, 0x118, 0xf, 0xf, true);
    v += __builtin_amdgcn_update_dpp(0, v, 0x142, 0xa, 0xf, true);
    v += __builtin_amdgcn_update_dpp(0, v, 0x143, 0xc, 0xf, true);
    return __builtin_amdgcn_readlane(v, 63);
}
template <int NCH> __device__ __forceinline__ void select_row(const float* src, int n, u16* orow, int lane) {
    unsigned key[4 * NCH];
#pragma unroll
    for (int j = 0; j < NCH; ++j) { const int base = 256 * j + 4 * lane; const f32x4 v = *(const f32x4*)(src + base);
#pragma unroll
        for (int e = 0; e < 4; ++e) key[4 * j + e] = ord_key(v[e]) & (unsigned)((base + e - n) >> 31); }
    unsigned tau = 0u;
    for (int bit = 31; bit >= 0; --bit) { const unsigned cand = tau | (1u << bit); int cnt = 0;
#pragma unroll
        for (int m = 0; m < 4 * NCH; ++m) cnt += (key[m] >= cand) ? 1 : 0;
        cnt = wave_total(cnt);
        if (cnt >= 256) { tau = cand; if (cnt == 256) break; } }
    int cgt = 0;
#pragma unroll
    for (int m = 0; m < 4 * NCH; ++m) cgt += (key[m] > tau) ? 1 : 0;
    cgt = wave_total(cgt);
    const int need = 256 - cgt; int og = 0, oe = 0;
    asm volatile("" : "+v"(tau));
#pragma unroll
    for (int m = 0; m < 4 * NCH; ++m) {
        const unsigned kidx = (unsigned)(256 * (m >> 2) + 4 * lane + (m & 3));
        const bool isg = key[m] > tau, ise = key[m] == tau;
        const unsigned long long bg = __ballot(isg), be = __ballot(ise);
        const unsigned lo_g = __builtin_amdgcn_mbcnt_hi((unsigned)(bg >> 32), __builtin_amdgcn_mbcnt_lo((unsigned)bg, 0u));
        const unsigned lo_e = __builtin_amdgcn_mbcnt_hi((unsigned)(be >> 32), __builtin_amdgcn_mbcnt_lo((unsigned)be, 0u));
        if (isg) orow[og + (int)lo_g] = (u16)kidx;
        else if (ise && (oe + (int)lo_e) < need) orow[cgt + oe + (int)lo_e] = (u16)kidx;
        og += __popcll(bg); oe += __popcll(be);
        __builtin_amdgcn_sched_barrier(0);
    }
}
__device__ __forceinline__ void select_phase(const float* S, u16* idx, int lane, int wave, int G, int bx) {
    const int gw = bx * NWAVES + wave, NGW = G * NWAVES;
    for (int pr = gw; pr < NB * (SEQ / 2); pr += NGW)
        for (int hh = 0; hh < 2; ++hh) {
            const int b = pr / (SEQ / 2), t0 = pr % (SEQ / 2), t = hh ? SEQ - 1 - t0 : t0, row = b * SEQ + t, qb = t >> 7, n = t + 1;
            u16* orow = idx + (size_t)row * 256;
            if (n <= 256) { u32x2 w; const int k = 4 * lane;
                w.x = (unsigned)(k < n ? k : 0xFFFF) | ((unsigned)(k + 1 < n ? k + 1 : 0xFFFF) << 16); w.y = (unsigned)(k + 2 < n ? k + 2 : 0xFFFF) | ((unsigned)(k + 3 < n ? k + 3 : 0xFFFF) << 16);
                *(u32x2*)(orow + k) = w; continue; }
            const float* src = S + (size_t)b * SC_BATCH + (size_t)16384 * (qb * (qb + 1) / 2) + (size_t)(t & 127) * ((qb + 1) * 128);
            const int nch = (n + 255) >> 8;
            if (nch <= 2) select_row<2>(src, n, orow, lane); else if (nch <= 4) select_row<4>(src, n, orow, lane); else if (nch <= 6) select_row<6>(src, n, orow, lane);
            else if (nch <= 8) select_row<8>(src, n, orow, lane); else if (nch <= 10) select_row<10>(src, n, orow, lane); else if (nch <= 12) select_row<12>(src, n, orow, lane);
            else if (nch <= 14) select_row<14>(src, n, orow, lane); else select_row<16>(src, n, orow, lane);
        }
}
__device__ __forceinline__ void bmerge_phase(const f16* ob, const float* lse, f16* yb, int lane, int wave, int G, int bx) {
    const int gw = bx * NWAVES + wave, NGW = G * NWAVES; const int js = lane >> 4, e0 = (lane & 15) * 8;
    for (int row = gw; row < M; row += NGW) {
        const float l0 = lse[((size_t)0 * M + row) * 4 + js], l1 = lse[((size_t)1 * M + row) * 4 + js], l2 = lse[((size_t)2 * M + row) * 4 + js];
        const float mx = fmaxf(l0, fmaxf(l1, l2)); float w0 = __expf(l0 - mx), w1 = __expf(l1 - mx), w2 = __expf(l2 - mx); const float inv = 1.0f / (w0 + w1 + w2); w0 *= inv; w1 *= inv; w2 *= inv;
        const size_t o = (size_t)row * 512 + js * 128 + e0;
        const u32x4 a = *(const u32x4*)(ob + o), bq = *(const u32x4*)(ob + (size_t)M * 512 + o), cq = *(const u32x4*)(ob + (size_t)2 * M * 512 + o);
        const unsigned aw[4] = {a.x, a.y, a.z, a.w}, bw[4] = {bq.x, bq.y, bq.z, bq.w}, cw[4] = {cq.x, cq.y, cq.z, cq.w}; unsigned rw[4];
#pragma unroll
        for (int i = 0; i < 4; ++i) { const f32x2 x0 = unpk(aw[i]), x1 = unpk(bw[i]), x2 = unpk(cw[i]); rw[i] = pkh(w0 * x0.x + w1 * x1.x + w2 * x2.x, w0 * x0.y + w1 * x1.y + w2 * x2.y); }
        *(u32x4*)(yb + o) = (u32x4){rw[0], rw[1], rw[2], rw[3]};
    }
}

__device__ __forceinline__ void dsa_phase(const f16* zA, const u16* idx, const float* rel_bias, const unsigned char* lut, f16* olat, LAS unsigned char* lds, int tid, int lane, int wave, int G, int bx) {
    LAS unsigned char* lutS = lds + SMALL_OFF; LAS float* biasS = (LAS float*)(lds + SMALL_OFF + 4096);
    for (int i = tid; i < SEQ / 4; i += 512) ((LAS unsigned*)lutS)[i] = ((const unsigned*)lut)[i];
    if (tid < 256) biasS[tid] = rel_bias[(tid >> 3) * 20 + (tid & 7)];
    __syncthreads();
    LAS unsigned char* kv = lds + wave * 16384;
    const int g4 = lane >> 4, head = lane & 15, hq = head & 7;
    const unsigned trq = (unsigned)(head >> 2), trp = (unsigned)(lane & 3);
    int tok0, tstride, ntok;
    if (G == 256) { const int bsel = (bx & 7) >> 1, wib = (((bx & 7) & 1) + 2 * (bx >> 3)) * NWAVES + wave; tok0 = bsel * SEQ + wib; tstride = 512; ntok = 8; }
    else { tok0 = bx * NWAVES + wave; tstride = G * NWAVES; ntok = (M - tok0 + tstride - 1) / tstride; }
    for (int it = 0; it < ntok; ++it) {
        const int row = tok0 + it * tstride, b = row >> 12, t = row & (SEQ - 1);
        const f16* zb = zA + (size_t)b * SEQ * NZA; const f16* zq = zb + (size_t)t * NZA;
        f16x8 qf[8];
#pragma unroll
        for (int s = 0; s < 8; ++s) { const u32x4 w = *(const u32x4*)(zq + hq * 256 + 32 * s + 8 * g4); qf[s] = head < 8 ? __builtin_bit_cast(f16x8, w) : (f16x8){0, 0, 0, 0, 0, 0, 0, 0}; }
        const int nvalid = t + 1 < 256 ? t + 1 : 256, nch = (nvalid + 31) >> 5;
        f32x4 oacc[16];
#pragma unroll
        for (int c = 0; c < 16; ++c) oacc[c] = (f32x4){0.f, 0.f, 0.f, 0.f};
        float mrun = NEG_INF, lrun = 0.f;
        const u16* irow = idx + (size_t)row * 256;
        for (int ch = 0; ch < nch; ++ch) {
            const u16x8 my8 = *(const u16x8*)(irow + 32 * ch + 8 * g4);
            const int idxr = (int)irow[32 * ch + (lane & 31)];
#pragma unroll
            for (int p = 0; p < 16; ++p) { const int rr = 2 * p + (lane >> 5); int ir = __shfl(idxr, rr); ir = ir == 0xFFFF ? 0 : ir;
                const u32x4 v = *(const u32x4*)(zb + (size_t)ir * NZA + ZA_CKV + 8 * (lane & 31));
                *(LAS u32x4*)(kv + ((lane & 31) >> 4) * 8192 + off_b((unsigned)rr, (unsigned)(lane & 15))) = v; }
            asm volatile("s_waitcnt lgkmcnt(0)" ::: "memory");
            f32x4 st[2];
#pragma unroll
            for (int hf = 0; hf < 2; ++hf) { const unsigned krow = 8u * (unsigned)(head >> 2) + 4u * hf + (unsigned)(head & 3); f32x4 acc = {0.f, 0.f, 0.f, 0.f};
#pragma unroll
                for (int s = 0; s < 8; ++s) { const f16x8 kf = *(const LAS f16x8*)(kv + (s >> 2) * 8192 + off_b(krow, 4u * (s & 3) + (unsigned)g4)); acc = __builtin_amdgcn_mfma_f32_16x16x32_f16(kf, qf[s], acc, 0, 0, 0); }
                st[hf] = acc; }
            float sv[8], cmax = NEG_INF;
#pragma unroll
            for (int e = 0; e < 8; ++e) { const int kidx = (int)my8[e]; const bool valid = kidx != 0xFFFF; const int dist = valid ? t - kidx : 0;
                const int bk = (int)lutS[dist]; const float s = valid ? st[e >> 2][e & 3] + biasS[bk * 8 + hq] : NEG_INF; sv[e] = s; cmax = fmaxf(cmax, s); }
            cmax = fmaxf(cmax, __shfl_xor(cmax, 16)); cmax = fmaxf(cmax, __shfl_xor(cmax, 32));
            const float mnew = fmaxf(mrun, cmax), alpha = __expf(mrun - mnew); float p[8], ps = 0.f;
#pragma unroll
            for (int e = 0; e < 8; ++e) { p[e] = __expf(sv[e] - mnew); ps += p[e]; }
            ps += __shfl_xor(ps, 16); ps += __shfl_xor(ps, 32);
            lrun = lrun * alpha + ps; mrun = mnew;
            const f16x8 pf = __builtin_bit_cast(f16x8, pkh8((f32x4){p[0], p[1], p[2], p[3]}, (f32x4){p[4], p[5], p[6], p[7]}));
#pragma unroll
            for (int ct = 0; ct < 16; ++ct) {
                const unsigned r0 = 8u * (unsigned)g4 + trq, cch = 2u * (ct & 7) + (trp >> 1);
                LAS unsigned char* img = kv + (ct >> 3) * 8192;
                const s16x4 t0 = __builtin_amdgcn_ds_read_tr16_b64_v4i16((LAS s16x4*)(img + off_b(r0, cch) + 8 * (trp & 1)));
                const s16x4 t1 = __builtin_amdgcn_ds_read_tr16_b64_v4i16((LAS s16x4*)(img + off_b(r0 + 4, cch) + 8 * (trp & 1)));
                const f16x8 vf = __builtin_bit_cast(f16x8, __builtin_shufflevector(t0, t1, 0, 1, 2, 3, 4, 5, 6, 7));
                oacc[ct] = __builtin_amdgcn_mfma_f32_16x16x32_f16(vf, pf, oacc[ct] * alpha, 0, 0, 0); }
            asm volatile("s_waitcnt lgkmcnt(0)" ::: "memory");
        }
        const float rl = 1.0f / lrun;
        if (head < 8) { f16* op = olat + (size_t)row * 2048 + head * 256 + 4 * g4;
#pragma unroll
            for (int ct = 0; ct < 16; ++ct) { u32x2 w; w.x = pkh(oacc[ct][0] * rl, oacc[ct][1] * rl); w.y = pkh(oacc[ct][2] * rl, oacc[ct][3] * rl); *(u32x2*)(op + 16 * ct) = w; } }
    }
}
#define XB_TMO      128
#define XB_XCNT(j)  (256  + 64 * (j))
#define XB_XSUB(j)  (1280 + 64 * (j))
#define XB_XGEN(j)  (2304 + 64 * (j))
#define XB_TOP      3328
#define XB_TOPGEN   3392
#define XCD_BAR_WORDS 3456
#define XB_SPIN_CAP (1u << 18)

__device__ __forceinline__ unsigned xb_ld(unsigned* p)              { return __hip_atomic_load(p, __ATOMIC_RELAXED, __HIP_MEMORY_SCOPE_AGENT); }
__device__ __forceinline__ unsigned xb_add(unsigned* p, unsigned v) { return __hip_atomic_fetch_add(p, v, __ATOMIC_RELAXED, __HIP_MEMORY_SCOPE_AGENT); }
__device__ __forceinline__ unsigned xb_xcc_id() { return (unsigned)__builtin_amdgcn_s_getreg((3 << 11) | 20) & 0xFu; }
#define XB_SPIN(cond, bar) do { unsigned _sp = 0; while (cond) { __builtin_amdgcn_s_sleep(1); \
    if ((++_sp & 255u) == 0u) { if (xb_ld(&(bar)[XB_TMO])) break; if (_sp > XB_SPIN_CAP) { atomicAdd(&(bar)[XB_TMO], 1u); break; } } } } while (0)

struct XcdBarrier {
    unsigned* bar; unsigned x;
    volatile LAS unsigned* st;
};

__device__ __forceinline__ XcdBarrier xcd_barrier_post(unsigned* bar, volatile LAS unsigned* st) {
    XcdBarrier b; b.bar = bar; b.x = xb_xcc_id(); b.st = st;
    if (threadIdx.x == 0) (void)xb_add(&bar[XB_XCNT(b.x)], 1u);
    return b;
}
__device__ __forceinline__ void xcd_barrier_complete(unsigned* bar, unsigned x, unsigned& nloc, unsigned& nx) {
    const unsigned G = gridDim.x * gridDim.y * gridDim.z;
    unsigned sum, cnt, mine, sp = 0u;
    for (;;) {
        sum = 0u; cnt = 0u; mine = 0u;
#pragma unroll
        for (unsigned j = 0; j < 16; ++j) { const unsigned c = xb_ld(&bar[XB_XCNT(j)]); sum += c; cnt += (c > 0u) ? 1u : 0u; mine = (j == x) ? c : mine; }
        if (sum == G) break;
        __builtin_amdgcn_s_sleep(1);
        if ((++sp & 255u) == 0u) { if (xb_ld(&bar[XB_TMO])) break; if (sp > XB_SPIN_CAP) { atomicAdd(&bar[XB_TMO], 1u); break; } }
    }
    nloc = mine > 0u ? mine : 1u; nx = cnt > 0u ? cnt : 1u;
}

__device__ __forceinline__ void xcd_barrier(const XcdBarrier& b) {
    asm volatile("s_waitcnt vmcnt(0)" ::: "memory");
    __syncthreads();
    if (threadIdx.x == 0) {
        unsigned* bar = b.bar;
        __builtin_amdgcn_s_waitcnt(0);
        unsigned nloc = b.st[0], nx = b.st[1];
        if (nloc == 0u) { xcd_barrier_complete(bar, b.x, nloc, nx); b.st[0] = nloc; b.st[1] = nx; }
        const unsigned old = xb_add(&bar[XB_XSUB(b.x)], 1u);
        const unsigned gen = old / nloc;
        if (old + 1u == (gen + 1u) * nloc) {
            __builtin_amdgcn_fence(__ATOMIC_RELEASE, "agent");
            asm volatile("s_waitcnt vmcnt(0)" ::: "memory");
            const unsigned og = xb_add(&bar[XB_TOP], 1u);
            const unsigned tg = og / nx;
            if (og + 1u == (tg + 1u) * nx) xb_add(&bar[XB_TOPGEN], 1u);
            else XB_SPIN(xb_ld(&bar[XB_TOPGEN]) == tg, bar);
            __builtin_amdgcn_fence(__ATOMIC_ACQUIRE, "agent");
            xb_add(&bar[XB_XGEN(b.x)], 1u);
            asm volatile("s_waitcnt vmcnt(0)" ::: "memory");
        } else {
            XB_SPIN(xb_ld(&bar[XB_XGEN(b.x)]) == gen, bar);
            __builtin_amdgcn_fence(__ATOMIC_ACQUIRE, "agent");
            asm volatile("s_waitcnt vmcnt(0)" ::: "memory");
        }
    }
    __syncthreads();
}

#ifndef MK_PER_PHASE
#define MK_PER_PHASE 0
#endif
constexpr int N_PHASES = 12 * DEPTH + 1;
struct Args { const float* in[20]; float* out; unsigned char* ws; int ph_lo, ph_hi; };
#ifndef REPMASK
#define REPMASK 0
#endif
#ifndef ONLY_PHASE
#define ONLY_PHASE -1
#endif
#define IN(k) ((ONLY_PHASE < 0 || ((k) == 12 * DEPTH ? 12 : (k) % 12) == ONLY_PHASE) && lo <= (k) && (k) < hi)
#define SEAM(k) do { if (IN(k) && IN((k) + 1)) { XcdBarrier bb = bar; asm volatile("" : "+s"(bb.bar), "+s"(bb.x)); xcd_barrier(bb); if ((REPMASK >> 12) & 1) xcd_barrier(bb); } } while (0)
#define CAS __attribute__((address_space(4)))
#define PH_IDS int tid = tid0; asm volatile("" : "+v"(tid)); const int lane = tid & 63, wave = __builtin_amdgcn_readfirstlane(tid >> 6); (void)lane; (void)wave; \
    int G = (int)gridDim.x, bx = (int)blockIdx.x; asm volatile("" : "+s"(G), "+s"(bx)); \
    const CAS Args* ap = (const CAS Args*)__builtin_amdgcn_kernarg_segment_ptr(); asm volatile("" : "+s"(ap)); unsigned char* ws = ap->ws
#define W_INQ ((const pg8::bf16_t*)(ws + WS_W + WO_INQ))
#define W_INF_T ((f16*)(ws + WS_W + WO_INF))
#define B_H8 ((signed char*)(ws + WS_H8))
#define B_RS ((float*)(ws + WS_SCL))
#define B_SWIN ((const float*)(ws + WS_SCL) + 16384)
#define B_SWGU ((const float*)(ws + WS_SCL) + 32768)
#define W_GUQ ((const pg8::bf16_t*)(ws + WS_W + WO_GU))
#define W_DOWN_T ((f16*)(ws + WS_W + WO_DOWN))
#define W_OUT_T ((f16*)(ws + WS_W + WO_OUT))
#define W_AUP_T ((f16*)(ws + WS_W + WO_AUP))
#define W_BUP_T ((f16*)(ws + WS_W + WO_BUP))
#define B_XA ((float*)(ws + WS_X))
#define B_H ((f16*)(ws + WS_H))
#define B_OB ((f16*)(ws + WS_H))
#define B_YB ((f16*)(ws + WS_H + 48 * MiB))
#define B_ZA ((f16*)(ws + WS_ZA))
#define B_ZB ((f16*)(ws + WS_ZB))
#define B_ZG ((f16*)(ws + WS_ZG))
#define B_SC ((float*)(ws + WS_ZB))
#define B_OLAT ((f16*)(ws + WS_ZB))
#define B_MERGED ((f16*)(ws + WS_ZB + 64 * MiB))
#define B_ACT ((f16*)(ws + WS_ZA))
#define B_LSE ((float*)(ws + WS_LSE))
#define B_IDX ((u16*)(ws + WS_IDX))
#define B_ROPE ((const f32x2*)(ws + WS_ROPE))
#define B_LUT ((const unsigned char*)(ws + WS_LUT))
#define B_MOD ((const float*)(ws + WS_MOD) + (size_t)l * NB * 12288)
#define X_IN (l == 0 ? ap->in[0] : (const float*)ap->out)
#ifndef REPMASK
#define REPMASK 0
#endif
#define RUN(k, ...) do { { PH_IDS; __VA_ARGS__ } if ((REPMASK >> (k)) & 1) { PH_IDS; __VA_ARGS__ } } while (0)
template <int l> __device__ __forceinline__ void layer_body(LAS unsigned char* lds, const int tid0, const int lo, const int hi, const XcdBarrier& bar) {
    const int pb = 12 * l;
    if (IN(pb + 0)) { RUN(0, Ptrs P;
        P.x = ap->in[0]; P.c = ap->in[1]; P.rel_bias = ap->in[2]; P.w_ada = ap->in[3]; P.b_ada = ap->in[4]; P.norm1_g = ap->in[5]; P.w_in = ap->in[6]; P.kv_norm_g = ap->in[7];
        P.idx_ln_g = ap->in[8]; P.idx_ln_b = ap->in[9]; P.w_uk = ap->in[10]; P.w_uv = ap->in[11]; P.w_a_up = ap->in[12]; P.w_b_up = ap->in[13]; P.w_out = ap->in[14]; P.norm2_g = ap->in[15];
        P.w_ff_gate = ap->in[16]; P.w_ff_up = ap->in[17]; P.w_ff_down = ap->in[18]; P.final_g = ap->in[19]; P.out = ap->out; P.ws = ws;
        p0_phase(P, l, lds, tid, lane, wave, G, bx);); SEAM(pb + 0); }
    if (IN(pb + 1)) { RUN(1, norm_mod_phase<true>(X_IN, ap->in[5] + (size_t)l * D, B_MOD, B_MOD + D, B_H, B_H8, B_RS, lane, wave, G, bx);); SEAM(pb + 1); }
    if (IN(pb + 2)) { RUN(2,
        { pg8::Gemm g{(const pg8::bf16_t*)B_H8, W_INQ, M, NQ, D / 2}; pg8::StaticOrder S; S.init(M, NQ, G, bx); pg8::EpiInQ E{B_ZA, B_ZB, B_ZG, B_RS, B_SWIN};
          pg8::gemm_phase<pg8::EpiInQ, pg8::StaticOrder, true, true, true>(lds, g, S, E); }
        __syncthreads();
        { int tb2 = tid; asm volatile("" : "+v"(tb2)); (void)tb2; pg8::Gemm g{B_H, W_INF_T, M, NF, D}; pg8::StaticOrder S; S.init(M, NF, G, G == 256 ? ((bx + 64) & 255) : bx);
          pg8::EpiInF E{B_ZA}; pg8::gemm_phase<pg8::EpiInF, pg8::StaticOrder, true, true, false>(lds, g, S, E); }
        __syncthreads();); SEAM(pb + 2); }
    if (IN(pb + 3)) { { PH_IDS; zfix_phase(B_ZA, ap->in[7] + (size_t)l * 256, ap->in[8] + (size_t)l * 64, ap->in[9] + (size_t)l * 64, B_ROPE, lane, wave, G, bx); }
        RUN(3, battn_phase(B_ZB, ap->in[2], B_LUT, B_OB, B_LSE, lds, tid, lane, wave, G, bx);); SEAM(pb + 3); }
    if (IN(pb + 4)) { RUN(4, score_phase(B_ZA, B_SC, lane, wave, G, bx);); SEAM(pb + 4); }
    if (IN(pb + 5)) { RUN(5, select_phase(B_SC, B_IDX, lane, wave, G, bx);); RUN(13, bmerge_phase(B_OB, B_LSE, B_YB, lane, wave, G, bx);); SEAM(pb + 5); }
    if (IN(pb + 6)) { RUN(6, dsa_phase(B_ZA, B_IDX, ap->in[2], B_LUT, B_OLAT, lds, tid, lane, wave, G, bx);); SEAM(pb + 6); }
    if (IN(pb + 7)) { RUN(7,
        { pg8::Gemm g{B_OLAT, W_AUP_T, M, D, D}; pg8::StaticOrder S; S.init(M, D, G, bx); pg8::EpiGate<0> E{B_ZG, B_MERGED};
          pg8::gemm_phase<pg8::EpiGate<0>, pg8::StaticOrder, true, true>(lds, g, S, E); }
        __syncthreads();
        { int tb2 = tid; asm volatile("" : "+v"(tb2)); (void)tb2; pg8::Gemm g{B_YB, W_BUP_T, M, D, 512}; pg8::StaticOrder S; S.init(M, D, G, bx); pg8::EpiGate<1> E{B_ZG, B_MERGED};
          pg8::gemm_phase<pg8::EpiGate<1>, pg8::StaticOrder, true, true>(lds, g, S, E); }
        __syncthreads();); SEAM(pb + 7); }
    if (IN(pb + 8)) { RUN(8, pg8::Gemm g{B_MERGED, W_OUT_T, M, D, D}; pg8::StaticOrder S; S.init(M, D, G, bx); pg8::EpiResid E{X_IN, B_XA, B_MOD + 2 * D};
        pg8::gemm_phase<pg8::EpiResid, pg8::StaticOrder, true, true>(lds, g, S, E);); SEAM(pb + 8); }
    if (IN(pb + 9)) { RUN(9, norm_mod_phase<false>(B_XA, ap->in[15] + (size_t)l * D, B_MOD + 3 * D, B_MOD + 4 * D, B_H, B_H8, B_RS, lane, wave, G, bx);); SEAM(pb + 9); }
    if (IN(pb + 10)) { RUN(10, pg8::Gemm g{(const pg8::bf16_t*)B_H8, W_GUQ, M, NGU, D / 2}; pg8::StaticOrder S; S.init(M, NGU, G, bx); pg8::EpiSwiGLU E{B_ACT, B_RS, B_SWGU};
        pg8::gemm_phase<pg8::EpiSwiGLU, pg8::StaticOrder, true, true, true>(lds, g, S, E);); SEAM(pb + 10); }
    if (IN(pb + 11)) { RUN(11, pg8::Gemm g{B_ACT, W_DOWN_T, M, D, DFF}; pg8::StaticOrder S; S.init(M, D, G, bx); pg8::EpiResid E{B_XA, ap->out, B_MOD + 5 * D};
        pg8::gemm_phase<pg8::EpiResid, pg8::StaticOrder, true, true>(lds, g, S, E);); SEAM(pb + 11); }
}
__global__ void __launch_bounds__(NWAVES * 64, 2) fwd(Args args) {
    extern __shared__ __attribute__((aligned(16))) unsigned char lds_raw[];
    LAS unsigned char* lds = (LAS unsigned char*)lds_raw;
    const int tid0 = threadIdx.x;
    for (int u = tid0; u < (LDS_BYTES - LDSCTL_OFF) / 4; u += NWAVES * 64) ((LAS unsigned*)(lds + LDSCTL_OFF))[u] = 0u;
    __syncthreads();
    const int lo = args.ph_lo, hi = args.ph_hi;
    XcdBarrier bar; bar.bar = (unsigned*)(args.ws + WS_CTL) + CW_BAR; bar.x = 0; bar.st = nullptr;
    if (hi - lo > 1) bar = xcd_barrier_post((unsigned*)(args.ws + WS_CTL) + CW_BAR, (volatile LAS unsigned*)(lds + MISC_OFF) + 8);
    layer_body<0>(lds, tid0, lo, hi, bar);
    layer_body<1>(lds, tid0, lo, hi, bar);
    if (IN(12 * DEPTH)) { PH_IDS; final_norm_phase(ap->out, ap->in[19], lane, wave, G, bx); }
#undef IN
#undef SEAM
}

extern "C" void kernel_launch(void* const* d_in, const int* in_sizes, int n_in, void* d_out, int out_size, void* d_ws, size_t ws_size, hipStream_t stream) {
    static int grid = 0;
    if (grid == 0) {
        if (n_in != 20 || in_sizes[0] != M * D || out_size != M * D || ws_size < WS_END) { fprintf(stderr, "kernel_launch: built for 20 inputs, x/out of %d floats, >= %zu bytes of workspace; got n_in %d, in0 %d, out %d, ws %zu; nothing launched\n", M * D, (size_t)WS_END, n_in, n_in > 0 ? in_sizes[0] : -1, out_size, ws_size); grid = -1; return; }
        int dev = 0, cus = 0, per_cu = 0;
        if (hipGetDevice(&dev) != hipSuccess || hipDeviceGetAttribute(&cus, hipDeviceAttributeMultiprocessorCount, dev) != hipSuccess) { fprintf(stderr, "kernel_launch: device query failed\n"); grid = -1; return; }
        if (hipFuncSetAttribute((const void*)fwd, hipFuncAttributeMaxDynamicSharedMemorySize, LDS_BYTES) != hipSuccess) { fprintf(stderr, "kernel_launch: hipFuncSetAttribute failed\n"); grid = -1; return; }
        if (hipOccupancyMaxActiveBlocksPerMultiprocessor(&per_cu, (const void*)fwd, NWAVES * 64, LDS_BYTES) != hipSuccess || per_cu < 1)
            fprintf(stderr, "kernel_launch: note: occupancy query reports %d workgroups per CU\n", per_cu);
        (void)hipGetLastError();
        grid = cus;
    }
    if (grid < 0) return;
    if (hipMemsetAsync((char*)d_ws + WS_CTL, 0, CTL_ZERO_BYTES, stream) != hipSuccess) { fprintf(stderr, "kernel_launch: memset failed\n"); return; }
    Args a{};
    for (int i = 0; i < 20; ++i) a.in[i] = (const float*)d_in[i];
    a.out = (float*)d_out; a.ws = (unsigned char*)d_ws;
#if MK_PER_PHASE
    for (int p = 0; p < N_PHASES; ++p) { a.ph_lo = p; a.ph_hi = p + 1; hipLaunchKernelGGL(fwd, dim3(grid), dim3(NWAVES * 64), LDS_BYTES, stream, a); }
#else
    a.ph_lo = 0; a.ph_hi = N_PHASES;
    hipLaunchKernelGGL(fwd, dim3(grid), dim3(NWAVES * 64), LDS_BYTES, stream, a);
#endif
    const hipError_t le = hipPeekAtLastError();
    if (le != hipSuccess) fprintf(stderr, "kernel_launch: launch failed: %s\n", hipGetErrorName(le));
}
```

```cpp
#include <hip/hip_runtime.h>
#include <cstdio>
#include <cstdint>

#define LAS __attribute__((address_space(3)))
#define GAS __attribute__((address_space(1)))
typedef _Float16 f16;
typedef _Float16 f16x2 __attribute__((ext_vector_type(2)));
typedef _Float16 f16x4 __attribute__((ext_vector_type(4)));
typedef _Float16 f16x8 __attribute__((ext_vector_type(8)));
typedef float f32x2 __attribute__((ext_vector_type(2)));
typedef float f32x4 __attribute__((ext_vector_type(4)));
typedef float f32x16 __attribute__((ext_vector_type(16)));
typedef unsigned u32x2 __attribute__((ext_vector_type(2)));
typedef unsigned u32x4 __attribute__((ext_vector_type(4)));
typedef short s16x4 __attribute__((ext_vector_type(4)));
typedef unsigned short u16x8 __attribute__((ext_vector_type(8)));
typedef unsigned short u16;

__device__ __forceinline__ unsigned pkh(float a, float b) { f32x2 v = {a, b}; return __builtin_bit_cast(unsigned, __builtin_convertvector(v, f16x2)); }
__device__ __forceinline__ u32x4 pkh8(f32x4 a, f32x4 b) { u32x4 w; w.x = pkh(a[0], a[1]); w.y = pkh(a[2], a[3]); w.z = pkh(b[0], b[1]); w.w = pkh(b[2], b[3]); return w; }
__device__ __forceinline__ f32x2 unpk(unsigned w) { return __builtin_convertvector(__builtin_bit_cast(f16x2, w), f32x2); }
__device__ __forceinline__ float sigm(float x) { return __builtin_amdgcn_rcpf(1.0f + __expf(-x)); }
__device__ __forceinline__ float wave_sum(float v) {
#pragma unroll
    for (int o = 1; o < 64; o <<= 1) v += __shfl_xor(v, o);
    return v;
}
namespace pg8 {
#define PG8_LAS __attribute__((address_space(3)))
typedef _Float16 bf16_t;
typedef _Float16 bf16x8 __attribute__((ext_vector_type(8)));
typedef float f32x4 __attribute__((ext_vector_type(4)));
typedef unsigned u32x4 __attribute__((ext_vector_type(4)));
constexpr int BM = 256, BK = 64, HALF = 128, HTB = HALF * BK * 2  , STAGE_BYTES = 8 * HTB, NXCD = 8, WGM = 8;

__host__ __device__ __forceinline__ int lds_byte(int r, int c) { const int st = (r >> 4) * 2 + (c >> 5), rr = r & 15, cc = c & 31, ob = rr * 64 + cc * 2; return st * 1024 + (ob ^ (((ob >> 9) & 1) << 5)); }
__host__ __device__ __forceinline__ void stage_rc(int b, int& R, int& C) { const int st = b / 1024, sb = b % 1024, swz = sb ^ (((sb >> 9) & 1) << 5); R = (st >> 1) * 16 + swz / 64; C = (st & 1) * 32 + (swz % 64) / 2; }
__host__ __device__ __forceinline__ int perm32(int rho) { const int n = rho >> 4, i = rho & 15; return 8 * (i >> 2) + 4 * n + (i & 3); }

struct Unit { int pm, pn; };
struct Gemm { const bf16_t* A; const bf16_t* Bt; int M, N, K; };
typedef int i32x4v __attribute__((ext_vector_type(4)));

struct StaticOrder {
    int nM, nN, nwg, G, c;
    __host__ __device__ void init(int M, int N, int G_, int c_) { nM = M / BM; nN = N / BM; nwg = nM * nN; G = G_; c = c_; }
    __host__ __device__ bool next(int i, Unit& u) const {
        const long L = (long)i * G + c; if (L >= nwg) return false;
        int wgid = (int)L; { const int q = nwg / NXCD, r = nwg % NXCD, xcd = wgid % NXCD, off = wgid / NXCD; wgid = (xcd < r ? xcd * (q + 1) : r * (q + 1) + (xcd - r) * q) + off; }
        const int nig = WGM * nN, gid = wgid / nig, fm = gid * WGM, gsz = (nM - fm) < WGM ? (nM - fm) : WGM;
        u.pm = fm + ((wgid % nig) % gsz); u.pn = (wgid % nig) / gsz; return true;
    }
    __device__ __forceinline__ void a_ready(const Unit&) const {}
    __device__ __forceinline__ void done(const Unit&) const {}
};

__device__ __forceinline__ f32x4 i2f4(f32x4 a) { const i32x4v v = __builtin_bit_cast(i32x4v, a); return (f32x4){(float)v[0], (float)v[1], (float)v[2], (float)v[3]}; }
struct EpiInQ {
    static constexpr bool PERM = true, AFTER_DRAIN = false;
    bf16_t *ckv, *zB, *zG; const float* rs; const float* cs;
    __device__ __forceinline__ void operator()(const f32x4 (&acc)[2][2][4][2], const Unit& u, int wr, int wc, int fr, int fq) const {
        const int row0 = u.pm * BM + wr * 64 + fr; bf16_t* base; int ld, colt; bool sg = false;
        if (u.pn < 1) { base = ckv; ld = 256; colt = 0; } else if (u.pn < 19) { base = zB; ld = 4608; colt = (u.pn - 1) * BM; } else { base = zG; ld = 4096; colt = (u.pn - 19) * BM; sg = true; }
        const int col0 = colt + wc * 32 + 8 * fq; const float* csp = cs + u.pn * BM + wc * 32 + 8 * fq;
        f32x4 cv[2][2];
#pragma unroll
        for (int bj = 0; bj < 2; ++bj)
#pragma unroll
            for (int n = 0; n < 2; ++n) cv[bj][n] = *(const f32x4*)(csp + bj * HALF + 4 * n);
#pragma unroll
        for (int ai = 0; ai < 2; ++ai)
#pragma unroll
            for (int m = 0; m < 4; ++m) { const int row = row0 + ai * HALF + m * 16; const float r = rs[row]; bf16_t* rowp = base + (size_t)row * ld + col0;
#pragma unroll
                for (int bj = 0; bj < 2; ++bj) { f32x4 v0 = i2f4(acc[ai][bj][m][0]) * cv[bj][0] * r, v1 = i2f4(acc[ai][bj][m][1]) * cv[bj][1] * r;
                    if (sg) {
#pragma unroll
                        for (int j = 0; j < 4; ++j) { v0[j] = sigm(v0[j]); v1[j] = sigm(v1[j]); } }
                    *(u32x4*)(rowp + bj * HALF) = pkh8(v0, v1); } }
    }
};
struct EpiInF {
    static constexpr bool PERM = true, AFTER_DRAIN = false;
    bf16_t *qlat, *qi, *kw;
    __device__ __forceinline__ void operator()(const f32x4 (&acc)[2][2][4][2], const Unit& u, int wr, int wc, int fr, int fq) const {
        bf16_t* base; int ld, colt;
        if (u.pn < 8) { base = qlat; ld = 2048; colt = u.pn * BM; } else if (u.pn < 12) { base = qi; ld = 1024; colt = (u.pn - 8) * BM; } else { base = kw; ld = 256; colt = 0; }
        const int row0 = u.pm * BM + wr * 64 + fr, col0 = colt + wc * 32 + 8 * fq;
#pragma unroll
        for (int ai = 0; ai < 2; ++ai)
#pragma unroll
            for (int m = 0; m < 4; ++m) { bf16_t* rowp = base + (size_t)(row0 + ai * HALF + m * 16) * ld + col0;
#pragma unroll
                for (int bj = 0; bj < 2; ++bj) *(u32x4*)(rowp + bj * HALF) = pkh8(acc[ai][bj][m][0], acc[ai][bj][m][1]); }
    }
};
template <int MODE> struct EpiGate {
    static constexpr bool PERM = true, AFTER_DRAIN = false;
    const bf16_t* zG; bf16_t* out;
    __device__ __forceinline__ void operator()(const f32x4 (&acc)[2][2][4][2], const Unit& u, int wr, int wc, int fr, int fq) const {
        const int row0 = u.pm * BM + wr * 64 + fr, col0 = u.pn * BM + wc * 32 + 8 * fq;
#pragma unroll
        for (int ai = 0; ai < 2; ++ai)
#pragma unroll
            for (int m = 0; m < 4; ++m) { const size_t row = (size_t)(row0 + ai * HALF + m * 16);
#pragma unroll
                for (int bj = 0; bj < 2; ++bj) {
                    const u32x4 gw = *(const u32x4*)(zG + row * 4096 + MODE * 2048 + col0 + bj * HALF);
                    const f32x2 g0 = unpk(gw.x), g1 = unpk(gw.y), g2 = unpk(gw.z), g3 = unpk(gw.w);
                    f32x4 v0 = acc[ai][bj][m][0] * (f32x4){g0.x, g0.y, g1.x, g1.y}, v1 = acc[ai][bj][m][1] * (f32x4){g2.x, g2.y, g3.x, g3.y};
                    bf16_t* op = out + row * 2048 + col0 + bj * HALF;
                    if (MODE == 1) { const u32x4 pw = *(const u32x4*)op; const f32x2 p0 = unpk(pw.x), p1 = unpk(pw.y), p2 = unpk(pw.z), p3 = unpk(pw.w);
                        v0 += (f32x4){p0.x, p0.y, p1.x, p1.y}; v1 += (f32x4){p2.x, p2.y, p3.x, p3.y}; }
                    *(u32x4*)op = pkh8(v0, v1);
                    asm volatile("" ::: "memory"); } }
    }
};
struct EpiResid {
    static constexpr bool PERM = false, AFTER_DRAIN = false;
    const float* xi; float* xo; const float* gate;
    __device__ __forceinline__ void operator()(const f32x4 (&acc)[2][2][4][2], const Unit& u, int wr, int wc, int fr, int fq) const {
        const int row0 = u.pm * BM + wr * 64 + fr, col0 = u.pn * BM + wc * 32 + 4 * fq; const float* gp = gate + (size_t)(u.pm >> 4) * 12288 + col0;
        f32x4 gv[2][2];
#pragma unroll
        for (int bj = 0; bj < 2; ++bj)
#pragma unroll
            for (int n = 0; n < 2; ++n) gv[bj][n] = *(const f32x4*)(gp + bj * HALF + n * 16);
#pragma unroll
        for (int ai = 0; ai < 2; ++ai)
#pragma unroll
            for (int m = 0; m < 4; ++m) { const size_t off = (size_t)(row0 + ai * HALF + m * 16) * 2048 + col0;
#pragma unroll
                for (int bj = 0; bj < 2; ++bj)
#pragma unroll
                    for (int n = 0; n < 2; ++n) *(f32x4*)(xo + off + bj * HALF + n * 16) = *(const f32x4*)(xi + off + bj * HALF + n * 16) + gv[bj][n] * acc[ai][bj][m][n];
                asm volatile("" ::: "memory"); }
    }
};
struct EpiSwiGLU {
    static constexpr bool PERM = true, AFTER_DRAIN = false;
    bf16_t* act; const float* rs; const float* cs;
    __device__ __forceinline__ void operator()(const f32x4 (&acc)[2][2][4][2], const Unit& u, int wr, int wc, int fr, int fq) const {
        const int row0 = u.pm * BM + wr * 64 + fr, col0 = u.pn * HALF + wc * 32 + 8 * fq; const float* csp = cs + u.pn * BM + wc * 32 + 8 * fq;
        f32x4 cv[2][2];
#pragma unroll
        for (int bj = 0; bj < 2; ++bj)
#pragma unroll
            for (int n = 0; n < 2; ++n) cv[bj][n] = *(const f32x4*)(csp + bj * HALF + 4 * n);
#pragma unroll
        for (int ai = 0; ai < 2; ++ai)
#pragma unroll
            for (int m = 0; m < 4; ++m) { f32x4 o[2]; const int row = row0 + ai * HALF + m * 16; const float r = rs[row];
#pragma unroll
                for (int n = 0; n < 2; ++n) { const f32x4 g = i2f4(acc[ai][0][m][n]) * cv[0][n] * r, up = i2f4(acc[ai][1][m][n]) * cv[1][n] * r;
#pragma unroll
                    for (int j = 0; j < 4; ++j) o[n][j] = g[j] * sigm(g[j]) * up[j]; }
                *(u32x4*)(act + (size_t)row * 5632 + col0) = pkh8(o[0], o[1]); }
    }
};
template <class Epi, class Sched, bool ALIGN_EPI = false, bool SP2 = false, bool I8 = false>
__device__ __forceinline__ void gemm_phase(PG8_LAS unsigned char* lds, const Gemm g, const Sched& S, const Epi& E) {
    int tid_ = threadIdx.x; asm volatile("" : "+v"(tid_));
    const int tid = tid_, wid = __builtin_amdgcn_readfirstlane(tid >> 6), lane = tid & 63, wr = wid >> 2, wc = wid & 3, fr = lane & 15, fq = lane >> 4;
    const int K = g.K, nt = K / BK;
    unsigned voffA[2], voffB[2];
#pragma unroll
    for (int i = 0; i < 2; ++i) { int R, C; stage_rc(tid * 16 + i * 8192, R, C); const int Rb = Epi::PERM ? ((R & ~31) + perm32(R & 31)) : R;
        voffA[i] = (unsigned)(R * K + C) * 2u; voffB[i] = (unsigned)(Rb * K + C) * 2u; }
    const size_t kstep = (size_t)(BK * 2);
    const size_t hstep = (size_t)HALF * K * 2;
    const size_t tstep = 2 * hstep;
    const unsigned ldsw = (unsigned)wid * 1024u;
    const int aoff = lds_byte(wr * 64 + fr, fq * 8), boff = lds_byte(wc * 32 + fr, fq * 8);
#define PG8_SA(b, h) (((b) * 2 + (h)) * HTB)
#define PG8_SB(b, h) ((4 + (b) * 2 + (h)) * HTB)
#define PG8_STAGE(bufoff, gbase, voff) do { _Pragma("unroll") for (int _i = 0; _i < 2; ++_i) \
        __builtin_amdgcn_global_load_lds((const unsigned*)((const char*)(gbase) + (voff)[_i]), (PG8_LAS unsigned*)(lds + (bufoff) + ldsw + _i * 8192), 16, 0, 0); } while (0)
#define PG8_LDA(dst, b, h) do { _Pragma("unroll") for (int m = 0; m < 4; ++m) _Pragma("unroll") for (int k = 0; k < 2; ++k) dst[m][k] = *(const PG8_LAS bf16x8*)(lds + PG8_SA(b, h) + aoff + m * 2048 + k * 1024); } while (0)
#define PG8_LDB(dst, b, h) do { _Pragma("unroll") for (int n = 0; n < 2; ++n) _Pragma("unroll") for (int k = 0; k < 2; ++k) dst[n][k] = *(const PG8_LAS bf16x8*)(lds + PG8_SB(b, h) + boff + n * 2048 + k * 1024); } while (0)
#define PG8_MMA(ai, bj, At, Bt) do { __builtin_amdgcn_s_setprio(1); _Pragma("unroll") for (int m = 0; m < 4; ++m) _Pragma("unroll") for (int n = 0; n < 2; ++n) _Pragma("unroll") for (int k = 0; k < 2; ++k) { \
        if constexpr (I8) acc[ai][bj][m][n] = __builtin_bit_cast(f32x4, __builtin_amdgcn_mfma_i32_16x16x64_i8(__builtin_bit_cast(i32x4v, Bt[n][k]), __builtin_bit_cast(i32x4v, At[m][k]), __builtin_bit_cast(i32x4v, acc[ai][bj][m][n]), 0, 0, 0)); \
        else acc[ai][bj][m][n] = __builtin_amdgcn_mfma_f32_16x16x32_f16(Bt[n][k], At[m][k], acc[ai][bj][m][n], 0, 0, 0); } __builtin_amdgcn_s_setprio(0); } while (0)
#define PG8_WAIT_V(n) asm volatile("s_waitcnt vmcnt(" #n ")" ::: "memory")
#define PG8_WAIT_L(n) asm volatile("s_waitcnt lgkmcnt(" #n ")" ::: "memory")
#define PG8_BAR __builtin_amdgcn_s_barrier()
#define PG8_SCHED __builtin_amdgcn_sched_barrier(0)
    Unit cur, nxt; int ui = 0;
    if (!S.next(0, cur)) return;
    f32x4 acc[2][2][4][2];
#pragma unroll
    for (int a = 0; a < 2; ++a)
#pragma unroll
        for (int b = 0; b < 2; ++b)
#pragma unroll
            for (int m = 0; m < 4; ++m)
#pragma unroll
                for (int n = 0; n < 2; ++n) acc[a][b][m][n] = (f32x4){0.f, 0.f, 0.f, 0.f};
    bf16x8 At[4][2], B0[2][2], B1[2][2];
    const char* cA = (const char*)g.A + (size_t)cur.pm * tstep; const char* cB = (const char*)g.Bt + (size_t)cur.pn * tstep;
    S.a_ready(cur);
    if constexpr (SP2) {
        PG8_STAGE(PG8_SB(0, 0), cB, voffB); PG8_STAGE(PG8_SB(0, 1), cB + hstep, voffB); PG8_STAGE(PG8_SA(0, 0), cA, voffA); PG8_STAGE(PG8_SA(0, 1), cA + hstep, voffA);
        if (wr == 1) PG8_BAR;
        PG8_WAIT_V(2); PG8_BAR;
        PG8_STAGE(PG8_SB(1, 0), cB + kstep, voffB); PG8_STAGE(PG8_SA(1, 0), cA + kstep, voffA); PG8_STAGE(PG8_SB(1, 1), cB + hstep + kstep, voffB);
        PG8_WAIT_V(6); PG8_BAR;
    } else {
        PG8_STAGE(PG8_SB(0, 0), cB, voffB); PG8_STAGE(PG8_SA(0, 0), cA, voffA); PG8_STAGE(PG8_SB(0, 1), cB + hstep, voffB); PG8_STAGE(PG8_SA(0, 1), cA + hstep, voffA);
        if (wr == 1) PG8_BAR;
        PG8_WAIT_V(4); PG8_BAR;
        PG8_STAGE(PG8_SB(1, 0), cB + kstep, voffB); PG8_STAGE(PG8_SA(1, 0), cA + kstep, voffA); PG8_STAGE(PG8_SB(1, 1), cB + hstep + kstep, voffB);
        PG8_WAIT_V(6); PG8_BAR;
    }
    for (;;) {
        const bool has_next = S.next(ui + 1, nxt);
        const char* nA = has_next ? (const char*)g.A + (size_t)nxt.pm * tstep : cA; const char* nB = has_next ? (const char*)g.Bt + (size_t)nxt.pn * tstep : cB;
        for (int t = 0; t < nt; t += 2) {
            const bool last = (t == nt - 2);
            const char* a1 = cA + (size_t)(t + 1) * kstep;
            const char* a2 = last ? nA : cA + (size_t)(t + 2) * kstep; const char* b2 = last ? nB : cB + (size_t)(t + 2) * kstep;
            const char* a3 = a2 + kstep; const char* b3 = b2 + kstep;
            if (last && has_next) S.a_ready(nxt);
            if constexpr (SP2) {
            PG8_LDB(B0, 0, 0); PG8_LDB(B1, 0, 1); PG8_SCHED; PG8_LDA(At, 0, 0); PG8_STAGE(PG8_SA(1, 1), a1 + hstep, voffA);
            PG8_WAIT_V(8); PG8_WAIT_L(0); PG8_BAR; PG8_MMA(0, 0, At, B0); PG8_MMA(0, 1, At, B1); PG8_BAR; PG8_SCHED;
            PG8_LDA(At, 0, 1); PG8_STAGE(PG8_SB(0, 0), b2, voffB); PG8_STAGE(PG8_SB(0, 1), b2 + hstep, voffB); PG8_STAGE(PG8_SA(0, 0), a2, voffA);
            PG8_WAIT_V(8); PG8_WAIT_L(0); PG8_BAR; PG8_MMA(1, 0, At, B0); PG8_MMA(1, 1, At, B1); PG8_BAR; PG8_SCHED;
            PG8_LDB(B0, 1, 0); PG8_LDB(B1, 1, 1); PG8_SCHED; PG8_LDA(At, 1, 0); PG8_STAGE(PG8_SA(0, 1), a2 + hstep, voffA);
            PG8_WAIT_V(8); PG8_WAIT_L(0); PG8_BAR; PG8_MMA(0, 0, At, B0); PG8_MMA(0, 1, At, B1); PG8_BAR; PG8_SCHED;
            PG8_LDA(At, 1, 1); PG8_STAGE(PG8_SB(1, 0), b3, voffB); PG8_STAGE(PG8_SB(1, 1), b3 + hstep, voffB); PG8_STAGE(PG8_SA(1, 0), a3, voffA);
            PG8_WAIT_V(8); PG8_WAIT_L(0); PG8_BAR; PG8_MMA(1, 0, At, B0); PG8_MMA(1, 1, At, B1); PG8_BAR; PG8_SCHED;
            } else {
            PG8_LDB(B0, 0, 0); PG8_SCHED; PG8_LDA(At, 0, 0); PG8_STAGE(PG8_SA(1, 1), a1 + hstep, voffA);
            PG8_WAIT_L(8); PG8_BAR; PG8_WAIT_L(0); PG8_MMA(0, 0, At, B0); PG8_BAR; PG8_SCHED;
            PG8_LDB(B1, 0, 1); PG8_STAGE(PG8_SB(0, 0), b2, voffB);
            PG8_BAR; PG8_WAIT_L(0); PG8_MMA(0, 1, At, B1); PG8_BAR;
            PG8_LDA(At, 0, 1); PG8_STAGE(PG8_SA(0, 0), a2, voffA);
            PG8_BAR; PG8_WAIT_L(0); PG8_MMA(1, 0, At, B0); PG8_BAR; PG8_SCHED;
            PG8_STAGE(PG8_SB(0, 1), b2 + hstep, voffB);
            PG8_WAIT_V(6); PG8_BAR; PG8_MMA(1, 1, At, B1); PG8_BAR;
            PG8_LDB(B0, 1, 0); PG8_SCHED; PG8_LDA(At, 1, 0); PG8_STAGE(PG8_SA(0, 1), a2 + hstep, voffA);
            PG8_WAIT_L(8); PG8_BAR; PG8_WAIT_L(0); PG8_MMA(0, 0, At, B0); PG8_BAR; PG8_SCHED;
            PG8_LDB(B1, 1, 1); PG8_STAGE(PG8_SB(1, 0), b3, voffB);
            PG8_BAR; PG8_WAIT_L(0); PG8_MMA(0, 1, At, B1); PG8_BAR;
            PG8_LDA(At, 1, 1); PG8_STAGE(PG8_SA(1, 0), a3, voffA);
            PG8_BAR; PG8_WAIT_L(0); PG8_MMA(1, 0, At, B0); PG8_BAR; PG8_SCHED;
            PG8_STAGE(PG8_SB(1, 1), b3 + hstep, voffB);
            PG8_WAIT_V(6); PG8_BAR; PG8_MMA(1, 1, At, B1); PG8_BAR;
            }
        }
        if constexpr (ALIGN_EPI) { if (wr == 0) PG8_BAR; }
        if constexpr (!Epi::AFTER_DRAIN) { E(acc, cur, wr, wc, fr, fq); S.done(cur); }
        if (!has_next) break;
#pragma unroll
        for (int a = 0; a < 2; ++a)
#pragma unroll
            for (int b = 0; b < 2; ++b)
#pragma unroll
                for (int m = 0; m < 4; ++m)
#pragma unroll
                    for (int n = 0; n < 2; ++n) acc[a][b][m][n] = (f32x4){0.f, 0.f, 0.f, 0.f};
        cur = nxt; cA = nA; cB = nB; ++ui;
        if constexpr (ALIGN_EPI) { if (wr == 1) PG8_BAR; }
    }
    PG8_WAIT_V(0);
    if constexpr (!ALIGN_EPI) { if (wr == 0) PG8_BAR; }
    PG8_BAR;
    if constexpr (Epi::AFTER_DRAIN) { E.fused(acc, cur, wr, wc, fr, fq, lds, wid, lane); S.done(cur); }
#undef PG8_SA
#undef PG8_SB
#undef PG8_STAGE
#undef PG8_LDA
#undef PG8_LDB
#undef PG8_MMA
#undef PG8_WAIT_V
#undef PG8_WAIT_L
#undef PG8_BAR
#undef PG8_SCHED
}
}

constexpr int NB = 4, SEQ = 4096, M = NB * SEQ, D = 2048, DEPTH = 2;
constexpr int N_IN_SRC = 11088, NQ = 8960  , NF = 3328  ;
constexpr int NZA = 3584, NZB = 4608, NZG = 4096, NIN = 12288;
constexpr int KW_W = 64;
constexpr int DFF = 5632, NGU = 2 * DFF;
constexpr int NWAVES = 8;
constexpr float NORM_EPS = 1e-6f, NEG_INF = -1e30f;
constexpr int SC_BATCH = 8650752;

constexpr size_t MiB = 1u << 20;
constexpr size_t WS_CTL = 0, CTL_ZERO_BYTES = 1 * MiB;
constexpr size_t WS_MOD = 1 * MiB;
constexpr size_t WS_ROPE = 2 * MiB;
constexpr size_t WS_LUT = 2 * MiB + 768 * 1024;
constexpr size_t WS_LSE = 3 * MiB;
constexpr size_t WS_IDX = 4 * MiB;
constexpr size_t WS_W = 12 * MiB;
constexpr size_t WO_INQ = 0  , WO_INF = 24 * MiB  , WO_GU   = 48 * MiB, WO_DOWN = 92 * MiB, WO_OUT = 114 * MiB, WO_AUP = 122 * MiB, WO_BUP = 130 * MiB;
constexpr size_t WS_X = 144 * MiB;
constexpr size_t WS_H = 272 * MiB;
constexpr size_t WS_ZA = 336 * MiB;
constexpr size_t ZO_QLAT = 0, ZO_QI = 64 * MiB, ZO_CKV = 96 * MiB, ZO_KW = 104 * MiB;
constexpr size_t WS_ZB = 448 * MiB;
constexpr size_t WS_ZG = 592 * MiB;
constexpr size_t WS_H8 = 720 * MiB;
constexpr size_t WS_SCL = 2 * MiB + 512 * 1024;
constexpr size_t WS_END = 752 * MiB;
constexpr int CW_BAR = 4096;

constexpr int RING_BYTES = 131072;
constexpr int LDSCTL_OFF = RING_BYTES, MISC_OFF = LDSCTL_OFF + 320;
constexpr int SMALL_OFF = RING_BYTES + 1024;
constexpr int LDS_BYTES = 147456;

__device__ __forceinline__ unsigned off_b(unsigned row, unsigned ch) { return 256u * row + 16u * (ch ^ (((row & 3) << 2) | ((row >> 2) & 3))); }
__device__ __forceinline__ int rel_bucket_of(int n) {
    if (n < 16) return n;
    int b = 16;
    b += (n >= 22) + (n >= 30) + (n >= 40) + (n >= 54) + (n >= 73) + (n >= 99) + (n >= 134) + (n >= 182) + (n >= 246) + (n >= 332) + (n >= 450) + (n >= 609) + (n >= 825) + (n >= 1117) + (n >= 1513);
    return b;
}

struct Ptrs {
    const float *x, *c, *rel_bias, *w_ada, *b_ada, *norm1_g, *w_in, *kv_norm_g, *idx_ln_g, *idx_ln_b, *w_uk, *w_uv, *w_a_up, *w_b_up, *w_out, *norm2_g, *w_ff_gate, *w_ff_up, *w_ff_down, *final_g;
    float* out; unsigned char* ws;
};

__device__ __forceinline__ unsigned pkq4(float a, float b, float c, float d) {
    const int q0 = (int)__builtin_rintf(a), q1 = (int)__builtin_rintf(b), q2 = (int)__builtin_rintf(c), q3 = (int)__builtin_rintf(d);
    return (unsigned)(q0 & 255) | ((unsigned)(q1 & 255) << 8) | ((unsigned)(q2 & 255) << 16) | ((unsigned)q3 << 24); }
template <int MAP> __device__ __forceinline__ int map_row(int n, float& sc) {
    sc = 1.0f;
    if (MAP == 0) {
        if (n < 2304) return 2048 + (n - 1280);
        if (n < 2368) return 3072 + (n - 2304);
        sc = 0.03125f; return 3136 + (n - 2368);
    }
    return n;
}
template <int MAP> __device__ __forceinline__ void transpose_item(const float* W, int ldw, int k0, int n0, int nvalid, f16* WT, int K, LAS float* scr, int lane) {
#pragma unroll 8
    for (int i = 0; i < 32; ++i) { const int kk = 2 * i + (lane >> 5), n = lane & 31; scr[kk * 33 + n] = (n < nvalid) ? W[(size_t)(k0 + kk) * ldw + n0 + n] : 0.0f; }
    asm volatile("s_waitcnt lgkmcnt(0)" ::: "memory");
    const int c = lane & 7;
#pragma unroll
    for (int j = 0; j < 4; ++j) { const int n = (lane >> 3) + 8 * j; const LAS float* s = scr + (8 * c) * 33 + n;
        if (n < nvalid) { float sc; const int row = map_row<MAP>(n0 + n, sc);
            u32x4 o; o.x = pkh(s[0 * 33] * sc, s[1 * 33] * sc); o.y = pkh(s[2 * 33] * sc, s[3 * 33] * sc); o.z = pkh(s[4 * 33] * sc, s[5 * 33] * sc); o.w = pkh(s[6 * 33] * sc, s[7 * 33] * sc);
            *(u32x4*)(WT + (size_t)row * K + k0 + 8 * c) = o; } }
    asm volatile("s_waitcnt lgkmcnt(0)" ::: "memory");
}
__device__ __forceinline__ void quant_item(const float* W, int ldw, int n0, signed char* dst, int r0, float* sw, LAS unsigned char* lds, int tid) {
    LAS float* T = (LAS float*)lds; LAS float* pm = (LAS float*)(lds + SMALL_OFF);
#pragma unroll
    for (int i = 0; i < 16; ++i) { const int q = tid + 512 * i, k = q >> 2, c4 = q & 3; *(LAS f32x4*)(T + k * 16 + 4 * c4) = *(const f32x4*)(W + (size_t)k * ldw + n0 + 4 * c4); }
    __syncthreads();
    const int col = tid & 15, ks = tid >> 4; const LAS float* tp = T + (64 * ks) * 16 + col;
    float mx = 0.f;
#pragma unroll 16
    for (int j = 0; j < 64; ++j) mx = fmaxf(mx, __builtin_fabsf(tp[j * 16]));
    pm[ks * 16 + col] = mx;
    __syncthreads();
    mx = 0.f;
#pragma unroll
    for (int j = 0; j < 32; ++j) mx = fmaxf(mx, pm[j * 16 + col]);
    const float inv = mx > 0.f ? 127.0f / mx : 0.f;
    if (tid < 16) sw[r0 + col] = mx > 0.f ? mx * (1.0f / 127.0f) : 1.0f;
    signed char* dp = dst + (size_t)(r0 + col) * 2048 + 64 * ks;
#pragma unroll
    for (int i = 0; i < 4; ++i) { const LAS float* sp = tp + (16 * i) * 16; u32x4 o;
        o.x = pkq4(sp[0 * 16] * inv, sp[1 * 16] * inv, sp[2 * 16] * inv, sp[3 * 16] * inv); o.y = pkq4(sp[4 * 16] * inv, sp[5 * 16] * inv, sp[6 * 16] * inv, sp[7 * 16] * inv);
        o.z = pkq4(sp[8 * 16] * inv, sp[9 * 16] * inv, sp[10 * 16] * inv, sp[11 * 16] * inv); o.w = pkq4(sp[12 * 16] * inv, sp[13 * 16] * inv, sp[14 * 16] * inv, sp[15 * 16] * inv);
        *(u32x4*)(dp + 16 * i) = o; }
    __syncthreads();
}
__device__ __forceinline__ void minigemm_tile(const float* Asrc, int lda, const float* Bsrc, int ldb, f16* out, int ldo, float scale, LAS unsigned char* lds, int tid) {
    LAS float* As = (LAS float*)lds; LAS float* Bs = (LAS float*)(lds + 32768);
#pragma unroll
    for (int i = 0; i < 4; ++i) { const int q = tid + 512 * i, d = q >> 4, r4 = q & 15; *(LAS f32x4*)(As + d * 64 + 4 * r4) = *(const f32x4*)(Asrc + (size_t)d * lda + 4 * r4); }
#pragma unroll
    for (int i = 0; i < 4; ++i) { const int q = tid + 512 * i, col = q >> 5, d4 = q & 31; const f32x4 v = *(const f32x4*)(Bsrc + (size_t)col * ldb + 4 * d4);
        LAS float* bp = Bs + col * 129 + 4 * d4; bp[0] = v[0]; bp[1] = v[1]; bp[2] = v[2]; bp[3] = v[3]; }
    __syncthreads();
    const int tk = tid & 31, tc = tid >> 5;
    float a0[4] = {0.f, 0.f, 0.f, 0.f}, a1[4] = {0.f, 0.f, 0.f, 0.f};
#pragma unroll 8
    for (int d = 0; d < 128; ++d) { const f32x4 a = *(const LAS f32x4*)(As + d * 64 + 4 * tc); const float b0 = Bs[tk * 129 + d], b1 = Bs[(tk + 32) * 129 + d];
#pragma unroll
        for (int i = 0; i < 4; ++i) { a0[i] += a[i] * b0; a1[i] += a[i] * b1; } }
#pragma unroll
    for (int i = 0; i < 4; ++i) { f16* op = out + (size_t)(4 * tc + i) * ldo + tk; op[0] = (f16)(a0[i] * scale); op[32] = (f16)(a1[i] * scale); }
    __syncthreads();
}
__device__ __forceinline__ void p0_phase(const Ptrs& P, int l, LAS unsigned char* lds, int tid, int lane, int wave, int G, int bx) {
    __syncthreads();
    unsigned char* wsw = P.ws + WS_W;
    signed char* Winq = (signed char*)(wsw + WO_INQ); f16* Winf_t = (f16*)(wsw + WO_INF); signed char* Wguq = (signed char*)(wsw + WO_GU);
    float* sw_in = (float*)(P.ws + WS_SCL) + 16384; float* sw_gu = (float*)(P.ws + WS_SCL) + 32768; f16* Wdown_t = (f16*)(wsw + WO_DOWN); f16* Wout_t = (f16*)(wsw + WO_OUT); f16* Waup_t = (f16*)(wsw + WO_AUP); f16* Wbup_t = (f16*)(wsw + WO_BUP);
    const float* w_in = P.w_in + (size_t)l * D * N_IN_SRC; const float* w_uk = P.w_uk + (size_t)l * 8 * 128 * 256; const float* w_uv = P.w_uv + (size_t)l * 8 * 256 * 128;
    const float* w_a_up = P.w_a_up + (size_t)l * 1024 * D; const float* w_b_up = P.w_b_up + (size_t)l * 512 * D; const float* w_out = P.w_out + (size_t)l * D * D;
    const float* w_g = P.w_ff_gate + (size_t)l * D * DFF; const float* w_u = P.w_ff_up + (size_t)l * D * DFF; const float* w_d = P.w_ff_down + (size_t)l * DFF * D;
    if (l == 0 && bx < 192) {
        LAS float* sc = (LAS float*)lds; LAS float* red = (LAS float*)(lds + 32768);
        for (int i = tid; i < NB * D; i += 512) { const float v = P.c[i]; sc[i] = v / (1.0f + __expf(-v)); }
        __syncthreads();
        float* mod = (float*)(P.ws + WS_MOD);
        for (int it = bx; it < 192; it += G) {
            const int ll = it / 96, col0 = (it % 96) * 128, c4 = lane & 31, kh = lane >> 5;
            const float* wsrc = P.w_ada + (size_t)ll * D * 12288 + col0 + 4 * c4;
            f32x4 a[4];
#pragma unroll
            for (int b = 0; b < 4; ++b) a[b] = (f32x4){0.f, 0.f, 0.f, 0.f};
#pragma unroll 8
            for (int kk = 0; kk < 128; ++kk) { const int k = wave * 256 + 2 * kk + kh; const f32x4 wv = *(const f32x4*)(wsrc + (size_t)k * 12288);
#pragma unroll
                for (int b = 0; b < 4; ++b) a[b] += wv * sc[b * D + k]; }
#pragma unroll
            for (int b = 0; b < 4; ++b) {
#pragma unroll
                for (int e = 0; e < 4; ++e) a[b][e] += __shfl_xor(a[b][e], 32);
                if (kh == 0) *(LAS f32x4*)(red + (wave * 4 + b) * 128 + 4 * c4) = a[b]; }
            __syncthreads();
            { const int b = tid >> 7, col = tid & 127; float s2 = 0.f;
#pragma unroll
              for (int w = 0; w < 8; ++w) s2 += red[(w * 4 + b) * 128 + col];
              mod[(size_t)(ll * 4 + b) * 12288 + col0 + col] = s2 + P.b_ada[(size_t)ll * 12288 + col0 + col]; }
            __syncthreads();
        }
    }
    for (int it = bx; it < 2048; it += G) {
        const int idx = it & 1023, h = idx >> 7, rem = idx & 127;
        if (it < 1024) { const int c0 = (rem >> 5) * 64, k0 = (rem & 31) * 64;
            minigemm_tile(w_uk + (size_t)(h * 128) * 256 + c0, 256, w_in + (size_t)k0 * N_IN_SRC + h * 128, N_IN_SRC, Winf_t + (size_t)(h * 256 + c0) * D + k0, D, 0.08838834764831845f, lds, tid); }
        else { const int n0 = (rem >> 2) * 64, c0 = (rem & 3) * 64;
            minigemm_tile(w_a_up + (size_t)(h * 128) * D + n0, D, w_uv + (size_t)(h * 256 + c0) * 128, 128, Waup_t + (size_t)n0 * D + h * 256 + c0, D, 1.0f, lds, tid); }
    }
    constexpr int Q_CKV = 16, Q_QKV = 288, Q_GATES = 256, Q_FF = 352, NQITEMS = Q_CKV + Q_QKV + Q_GATES + 2 * Q_FF;
    for (int it = bx; it < NQITEMS; it += G) {
        int r = it; const float* Wsrc = w_in; int ldw = N_IN_SRC, n0, r0; signed char* dq = Winq; float* sq = sw_in;
        if (r < Q_CKV) { n0 = 1024 + 16 * r; r0 = 16 * r; }
        else if ((r -= Q_CKV) < Q_QKV) { n0 = 2384 + 16 * r; r0 = 256 + 16 * r; }
        else if ((r -= Q_QKV) < Q_GATES) { n0 = 6992 + 16 * r; r0 = 4864 + 16 * r; }
        else { r -= Q_GATES; const int up = r >= Q_FF; if (up) r -= Q_FF; Wsrc = up ? w_u : w_g; ldw = DFF; n0 = 16 * r; r0 = 256 * (n0 >> 7) + 128 * up + (n0 & 127); dq = Wguq; sq = sw_gu; }
        quant_item(Wsrc, ldw, n0, dq, r0, sq, lds, tid);
    }
    LAS float* scr = (LAS float*)(lds + wave * 16384);
    const int gw = bx * NWAVES + wave, NGW = G * NWAVES;
    constexpr int I_IDX = 32 * 35, I_B = 8 * 64, I_O = 32 * 64, I_D = 88 * 64;
    constexpr int NITEMS = I_IDX + I_B + I_O + I_D;
    for (int it = gw; it < NITEMS; it += NGW) {
        int r = it;
        if (r < I_IDX) { const int kb = r / 35, nb = r % 35, n0 = 1280 + 32 * nb; const int nv = (2384 - n0) < 32 ? (2384 - n0) : 32; transpose_item<0>(w_in, N_IN_SRC, 64 * kb, n0, nv, Winf_t, D, scr, lane); continue; } r -= I_IDX;
        if (r < I_B) { transpose_item<1>(w_b_up, D, 64 * (r / 64), 32 * (r % 64), 32, Wbup_t, 512, scr, lane); continue; } r -= I_B;
        if (r < I_O) { transpose_item<1>(w_out, D, 64 * (r / 64), 32 * (r % 64), 32, Wout_t, D, scr, lane); continue; } r -= I_O;
        transpose_item<1>(w_d, D, 64 * (r / 64), 32 * (r % 64), 32, Wdown_t, DFF, scr, lane);
    }
    const int gt = bx * 512 + tid, NGT = G * 512;
    { u32x4* pz = (u32x4*)(Winf_t + (size_t)3152 * D); for (int i = gt; i < 176 * D / 8; i += NGT) pz[i] = (u32x4){0u, 0u, 0u, 0u}; }
    if (l == 0) {
        f32x2* rope = (f32x2*)(P.ws + WS_ROPE);
        for (int e = gt; e < SEQ * 16; e += NGT) {
            const int pos = e >> 4, j = e & 15, a = j >> 2, b = j & 3;
            const double fa = a == 0 ? 1.0 : a == 1 ? 0.1 : a == 2 ? 0.01 : 0.001;
            const double fb = b == 0 ? 1.0 : b == 1 ? 0.5623413251903491 : b == 2 ? 0.31622776601683794 : 0.1778279410038923;
            const double ang = (double)pos * (fa * fb);
            const double q = __builtin_rint(ang * 0.15915494309189535);
            const double rr = __builtin_fma(-q, 2.4492935982947064e-16, __builtin_fma(-q, 6.283185307179586, ang));
            const float rf = (float)rr;
            rope[e] = (f32x2){cosf(rf), sinf(rf)};
        }
        unsigned char* lut = P.ws + WS_LUT;
        for (int n = gt; n < SEQ; n += NGT) lut[n] = (unsigned char)rel_bucket_of(n);
    }
}

template <bool F16OUT> __device__ __forceinline__ void norm_mod_phase(const float* x, const float* g, const float* shift, const float* scale, f16* out, signed char* out8, float* rs, int lane, int wave, int G, int bx) {
    const int gw = bx * NWAVES + wave, NGW = G * NWAVES;
    for (int blk = gw; blk < M / 8; blk += NGW) {
        const int row0 = blk * 8, b = row0 >> 12;
        f32x4 ca[8], cs[8];
#pragma unroll
        for (int j = 0; j < 8; ++j) { const int col = 4 * lane + 256 * j; const f32x4 gg = *(const f32x4*)(g + col), sc = *(const f32x4*)(scale + (size_t)b * 12288 + col); ca[j] = gg * (sc + 1.0f); cs[j] = *(const f32x4*)(shift + (size_t)b * 12288 + col); }
        for (int r = 0; r < 8; ++r) {
            const float* xr = x + (size_t)(row0 + r) * D + 4 * lane; f32x4 v[8]; float ss = 0.f;
#pragma unroll
            for (int j = 0; j < 8; ++j) { v[j] = *(const f32x4*)(xr + 256 * j); ss += (v[j].x * v[j].x + v[j].y * v[j].y) + (v[j].z * v[j].z + v[j].w * v[j].w); }
            const float rstd = 1.0f / sqrtf(wave_sum(ss) * (1.0f / D) + NORM_EPS);
            f16* orow = out + (size_t)(row0 + r) * D + 4 * lane; float mx = 0.f;
#pragma unroll
            for (int j = 0; j < 8; ++j) { const f32x4 o = v[j] * rstd * ca[j] + cs[j]; v[j] = o; mx = fmaxf(fmaxf(mx, fmaxf(__builtin_fabsf(o.x), __builtin_fabsf(o.y))), fmaxf(__builtin_fabsf(o.z), __builtin_fabsf(o.w)));
                if (F16OUT) { u32x2 w; w.x = pkh(o.x, o.y); w.y = pkh(o.z, o.w); *(u32x2*)(orow + 256 * j) = w; } }
#pragma unroll
            for (int o = 1; o < 64; o <<= 1) mx = fmaxf(mx, __shfl_xor(mx, o));
            const float inv = mx > 0.f ? 127.0f / mx : 0.f;
            if (lane == 0) rs[row0 + r] = mx > 0.f ? mx * (1.0f / 127.0f) : 1.0f;
            signed char* qrow = out8 + (size_t)(row0 + r) * D + 4 * lane;
#pragma unroll
            for (int j = 0; j < 8; ++j) *(unsigned*)(qrow + 256 * j) = pkq4(v[j].x * inv, v[j].y * inv, v[j].z * inv, v[j].w * inv);
        }
    }
}
__device__ __forceinline__ void final_norm_phase(float* xo, const float* g, int lane, int wave, int G, int bx) {
    const int gw = bx * NWAVES + wave, NGW = G * NWAVES;
    f32x4 cg[8];
#pragma unroll
    for (int j = 0; j < 8; ++j) cg[j] = *(const f32x4*)(g + 4 * lane + 256 * j);
    for (int row = gw; row < M; row += NGW) {
        float* xr = xo + (size_t)row * D + 4 * lane; f32x4 v[8]; float ss = 0.f;
#pragma unroll
        for (int j = 0; j < 8; ++j) { v[j] = *(const f32x4*)(xr + 256 * j); ss += (v[j].x * v[j].x + v[j].y * v[j].y) + (v[j].z * v[j].z + v[j].w * v[j].w); }
        const float rstd = 1.0f / sqrtf(wave_sum(ss) * (1.0f / D) + NORM_EPS);
#pragma unroll
        for (int j = 0; j < 8; ++j) *(f32x4*)(xr + 256 * j) = v[j] * rstd * cg[j];
    }
}

__device__ __forceinline__ void zfix_phase(f16* ckv, f16* qi, f16* kw, const float* kvg, const float* lng, const float* lnb, const f32x2* rope, int lane, int wave, int G, int bx) {
    const int gw = bx * NWAVES + wave, NGW = G * NWAVES;
    const f32x4 g4 = *(const f32x4*)(kvg + 4 * lane); const float lg = lng[lane], lb = lnb[lane];
    for (int blk = gw; blk < M / 8; blk += NGW)
        for (int r = 0; r < 8; ++r) {
            const int row = blk * 8 + r, pos = row & (SEQ - 1);
            { f16* z = ckv + (size_t)row * 256 + 4 * lane; const u32x2 w = *(const u32x2*)z; const f32x2 a = unpk(w.x), b = unpk(w.y);
              const float ss = wave_sum((a.x * a.x + a.y * a.y) + (b.x * b.x + b.y * b.y)); const float rstd = 1.0f / sqrtf(ss * (1.0f / 256.0f) + NORM_EPS);
              u32x2 o; o.x = pkh(a.x * rstd * g4.x, a.y * rstd * g4.y); o.y = pkh(b.x * rstd * g4.z, b.y * rstd * g4.w); *(u32x2*)z = o; }
            { f16* z = qi + (size_t)row * 1024 + 16 * lane; const u32x4 w0 = *(const u32x4*)z, w1 = *(const u32x4*)(z + 8);
              const unsigned mine[8] = {w0.x, w0.y, w0.z, w0.w, w1.x, w1.y, w1.z, w1.w}; unsigned res[8]; const int seg = lane & 3;
#pragma unroll
              for (int i = 0; i < 8; ++i) { const unsigned oth = (unsigned)__shfl_xor((int)mine[i], 1); const f32x2 me = unpk(mine[i]), ot = unpk(oth);
                  const f32x2 cs0 = rope[pos * 16 + 2 * i], cs1 = rope[pos * 16 + 2 * i + 1];
                  float r0, r1;
                  if (seg == 0) { r0 = me.x * cs0.x - ot.x * cs0.y; r1 = me.y * cs1.x - ot.y * cs1.y; }
                  else          { r0 = ot.x * cs0.y + me.x * cs0.x; r1 = ot.y * cs1.y + me.y * cs1.x; }
                  res[i] = seg < 2 ? pkh(r0, r1) : mine[i]; }
              *(u32x4*)z = (u32x4){res[0], res[1], res[2], res[3]}; *(u32x4*)(z + 8) = (u32x4){res[4], res[5], res[6], res[7]}; }
            { f16* z = kw + (size_t)row * 256 + lane; const float xv = (float)z[0]; const float mu = wave_sum(xv) * (1.0f / 64.0f); const float dv = xv - mu; const float var = wave_sum(dv * dv) * (1.0f / 64.0f);
              const float y = dv * (1.0f / sqrtf(var + NORM_EPS)) * lg + lb; const float oth = __shfl_xor(y, 16); const f32x2 cs = rope[pos * 16 + (lane & 15)];
              float o = y; if (lane < 16) o = y * cs.x - oth * cs.y; else if (lane < 32) o = oth * cs.y + y * cs.x;
              z[0] = (f16)o; }
        }
}

__device__ __forceinline__ void battn_phase(const f16* zB, const float* rel_bias, const unsigned char* lut, f16* ob, float* lse, LAS unsigned char* lds, int tid, int lane, int wave, int G, int bx) {
    LAS unsigned char* Kimg = lds; LAS unsigned char* Vimg = lds + 65536; LAS float* tb = (LAS float*)(lds + SMALL_OFF);
    const int g4 = lane >> 4, q15 = lane & 15;
    for (int uid = bx; uid < NB * 3 * 4 * 32; uid += G) {
        const int s = uid & 31, j = (uid >> 5) & 3, grp = (uid >> 7) % 3, b = uid / 384;
        const int dsh = 2 * grp, r = s & ((1 << dsh) - 1), n = s >> dsh;
        const f16* zb = zB + (size_t)b * SEQ * NZB; const int colQ = (grp * 4 + j) * 128, colK = ((3 + grp) * 4 + j) * 128, colV = ((6 + grp) * 4 + j) * 128;
#pragma unroll
        for (int i = 0; i < 8; ++i) { const int cidx = tid + 512 * i, u = cidx >> 4, ch = cidx & 15, mk = (n - 1) * 128 + u;
            u32x4 kv = {0u, 0u, 0u, 0u}, vv = {0u, 0u, 0u, 0u};
            if (mk >= 0) { const f16* rp = zb + (size_t)((mk << dsh) + r) * NZB + ch * 8; kv = *(const u32x4*)(rp + colK); vv = *(const u32x4*)(rp + colV); }
            *(LAS u32x4*)(Kimg + off_b(u, ch)) = kv; *(LAS u32x4*)(Vimg + off_b(u, ch)) = vv; }
        if (tid <= 128) tb[tid] = rel_bias[(int)lut[tid << dsh] * 20 + 8 + grp * 4 + j];
        __syncthreads();
        const int iq = 16 * wave + q15, tq = ((n * 128 + iq) << dsh) + r;
        const f16* qp = zb + (size_t)tq * NZB + colQ + 8 * g4;
        f16x8 qf[4];
#pragma unroll
        for (int k = 0; k < 4; ++k) qf[k] = *(const f16x8*)(qp + 32 * k);
        const int kstart = 32 * (wave >> 1);
        const int back0 = iq + 128 - (kstart + 8 * g4); const unsigned bmax = n > 0 ? 128u : (unsigned)iq;
        f32x4 sreg[5][2]; float mx = NEG_INF;
#pragma unroll
        for (int T = 0; T < 5; ++T)
#pragma unroll
            for (int hf = 0; hf < 2; ++hf) {
                const int krow = kstart + 32 * T + 8 * (q15 >> 2) + 4 * hf + (q15 & 3);
                f32x4 acc = {0.f, 0.f, 0.f, 0.f};
#pragma unroll
                for (int k = 0; k < 4; ++k) { const f16x8 kf = *(const LAS f16x8*)(Kimg + off_b(krow, 4 * k + g4)); acc = __builtin_amdgcn_mfma_f32_16x16x32_f16(kf, qf[k], acc, 0, 0, 0); }
#pragma unroll
                for (int e = 0; e < 4; ++e) { const unsigned back = (unsigned)(back0 - (32 * T + 4 * hf + e));
                    const bool valid = back <= bmax; const unsigned bi = back < 128u ? back : 128u;
                    const float sv = valid ? acc[e] * 0.08838834764831845f + tb[bi] : NEG_INF; acc[e] = sv; mx = fmaxf(mx, sv); }
                sreg[T][hf] = acc; }
        mx = fmaxf(mx, __shfl_xor(mx, 16)); mx = fmaxf(mx, __shfl_xor(mx, 32));
        float den = 0.f; f16x8 pf[5];
#pragma unroll
        for (int T = 0; T < 5; ++T) { float p[8];
#pragma unroll
            for (int e = 0; e < 8; ++e) { p[e] = __expf(sreg[T][e >> 2][e & 3] - mx); den += p[e]; }
            const u32x4 w = pkh8((f32x4){p[0], p[1], p[2], p[3]}, (f32x4){p[4], p[5], p[6], p[7]}); pf[T] = __builtin_bit_cast(f16x8, w); }
        den += __shfl_xor(den, 16); den += __shfl_xor(den, 32);
        const float rden = 1.0f / den;
        f16* op = ob + ((size_t)grp * M + (size_t)b * SEQ + tq) * 512 + j * 128 + 4 * g4;
        const unsigned trq = (unsigned)(q15 >> 2), trp = (unsigned)(lane & 3);
#pragma unroll
        for (int c = 0; c < 8; ++c) { f32x4 acc = {0.f, 0.f, 0.f, 0.f};
#pragma unroll
            for (int T = 0; T < 5; ++T) {
                const unsigned r0 = (unsigned)(kstart + 32 * T + 8 * g4) + trq;
                const s16x4 t0 = __builtin_amdgcn_ds_read_tr16_b64_v4i16((LAS s16x4*)(Vimg + off_b(r0, 2 * c + (trp >> 1)) + 8 * (trp & 1)));
                const s16x4 t1 = __builtin_amdgcn_ds_read_tr16_b64_v4i16((LAS s16x4*)(Vimg + off_b(r0 + 4, 2 * c + (trp >> 1)) + 8 * (trp & 1)));
                const f16x8 vf = __builtin_bit_cast(f16x8, __builtin_shufflevector(t0, t1, 0, 1, 2, 3, 4, 5, 6, 7));
                acc = __builtin_amdgcn_mfma_f32_16x16x32_f16(vf, pf[T], acc, 0, 0, 0); }
            u32x2 w; w.x = pkh(acc[0] * rden, acc[1] * rden); w.y = pkh(acc[2] * rden, acc[3] * rden); *(u32x2*)(op + 16 * c) = w; }
        if (lane < 16) lse[((size_t)grp * M + (size_t)b * SEQ + tq) * 4 + j] = mx + __logf(den);
        __syncthreads();
    }
}

__device__ __forceinline__ void score_phase(const f16* qi, const f16* kw, float* S, int lane, int wave, int G, int bx) {
    const int wq = wave & 3, wk = wave >> 2, l31 = lane & 31, lh = lane >> 5;
    for (int uid = bx; uid < NB * 272; uid += G) {
        const int b = uid / 272; int rem = uid % 272, qb = 0;
        for (;;) { const int cnt = (qb + 2) >> 1; if (rem < cnt) break; rem -= cnt; ++qb; }
        const int kb = 2 * rem + wk;
        if (kb > qb) continue;
        const int t = qb * 128 + 32 * wq + l31; const f16* zq = qi + (size_t)(b * SEQ + t) * 1024; const f16* zw = kw + (size_t)(b * SEQ + t) * 256 + KW_W;
        f16x8 kf[4][4];
#pragma unroll
        for (int tl = 0; tl < 4; ++tl) { const f16* kp = kw + (size_t)(b * SEQ + kb * 128 + 32 * tl + l31) * 256 + 8 * lh;
#pragma unroll
            for (int k = 0; k < 4; ++k) kf[tl][k] = *(const f16x8*)(kp + 16 * k); }
        f32x16 sc[4];
#pragma unroll
        for (int tl = 0; tl < 4; ++tl)
#pragma unroll
            for (int e = 0; e < 16; ++e) sc[tl][e] = 0.f;
#pragma unroll 2
        for (int hd = 0; hd < 16; ++hd) {
            f16x8 qf[4];
#pragma unroll
            for (int k = 0; k < 4; ++k) qf[k] = *(const f16x8*)(zq + hd * 64 + 16 * k + 8 * lh);
            const float wh = (float)zw[hd];
#pragma unroll
            for (int pr = 0; pr < 2; ++pr) {
                f32x16 a0, a1;
#pragma unroll
                for (int e = 0; e < 16; ++e) { a0[e] = 0.f; a1[e] = 0.f; }
#pragma unroll
                for (int k = 0; k < 4; ++k) { a0 = __builtin_amdgcn_mfma_f32_32x32x16_f16(kf[2 * pr][k], qf[k], a0, 0, 0, 0); a1 = __builtin_amdgcn_mfma_f32_32x32x16_f16(kf[2 * pr + 1][k], qf[k], a1, 0, 0, 0); }
#pragma unroll
                for (int e = 0; e < 16; ++e) { sc[2 * pr][e] += wh * fmaxf(a0[e], 0.f); sc[2 * pr + 1][e] += wh * fmaxf(a1[e], 0.f); }
            }
        }
        float* sp = S + (size_t)b * SC_BATCH + (size_t)16384 * (qb * (qb + 1) / 2) + (size_t)(32 * wq + l31) * ((qb + 1) * 128) + kb * 128 + 4 * lh;
#pragma unroll
        for (int tl = 0; tl < 4; ++tl)
#pragma unroll
            for (int a = 0; a < 4; ++a) *(f32x4*)(sp + 32 * tl + 8 * a) = (f32x4){sc[tl][4 * a], sc[tl][4 * a + 1], sc[tl][4 * a + 2], sc[tl][4 * a + 3]};
    }
}

__device__ __forceinline__ unsigned ord_key(float x) { const unsigned u = __builtin_bit_cast(unsigned, x); return u ^ ((unsigned)((int)u >> 31) | 0x80000000u); }
__device__ __forceinline__ int wave_total(int v) {
    v += __builtin_amdgcn_update_dpp(0, v, 0x111, 0xf, 0xf, true);
    v += __builtin_amdgcn_update_dpp(0, v, 0x112, 0xf, 0xf, true);
    v += __builtin_amdgcn_update_dpp(0, v, 0x114, 0xf, 0xf, true);
    v += __builtin_amdgcn_update_dpp(0, v, 0x118, 0xf, 0xf, true);
    v += __builtin_amdgcn_update_dpp(0, v, 0x142, 0xa, 0xf, true);
    v += __builtin_amdgcn_update_dpp(0, v, 0x143, 0xc, 0xf, true);
    return __builtin_amdgcn_readlane(v, 63);
}
template <int NCH> __device__ __forceinline__ void select_row(const float* src, int n, u16* orow, int lane) {
    unsigned key[4 * NCH];
#pragma unroll
    for (int j = 0; j < NCH; ++j) { const int base = 256 * j + 4 * lane; const f32x4 v = *(const f32x4*)(src + base);
#pragma unroll
        for (int e = 0; e < 4; ++e) key[4 * j + e] = ord_key(v[e]) & (unsigned)((base + e - n) >> 31); }
    unsigned tau = 0u;
    for (int bit = 31; bit >= 0; --bit) { const unsigned cand = tau | (1u << bit); int cnt = 0;
#pragma unroll
        for (int m = 0; m < 4 * NCH; ++m) cnt += (key[m] >= cand) ? 1 : 0;
        cnt = wave_total(cnt);
        if (cnt >= 256) { tau = cand; if (cnt == 256) break; } }
    int cgt = 0;
#pragma unroll
    for (int m = 0; m < 4 * NCH; ++m) cgt += (key[m] > tau) ? 1 : 0;
    cgt = wave_total(cgt);
    const int need = 256 - cgt; int og = 0, oe = 0;
    asm volatile("" : "+v"(tau));
#pragma unroll
    for (int m = 0; m < 4 * NCH; ++m) {
        const unsigned kidx = (unsigned)(256 * (m >> 2) + 4 * lane + (m & 3));
        const bool isg = key[m] > tau, ise = key[m] == tau;
        const unsigned long long bg = __ballot(isg), be = __ballot(ise);
        const unsigned lo_g = __builtin_amdgcn_mbcnt_hi((unsigned)(bg >> 32), __builtin_amdgcn_mbcnt_lo((unsigned)bg, 0u));
        const unsigned lo_e = __builtin_amdgcn_mbcnt_hi((unsigned)(be >> 32), __builtin_amdgcn_mbcnt_lo((unsigned)be, 0u));
        if (isg) orow[og + (int)lo_g] = (u16)kidx;
        else if (ise && (oe + (int)lo_e) < need) orow[cgt + oe + (int)lo_e] = (u16)kidx;
        og += __popcll(bg); oe += __popcll(be);
        __builtin_amdgcn_sched_barrier(0);
    }
}
__device__ __forceinline__ void select_phase(const float* S, u16* idx, int lane, int wave, int G, int bx) {
    const int gw = bx * NWAVES + wave, NGW = G * NWAVES;
    for (int pr = gw; pr < NB * (SEQ / 2); pr += NGW)
        for (int hh = 0; hh < 2; ++hh) {
            const int b = pr / (SEQ / 2), t0 = pr % (SEQ / 2), t = hh ? SEQ - 1 - t0 : t0, row = b * SEQ + t, qb = t >> 7, n = t + 1;
            u16* orow = idx + (size_t)row * 256;
            if (n <= 256) { u32x2 w; const int k = 4 * lane;
                w.x = (unsigned)(k < n ? k : 0xFFFF) | ((unsigned)(k + 1 < n ? k + 1 : 0xFFFF) << 16); w.y = (unsigned)(k + 2 < n ? k + 2 : 0xFFFF) | ((unsigned)(k + 3 < n ? k + 3 : 0xFFFF) << 16);
                *(u32x2*)(orow + k) = w; continue; }
            const float* src = S + (size_t)b * SC_BATCH + (size_t)16384 * (qb * (qb + 1) / 2) + (size_t)(t & 127) * ((qb + 1) * 128);
            const int nch = (n + 255) >> 8;
            if (nch <= 2) select_row<2>(src, n, orow, lane); else if (nch <= 4) select_row<4>(src, n, orow, lane); else if (nch <= 6) select_row<6>(src, n, orow, lane);
            else if (nch <= 8) select_row<8>(src, n, orow, lane); else if (nch <= 10) select_row<10>(src, n, orow, lane); else if (nch <= 12) select_row<12>(src, n, orow, lane);
            else if (nch <= 14) select_row<14>(src, n, orow, lane); else select_row<16>(src, n, orow, lane);
        }
}
__device__ __forceinline__ void bmerge_phase(const f16* ob, const float* lse, f16* yb, int lane, int wave, int G, int bx) {
    const int gw = bx * NWAVES + wave, NGW = G * NWAVES; const int js = lane >> 4, e0 = (lane & 15) * 8;
    for (int row = gw; row < M; row += NGW) {
        const float l0 = lse[((size_t)0 * M + row) * 4 + js], l1 = lse[((size_t)1 * M + row) * 4 + js], l2 = lse[((size_t)2 * M + row) * 4 + js];
        const float mx = fmaxf(l0, fmaxf(l1, l2)); float w0 = __expf(l0 - mx), w1 = __expf(l1 - mx), w2 = __expf(l2 - mx); const float inv = 1.0f / (w0 + w1 + w2); w0 *= inv; w1 *= inv; w2 *= inv;
        const size_t o = (size_t)row * 512 + js * 128 + e0;
        const u32x4 a = *(const u32x4*)(ob + o), bq = *(const u32x4*)(ob + (size_t)M * 512 + o), cq = *(const u32x4*)(ob + (size_t)2 * M * 512 + o);
        const unsigned aw[4] = {a.x, a.y, a.z, a.w}, bw[4] = {bq.x, bq.y, bq.z, bq.w}, cw[4] = {cq.x, cq.y, cq.z, cq.w}; unsigned rw[4];
#pragma unroll
        for (int i = 0; i < 4; ++i) { const f32x2 x0 = unpk(aw[i]), x1 = unpk(bw[i]), x2 = unpk(cw[i]); rw[i] = pkh(w0 * x0.x + w1 * x1.x + w2 * x2.x, w0 * x0.y + w1 * x1.y + w2 * x2.y); }
        *(u32x4*)(yb + o) = (u32x4){rw[0], rw[1], rw[2], rw[3]};
    }
}

__device__ __forceinline__ float grp4_max(float x) {
    u32x2 r = __builtin_amdgcn_permlane16_swap(__builtin_bit_cast(unsigned, x), __builtin_bit_cast(unsigned, x), false, false);
    x = fmaxf(__builtin_bit_cast(float, r.x), __builtin_bit_cast(float, r.y));
    r = __builtin_amdgcn_permlane32_swap(__builtin_bit_cast(unsigned, x), __builtin_bit_cast(unsigned, x), false, false);
    return fmaxf(__builtin_bit_cast(float, r.x), __builtin_bit_cast(float, r.y));
}
__device__ __forceinline__ float grp4_sum(float x) {
    u32x2 r = __builtin_amdgcn_permlane16_swap(__builtin_bit_cast(unsigned, x), __builtin_bit_cast(unsigned, x), false, false);
    x = __builtin_bit_cast(float, r.x) + __builtin_bit_cast(float, r.y);
    r = __builtin_amdgcn_permlane32_swap(__builtin_bit_cast(unsigned, x), __builtin_bit_cast(unsigned, x), false, false);
    return __builtin_bit_cast(float, r.x) + __builtin_bit_cast(float, r.y);
}
template <int MODE  > __device__ __forceinline__ void dsa_phase(const f16* qlat, const f16* ckv, const u16* idx, const float* rel_bias, const unsigned char* lut, f16* olat, LAS unsigned char* lds, int tid, int lane, int wave, int G, int bx) {
    LAS unsigned char* lutS = lds + SMALL_OFF; LAS float* biasS = (LAS float*)(lds + SMALL_OFF + 4096);
    for (int i = tid; i < SEQ / 4; i += 512) ((LAS unsigned*)lutS)[i] = ((const unsigned*)lut)[i];
    if (tid < 256) biasS[tid] = rel_bias[(tid >> 3) * 20 + (tid & 7)];
    __syncthreads();
    LAS unsigned char* kv = lds + wave * 16384;
    const int g4 = lane >> 4, head = lane & 15, hq = head & 7, l31 = lane & 31, lh = lane >> 5;
    const unsigned trq = (unsigned)(head >> 2), trp = (unsigned)(lane & 3);
    int tok0, tstride, ntok;
    if (G == 256) { const int bsel = (bx & 7) >> 1, wib = (((bx & 7) & 1) + 2 * (bx >> 3)) * NWAVES + wave; tok0 = bsel * SEQ + wib; tstride = 512; ntok = 8; }
    else { tok0 = bx * NWAVES + wave; tstride = G * NWAVES; ntok = tok0 < M ? (M - tok0 + tstride - 1) / tstride : 0; }
    const int nsteps = ntok * 8;
    if (nsteps == 0) return;
    u32x4 GR[16]; f32x4 oacc[16]; f16x8 qf[8];
    float mrun = NEG_INF, lrun = 0.f, bvc[8];
    u16x8 my8n; int idxn;
#define DSA_ROW(st) (tok0 + ((st) >> 3) * tstride)
#define DSA_IDX(st, m8, ix) do { const int st_ = (st) < nsteps ? (st) : nsteps - 1; const u16* ir_ = idx + (size_t)DSA_ROW(st_) * 256 + 32 * (st_ & 7); \
        m8 = *(const u16x8*)(ir_ + 8 * g4); ix = (int)ir_[l31]; } while (0)
#define DSA_GATHER(st, ix) do { const int st_ = (st) < nsteps ? (st) : nsteps - 1; const f16* zb_ = ckv + (size_t)(DSA_ROW(st_) >> 12) * SEQ * 256 + 8 * l31; \
        _Pragma("unroll") for (int p_ = 0; p_ < 16; ++p_) { const int ia_ = __builtin_amdgcn_readlane((ix), 2 * p_), ib_ = __builtin_amdgcn_readlane((ix), 2 * p_ + 1); int ir_ = lh ? ib_ : ia_; ir_ = ir_ == 0xFFFF ? 0 : ir_; GR[p_] = *(const u32x4*)(zb_ + (size_t)ir_ * 256); } } while (0)
#define DSA_BIAS(st, m8, bv) do { const int st_ = (st) < nsteps ? (st) : nsteps - 1; const int t_ = DSA_ROW(st_) & (SEQ - 1); int bk_[8]; \
        _Pragma("unroll") for (int e_ = 0; e_ < 8; ++e_) { const int k_ = (int)m8[e_]; const int d_ = k_ == 0xFFFF ? 0 : t_ - k_; bk_[e_] = (int)lutS[d_]; } \
        _Pragma("unroll") for (int e_ = 0; e_ < 8; ++e_) { const float b_ = biasS[bk_[e_] * 8 + hq]; bv[e_] = (int)m8[e_] == 0xFFFF ? NEG_INF : b_; } } while (0)
    { u16x8 m0; int ix0; DSA_IDX(0, m0, ix0); if (MODE != 1) DSA_GATHER(0, ix0); DSA_BIAS(0, m0, bvc); DSA_IDX(1, my8n, idxn); }
    for (int st = 0; st < nsteps; ++st) {
        const int row = DSA_ROW(st), ch = st & 7;
        if (ch == 0) {
            const f16* zq = qlat + (size_t)row * 2048;
#pragma unroll
            for (int s = 0; s < 8; ++s) { const u32x4 w = *(const u32x4*)(zq + hq * 256 + 32 * s + 8 * g4); qf[s] = head < 8 ? __builtin_bit_cast(f16x8, w) : (f16x8){0, 0, 0, 0, 0, 0, 0, 0}; }
#pragma unroll
            for (int c = 0; c < 16; ++c) oacc[c] = (f32x4){0.f, 0.f, 0.f, 0.f};
            mrun = NEG_INF; lrun = 0.f;
        }
        if (MODE != 1) {
#pragma unroll
            for (int p = 0; p < 16; ++p) *(LAS u32x4*)(kv + (l31 >> 4) * 8192 + off_b((unsigned)(2 * p + lh), (unsigned)(lane & 15))) = GR[p];
            DSA_GATHER(st + 1, idxn);
        }
        u16x8 my8nn; int idxnn; DSA_IDX(st + 2, my8nn, idxnn);
        float bvn[8]; DSA_BIAS(st + 1, my8n, bvn);
        if (MODE != 2) {
        f32x4 stl[2];
#pragma unroll
        for (int hf = 0; hf < 2; ++hf) { const unsigned krow = 8u * (unsigned)(head >> 2) + 4u * hf + (unsigned)(head & 3); f32x4 acc = {0.f, 0.f, 0.f, 0.f};
#pragma unroll
            for (int s = 0; s < 8; ++s) { const f16x8 kf = *(const LAS f16x8*)(kv + (s >> 2) * 8192 + off_b(krow, 4u * (s & 3) + (unsigned)g4)); acc = __builtin_amdgcn_mfma_f32_16x16x32_f16(kf, qf[s], acc, 0, 0, 0); }
            stl[hf] = acc; }
        float sv[8], cmax = NEG_INF;
#pragma unroll
        for (int e = 0; e < 8; ++e) { sv[e] = stl[e >> 2][e & 3] + bvc[e]; cmax = fmaxf(cmax, sv[e]); }
        cmax = fmaxf(cmax, __shfl_xor(cmax, 16)); cmax = fmaxf(cmax, __shfl_xor(cmax, 32));
        if (__any(cmax > mrun + 6.0f)) {
            const float mnew = fmaxf(mrun, cmax), alpha = __expf(mrun - mnew);
            lrun *= alpha; mrun = mnew;
            if (ch != 0) {
#pragma unroll
                for (int c = 0; c < 16; ++c) oacc[c] = oacc[c] * alpha; }
        }
        float p[8], ps = 0.f;
#pragma unroll
        for (int e = 0; e < 8; ++e) { p[e] = __expf(sv[e] - mrun); ps += p[e]; }
        ps += __shfl_xor(ps, 16); ps += __shfl_xor(ps, 32);
        lrun += ps;
        const f16x8 pf = __builtin_bit_cast(f16x8, pkh8((f32x4){p[0], p[1], p[2], p[3]}, (f32x4){p[4], p[5], p[6], p[7]}));
#pragma unroll
        for (int ct = 0; ct < 16; ++ct) {
            const unsigned r0 = 8u * (unsigned)g4 + trq, cch = 2u * (ct & 7) + (trp >> 1);
            LAS unsigned char* img = kv + (ct >> 3) * 8192;
            const s16x4 t0 = __builtin_amdgcn_ds_read_tr16_b64_v4i16((LAS s16x4*)(img + off_b(r0, cch) + 8 * (trp & 1)));
            const s16x4 t1 = __builtin_amdgcn_ds_read_tr16_b64_v4i16((LAS s16x4*)(img + off_b(r0 + 4, cch) + 8 * (trp & 1)));
            const f16x8 vf = __builtin_bit_cast(f16x8, __builtin_shufflevector(t0, t1, 0, 1, 2, 3, 4, 5, 6, 7));
            oacc[ct] = __builtin_amdgcn_mfma_f32_16x16x32_f16(vf, pf, oacc[ct], 0, 0, 0); }
        if (ch == 7) {
            const float rl = 1.0f / lrun;
            if (head < 8) { f16* op = olat + (size_t)row * 2048 + head * 256 + 4 * g4;
#pragma unroll
                for (int ct = 0; ct < 16; ++ct) { u32x2 w; w.x = pkh(oacc[ct][0] * rl, oacc[ct][1] * rl); w.y = pkh(oacc[ct][2] * rl, oacc[ct][3] * rl); *(u32x2*)(op + 16 * ct) = w; } }
        }
        }
        my8n = my8nn; idxn = idxnn;
#pragma unroll
        for (int e = 0; e < 8; ++e) bvc[e] = bvn[e];
    }
#undef DSA_ROW
#undef DSA_IDX
#undef DSA_GATHER
#undef DSA_BIAS
}
#define XB_TMO      128
#define XB_XCNT(j)  (256  + 64 * (j))
#define XB_XSUB(j)  (1280 + 64 * (j))
#define XB_XGEN(j)  (2304 + 64 * (j))
#define XB_TOP      3328
#define XB_TOPGEN   3392
#define XCD_BAR_WORDS 3456
#define XB_SPIN_CAP (1u << 18)

__device__ __forceinline__ unsigned xb_ld(unsigned* p)              { return __hip_atomic_load(p, __ATOMIC_RELAXED, __HIP_MEMORY_SCOPE_AGENT); }
__device__ __forceinline__ unsigned xb_add(unsigned* p, unsigned v) { return __hip_atomic_fetch_add(p, v, __ATOMIC_RELAXED, __HIP_MEMORY_SCOPE_AGENT); }
__device__ __forceinline__ unsigned xb_xcc_id() { return (unsigned)__builtin_amdgcn_s_getreg((3 << 11) | 20) & 0xFu; }
#define XB_SPIN(cond, bar) do { unsigned _sp = 0; while (cond) { __builtin_amdgcn_s_sleep(1); \
    if ((++_sp & 255u) == 0u) { if (xb_ld(&(bar)[XB_TMO])) break; if (_sp > XB_SPIN_CAP) { atomicAdd(&(bar)[XB_TMO], 1u); break; } } } } while (0)

struct XcdBarrier {
    unsigned* bar; unsigned x;
    volatile LAS unsigned* st;
};

__device__ __forceinline__ XcdBarrier xcd_barrier_post(unsigned* bar, volatile LAS unsigned* st) {
    XcdBarrier b; b.bar = bar; b.x = xb_xcc_id(); b.st = st;
    if (threadIdx.x == 0) (void)xb_add(&bar[XB_XCNT(b.x)], 1u);
    return b;
}
__device__ __forceinline__ void xcd_barrier_complete(unsigned* bar, unsigned x, unsigned& nloc, unsigned& nx) {
    const unsigned G = gridDim.x * gridDim.y * gridDim.z;
    unsigned sum, cnt, mine, sp = 0u;
    for (;;) {
        sum = 0u; cnt = 0u; mine = 0u;
#pragma unroll
        for (unsigned j = 0; j < 16; ++j) { const unsigned c = xb_ld(&bar[XB_XCNT(j)]); sum += c; cnt += (c > 0u) ? 1u : 0u; mine = (j == x) ? c : mine; }
        if (sum == G) break;
        __builtin_amdgcn_s_sleep(1);
        if ((++sp & 255u) == 0u) { if (xb_ld(&bar[XB_TMO])) break; if (sp > XB_SPIN_CAP) { atomicAdd(&bar[XB_TMO], 1u); break; } }
    }
    nloc = mine > 0u ? mine : 1u; nx = cnt > 0u ? cnt : 1u;
}

__device__ __forceinline__ void xcd_barrier(const XcdBarrier& b) {
    asm volatile("s_waitcnt vmcnt(0)" ::: "memory");
    __syncthreads();
    if (threadIdx.x == 0) {
        unsigned* bar = b.bar;
        __builtin_amdgcn_s_waitcnt(0);
        unsigned nloc = b.st[0], nx = b.st[1];
        if (nloc == 0u) { xcd_barrier_complete(bar, b.x, nloc, nx); b.st[0] = nloc; b.st[1] = nx; }
        const unsigned old = xb_add(&bar[XB_XSUB(b.x)], 1u);
        const unsigned gen = old / nloc;
        if (old + 1u == (gen + 1u) * nloc) {
            __builtin_amdgcn_fence(__ATOMIC_RELEASE, "agent");
            asm volatile("s_waitcnt vmcnt(0)" ::: "memory");
            const unsigned og = xb_add(&bar[XB_TOP], 1u);
            const unsigned tg = og / nx;
            if (og + 1u == (tg + 1u) * nx) xb_add(&bar[XB_TOPGEN], 1u);
            else XB_SPIN(xb_ld(&bar[XB_TOPGEN]) == tg, bar);
            __builtin_amdgcn_fence(__ATOMIC_ACQUIRE, "agent");
            xb_add(&bar[XB_XGEN(b.x)], 1u);
            asm volatile("s_waitcnt vmcnt(0)" ::: "memory");
        } else {
            XB_SPIN(xb_ld(&bar[XB_XGEN(b.x)]) == gen, bar);
            __builtin_amdgcn_fence(__ATOMIC_ACQUIRE, "agent");
            asm volatile("s_waitcnt vmcnt(0)" ::: "memory");
        }
    }
    __syncthreads();
}

#ifndef MK_PER_PHASE
#define MK_PER_PHASE 0
#endif
constexpr int N_PHASES = 12 * DEPTH + 1;
struct Args { const float* in[20]; float* out; unsigned char* ws; int ph_lo, ph_hi; };
#ifndef REPMASK
#define REPMASK 0
#endif
#ifndef ONLY_PHASE
#define ONLY_PHASE -1
#endif
#define IN(k) ((ONLY_PHASE < 0 || ((k) == 12 * DEPTH ? 12 : (k) % 12) == ONLY_PHASE) && lo <= (k) && (k) < hi)
#define SEAM(k) do { if (IN(k) && IN((k) + 1)) { XcdBarrier bb = bar; asm volatile("" : "+s"(bb.bar), "+s"(bb.x)); xcd_barrier(bb); if ((REPMASK >> 12) & 1) xcd_barrier(bb); } } while (0)
#define CAS __attribute__((address_space(4)))
#define PH_IDS int tid = tid0; asm volatile("" : "+v"(tid)); const int lane = tid & 63, wave = __builtin_amdgcn_readfirstlane(tid >> 6); (void)lane; (void)wave; \
    int G = (int)gridDim.x, bx = (int)blockIdx.x; asm volatile("" : "+s"(G), "+s"(bx)); \
    const CAS Args* ap = (const CAS Args*)__builtin_amdgcn_kernarg_segment_ptr(); asm volatile("" : "+s"(ap)); unsigned char* ws = ap->ws
#define W_INQ ((const pg8::bf16_t*)(ws + WS_W + WO_INQ))
#define W_INF_T ((f16*)(ws + WS_W + WO_INF))
#define B_H8 ((signed char*)(ws + WS_H8))
#define B_RS ((float*)(ws + WS_SCL))
#define B_SWIN ((const float*)(ws + WS_SCL) + 16384)
#define B_SWGU ((const float*)(ws + WS_SCL) + 32768)
#define W_GUQ ((const pg8::bf16_t*)(ws + WS_W + WO_GU))
#define W_DOWN_T ((f16*)(ws + WS_W + WO_DOWN))
#define W_OUT_T ((f16*)(ws + WS_W + WO_OUT))
#define W_AUP_T ((f16*)(ws + WS_W + WO_AUP))
#define W_BUP_T ((f16*)(ws + WS_W + WO_BUP))
#define B_XA ((float*)(ws + WS_X))
#define B_H ((f16*)(ws + WS_H))
#define B_OB ((f16*)(ws + WS_H))
#define B_YB ((f16*)(ws + WS_H + 48 * MiB))
#define B_QLAT ((f16*)(ws + WS_ZA + ZO_QLAT))
#define B_QI ((f16*)(ws + WS_ZA + ZO_QI))
#define B_CKV ((f16*)(ws + WS_ZA + ZO_CKV))
#define B_KW ((f16*)(ws + WS_ZA + ZO_KW))
#define B_ZB ((f16*)(ws + WS_ZB))
#define B_ZG ((f16*)(ws + WS_ZG))
#define B_SC ((float*)(ws + WS_ZB))
#define B_OLAT ((f16*)(ws + WS_ZB))
#define B_MERGED ((f16*)(ws + WS_ZB + 64 * MiB))
#define B_ACT ((f16*)(ws + WS_ZA))
#define B_LSE ((float*)(ws + WS_LSE))
#define B_IDX ((u16*)(ws + WS_IDX))
#define B_ROPE ((const f32x2*)(ws + WS_ROPE))
#define B_LUT ((const unsigned char*)(ws + WS_LUT))
#define B_MOD ((const float*)(ws + WS_MOD) + (size_t)l * NB * 12288)
#define X_IN (l == 0 ? ap->in[0] : (const float*)ap->out)
#ifndef REPMASK
#define REPMASK 0
#endif
#define RUN(k, ...) do { { PH_IDS; __VA_ARGS__ } if ((REPMASK >> (k)) & 1) { PH_IDS; __VA_ARGS__ } } while (0)
template <int l> __device__ __forceinline__ void layer_body(LAS unsigned char* lds, const int tid0, const int lo, const int hi, const XcdBarrier& bar) {
    const int pb = 12 * l;
    if (IN(pb + 0)) { RUN(0, Ptrs P;
        P.x = ap->in[0]; P.c = ap->in[1]; P.rel_bias = ap->in[2]; P.w_ada = ap->in[3]; P.b_ada = ap->in[4]; P.norm1_g = ap->in[5]; P.w_in = ap->in[6]; P.kv_norm_g = ap->in[7];
        P.idx_ln_g = ap->in[8]; P.idx_ln_b = ap->in[9]; P.w_uk = ap->in[10]; P.w_uv = ap->in[11]; P.w_a_up = ap->in[12]; P.w_b_up = ap->in[13]; P.w_out = ap->in[14]; P.norm2_g = ap->in[15];
        P.w_ff_gate = ap->in[16]; P.w_ff_up = ap->in[17]; P.w_ff_down = ap->in[18]; P.final_g = ap->in[19]; P.out = ap->out; P.ws = ws;
        p0_phase(P, l, lds, tid, lane, wave, G, bx);); SEAM(pb + 0); }
    if (IN(pb + 1)) { RUN(1, norm_mod_phase<true>(X_IN, ap->in[5] + (size_t)l * D, B_MOD, B_MOD + D, B_H, B_H8, B_RS, lane, wave, G, bx);); SEAM(pb + 1); }
    if (IN(pb + 2)) { RUN(2,
        { pg8::Gemm g{(const pg8::bf16_t*)B_H8, W_INQ, M, NQ, D / 2}; pg8::StaticOrder S; S.init(M, NQ, G, bx); pg8::EpiInQ E{B_CKV, B_ZB, B_ZG, B_RS, B_SWIN};
          pg8::gemm_phase<pg8::EpiInQ, pg8::StaticOrder, true, true, true>(lds, g, S, E); }
        __syncthreads();
        { int tb2 = tid; asm volatile("" : "+v"(tb2)); (void)tb2; pg8::Gemm g{B_H, W_INF_T, M, NF, D}; pg8::StaticOrder S; S.init(M, NF, G, G == 256 ? ((bx + 64) & 255) : bx);
          pg8::EpiInF E{B_QLAT, B_QI, B_KW}; pg8::gemm_phase<pg8::EpiInF, pg8::StaticOrder, true, true, false>(lds, g, S, E); }
        __syncthreads();); SEAM(pb + 2); }
    if (IN(pb + 3)) { if ((REPMASK >> 14) & 1) { PH_IDS; zfix_phase((f16*)(ws + WS_X), (f16*)(ws + WS_X) + 8 * MiB, (f16*)(ws + WS_X) + 32 * MiB, ap->in[7] + (size_t)l * 256, ap->in[8] + (size_t)l * 64, ap->in[9] + (size_t)l * 64, B_ROPE, lane, wave, G, bx); }
        { PH_IDS; zfix_phase(B_CKV, B_QI, B_KW, ap->in[7] + (size_t)l * 256, ap->in[8] + (size_t)l * 64, ap->in[9] + (size_t)l * 64, B_ROPE, lane, wave, G, bx); }
        RUN(3, battn_phase(B_ZB, ap->in[2], B_LUT, B_OB, B_LSE, lds, tid, lane, wave, G, bx);); SEAM(pb + 3); }
    if (IN(pb + 4)) { RUN(4, score_phase(B_QI, B_KW, B_SC, lane, wave, G, bx);); SEAM(pb + 4); }
    if (IN(pb + 5)) { RUN(5, select_phase(B_SC, B_IDX, lane, wave, G, bx);); RUN(13, bmerge_phase(B_OB, B_LSE, B_YB, lane, wave, G, bx);); SEAM(pb + 5); }
    if (IN(pb + 6)) { RUN(6, dsa_phase<0>(B_QLAT, B_CKV, B_IDX, ap->in[2], B_LUT, B_OLAT, lds, tid, lane, wave, G, bx););
        if ((REPMASK >> 15) & 1) { PH_IDS; dsa_phase<1>(B_QLAT, B_CKV, B_IDX, ap->in[2], B_LUT, (f16*)(ws + WS_X), lds, tid, lane, wave, G, bx); }
        if ((REPMASK >> 16) & 1) { PH_IDS; dsa_phase<2>(B_QLAT, B_CKV, B_IDX, ap->in[2], B_LUT, (f16*)(ws + WS_X), lds, tid, lane, wave, G, bx); } SEAM(pb + 6); }
    if (IN(pb + 7)) { RUN(7,
        { pg8::Gemm g{B_OLAT, W_AUP_T, M, D, D}; pg8::StaticOrder S; S.init(M, D, G, bx); pg8::EpiGate<0> E{B_ZG, B_MERGED};
          pg8::gemm_phase<pg8::EpiGate<0>, pg8::StaticOrder, true, true>(lds, g, S, E); }
        __syncthreads();
        { int tb2 = tid; asm volatile("" : "+v"(tb2)); (void)tb2; pg8::Gemm g{B_YB, W_BUP_T, M, D, 512}; pg8::StaticOrder S; S.init(M, D, G, bx); pg8::EpiGate<1> E{B_ZG, B_MERGED};
          pg8::gemm_phase<pg8::EpiGate<1>, pg8::StaticOrder, true, true>(lds, g, S, E); }
        __syncthreads();); SEAM(pb + 7); }
    if (IN(pb + 8)) { RUN(8, pg8::Gemm g{B_MERGED, W_OUT_T, M, D, D}; pg8::StaticOrder S; S.init(M, D, G, bx); pg8::EpiResid E{X_IN, B_XA, B_MOD + 2 * D};
        pg8::gemm_phase<pg8::EpiResid, pg8::StaticOrder, true, true>(lds, g, S, E);); SEAM(pb + 8); }
    if (IN(pb + 9)) { RUN(9, norm_mod_phase<false>(B_XA, ap->in[15] + (size_t)l * D, B_MOD + 3 * D, B_MOD + 4 * D, B_H, B_H8, B_RS, lane, wave, G, bx);); SEAM(pb + 9); }
    if (IN(pb + 10)) { RUN(10, pg8::Gemm g{(const pg8::bf16_t*)B_H8, W_GUQ, M, NGU, D / 2}; pg8::StaticOrder S; S.init(M, NGU, G, bx); pg8::EpiSwiGLU E{B_ACT, B_RS, B_SWGU};
        pg8::gemm_phase<pg8::EpiSwiGLU, pg8::StaticOrder, true, true, true>(lds, g, S, E);); SEAM(pb + 10); }
    if (IN(pb + 11)) { RUN(11, pg8::Gemm g{B_ACT, W_DOWN_T, M, D, DFF}; pg8::StaticOrder S; S.init(M, D, G, bx); pg8::EpiResid E{B_XA, ap->out, B_MOD + 5 * D};
        pg8::gemm_phase<pg8::EpiResid, pg8::StaticOrder, true, true>(lds, g, S, E);); SEAM(pb + 11); }
}
__global__ void __launch_bounds__(NWAVES * 64, 2) fwd(Args args) {
    extern __shared__ __attribute__((aligned(16))) unsigned char lds_raw[];
    LAS unsigned char* lds = (LAS unsigned char*)lds_raw;
    const int tid0 = threadIdx.x;
    for (int u = tid0; u < (LDS_BYTES - LDSCTL_OFF) / 4; u += NWAVES * 64) ((LAS unsigned*)(lds + LDSCTL_OFF))[u] = 0u;
    __syncthreads();
    const int lo = args.ph_lo, hi = args.ph_hi;
    XcdBarrier bar; bar.bar = (unsigned*)(args.ws + WS_CTL) + CW_BAR; bar.x = 0; bar.st = nullptr;
    if (hi - lo > 1) bar = xcd_barrier_post((unsigned*)(args.ws + WS_CTL) + CW_BAR, (volatile LAS unsigned*)(lds + MISC_OFF) + 8);
    layer_body<0>(lds, tid0, lo, hi, bar);
    layer_body<1>(lds, tid0, lo, hi, bar);
    if (IN(12 * DEPTH)) { PH_IDS; final_norm_phase(ap->out, ap->in[19], lane, wave, G, bx); }
#undef IN
#undef SEAM
}

extern "C" void kernel_launch(void* const* d_in, const int* in_sizes, int n_in, void* d_out, int out_size, void* d_ws, size_t ws_size, hipStream_t stream) {
    static int grid = 0;
    if (grid == 0) {
        if (n_in != 20 || in_sizes[0] != M * D || out_size != M * D || ws_size < WS_END) { fprintf(stderr, "kernel_launch: built for 20 inputs, x/out of %d floats, >= %zu bytes of workspace; got n_in %d, in0 %d, out %d, ws %zu; nothing launched\n", M * D, (size_t)WS_END, n_in, n_in > 0 ? in_sizes[0] : -1, out_size, ws_size); grid = -1; return; }
        int dev = 0, cus = 0, per_cu = 0;
        if (hipGetDevice(&dev) != hipSuccess || hipDeviceGetAttribute(&cus, hipDeviceAttributeMultiprocessorCount, dev) != hipSuccess) { fprintf(stderr, "kernel_launch: device query failed\n"); grid = -1; return; }
        if (hipFuncSetAttribute((const void*)fwd, hipFuncAttributeMaxDynamicSharedMemorySize, LDS_BYTES) != hipSuccess) { fprintf(stderr, "kernel_launch: hipFuncSetAttribute failed\n"); grid = -1; return; }
        if (hipOccupancyMaxActiveBlocksPerMultiprocessor(&per_cu, (const void*)fwd, NWAVES * 64, LDS_BYTES) != hipSuccess || per_cu < 1)
            fprintf(stderr, "kernel_launch: note: occupancy query reports %d workgroups per CU\n", per_cu);
        (void)hipGetLastError();
        grid = cus;
    }
    if (grid < 0) return;
    if (hipMemsetAsync((char*)d_ws + WS_CTL, 0, CTL_ZERO_BYTES, stream) != hipSuccess) { fprintf(stderr, "kernel_launch: memset failed\n"); return; }
    Args a{};
    for (int i = 0; i < 20; ++i) a.in[i] = (const float*)d_in[i];
    a.out = (float*)d_out; a.ws = (unsigned char*)d_ws;
#if MK_PER_PHASE
    for (int p = 0; p < N_PHASES; ++p) { a.ph_lo = p; a.ph_hi = p + 1; hipLaunchKernelGGL(fwd, dim3(grid), dim3(NWAVES * 64), LDS_BYTES, stream, a); }
#else
    a.ph_lo = 0; a.ph_hi = N_PHASES;
    hipLaunchKernelGGL(fwd, dim3(grid), dim3(NWAVES * 64), LDS_BYTES, stream, a);
#endif
    const hipError_t le = hipPeekAtLastError();
    if (le != hipSuccess) fprintf(stderr, "kernel_launch: launch failed: %s\n", hipGetErrorName(le));
}
```

```cpp
#include <hip/hip_runtime.h>
#include <cstdio>
#include <cstdint>

#define LAS __attribute__((address_space(3)))
#define GAS __attribute__((address_space(1)))
typedef _Float16 f16;
typedef _Float16 f16x2 __attribute__((ext_vector_type(2)));
typedef _Float16 f16x4 __attribute__((ext_vector_type(4)));
typedef _Float16 f16x8 __attribute__((ext_vector_type(8)));
typedef float f32x2 __attribute__((ext_vector_type(2)));
typedef float f32x4 __attribute__((ext_vector_type(4)));
typedef float f32x16 __attribute__((ext_vector_type(16)));
typedef unsigned u32x2 __attribute__((ext_vector_type(2)));
typedef unsigned u32x4 __attribute__((ext_vector_type(4)));
typedef short s16x4 __attribute__((ext_vector_type(4)));
typedef unsigned short u16x8 __attribute__((ext_vector_type(8)));
typedef unsigned short u16;

__device__ __forceinline__ unsigned pkh(float a, float b) { f32x2 v = {a, b}; return __builtin_bit_cast(unsigned, __builtin_convertvector(v, f16x2)); }
__device__ __forceinline__ u32x4 pkh8(f32x4 a, f32x4 b) { u32x4 w; w.x = pkh(a[0], a[1]); w.y = pkh(a[2], a[3]); w.z = pkh(b[0], b[1]); w.w = pkh(b[2], b[3]); return w; }
__device__ __forceinline__ f32x2 unpk(unsigned w) { return __builtin_convertvector(__builtin_bit_cast(f16x2, w), f32x2); }
__device__ __forceinline__ float sigm(float x) { return __builtin_amdgcn_rcpf(1.0f + __expf(-x)); }
__device__ __forceinline__ float wave_sum(float v) {
#pragma unroll
    for (int o = 1; o < 64; o <<= 1) v += __shfl_xor(v, o);
    return v;
}
namespace pg8 {
#define PG8_LAS __attribute__((address_space(3)))
typedef _Float16 bf16_t;
typedef _Float16 bf16x8 __attribute__((ext_vector_type(8)));
typedef float f32x4 __attribute__((ext_vector_type(4)));
typedef unsigned u32x4 __attribute__((ext_vector_type(4)));
constexpr int BM = 256, BK = 64, HALF = 128, HTB = HALF * BK * 2  , STAGE_BYTES = 8 * HTB, NXCD = 8, WGM = 8;

__host__ __device__ __forceinline__ int lds_byte(int r, int c) { const int st = (r >> 4) * 2 + (c >> 5), rr = r & 15, cc = c & 31, ob = rr * 64 + cc * 2; return st * 1024 + (ob ^ (((ob >> 9) & 1) << 5)); }
__host__ __device__ __forceinline__ void stage_rc(int b, int& R, int& C) { const int st = b / 1024, sb = b % 1024, swz = sb ^ (((sb >> 9) & 1) << 5); R = (st >> 1) * 16 + swz / 64; C = (st & 1) * 32 + (swz % 64) / 2; }
__host__ __device__ __forceinline__ int perm32(int rho) { const int n = rho >> 4, i = rho & 15; return 8 * (i >> 2) + 4 * n + (i & 3); }

struct Unit { int pm, pn; };
struct Gemm { const bf16_t* A; const bf16_t* Bt; int M, N, K; };
typedef int i32x4v __attribute__((ext_vector_type(4)));

struct StaticOrder {
    int nM, nN, nwg, G, c;
    __host__ __device__ void init(int M, int N, int G_, int c_) { nM = M / BM; nN = N / BM; nwg = nM * nN; G = G_; c = c_; }
    __host__ __device__ bool next(int i, Unit& u) const {
        const long L = (long)i * G + c; if (L >= nwg) return false;
        int wgid = (int)L; { const int q = nwg / NXCD, r = nwg % NXCD, xcd = wgid % NXCD, off = wgid / NXCD; wgid = (xcd < r ? xcd * (q + 1) : r * (q + 1) + (xcd - r) * q) + off; }
        const int nig = WGM * nN, gid = wgid / nig, fm = gid * WGM, gsz = (nM - fm) < WGM ? (nM - fm) : WGM;
        u.pm = fm + ((wgid % nig) % gsz); u.pn = (wgid % nig) / gsz; return true;
    }
    __device__ __forceinline__ void a_ready(const Unit&) const {}
    __device__ __forceinline__ void done(const Unit&) const {}
};

__device__ __forceinline__ f32x4 i2f4(f32x4 a) { const i32x4v v = __builtin_bit_cast(i32x4v, a); return (f32x4){(float)v[0], (float)v[1], (float)v[2], (float)v[3]}; }
struct EpiInQ {
    static constexpr bool PERM = true, AFTER_DRAIN = false;
    bf16_t *qa, *ckv, *zB, *zG; const float* rs; const float* cs;
    __device__ __forceinline__ void operator()(const f32x4 (&acc)[2][2][4][2], const Unit& u, int wr, int wc, int fr, int fq) const {
        const int row0 = u.pm * BM + wr * 64 + fr; bf16_t* base; int ld, colt; bool sg = false;
        if (u.pn < 4) { base = qa; ld = 1024; colt = u.pn * BM; } else if (u.pn < 5) { base = ckv; ld = 256; colt = 0; } else if (u.pn < 23) { base = zB; ld = 4608; colt = (u.pn - 5) * BM; } else { base = zG; ld = 4096; colt = (u.pn - 23) * BM; sg = true; }
        const int col0 = colt + wc * 32 + 8 * fq; const float* csp = cs + u.pn * BM + wc * 32 + 8 * fq;
        f32x4 cv[2][2];
#pragma unroll
        for (int bj = 0; bj < 2; ++bj)
#pragma unroll
            for (int n = 0; n < 2; ++n) cv[bj][n] = *(const f32x4*)(csp + bj * HALF + 4 * n);
#pragma unroll
        for (int ai = 0; ai < 2; ++ai)
#pragma unroll
            for (int m = 0; m < 4; ++m) { const int row = row0 + ai * HALF + m * 16; const float r = rs[row]; bf16_t* rowp = base + (size_t)row * ld + col0;
#pragma unroll
                for (int bj = 0; bj < 2; ++bj) { f32x4 v0 = i2f4(acc[ai][bj][m][0]) * cv[bj][0] * r, v1 = i2f4(acc[ai][bj][m][1]) * cv[bj][1] * r;
                    if (sg) {
#pragma unroll
                        for (int j = 0; j < 4; ++j) { v0[j] = sigm(v0[j]); v1[j] = sigm(v1[j]); } }
                    *(u32x4*)(rowp + bj * HALF) = pkh8(v0, v1); } }
    }
};
struct EpiInF {
    static constexpr bool PERM = true, AFTER_DRAIN = false;
    bf16_t *qi, *kw;
    __device__ __forceinline__ void operator()(const f32x4 (&acc)[2][2][4][2], const Unit& u, int wr, int wc, int fr, int fq) const {
        bf16_t* base; int ld, colt;
        if (u.pn < 4) { base = qi; ld = 1024; colt = u.pn * BM; } else { base = kw; ld = 256; colt = 0; }
        const int row0 = u.pm * BM + wr * 64 + fr, col0 = colt + wc * 32 + 8 * fq;
#pragma unroll
        for (int ai = 0; ai < 2; ++ai)
#pragma unroll
            for (int m = 0; m < 4; ++m) { bf16_t* rowp = base + (size_t)(row0 + ai * HALF + m * 16) * ld + col0;
#pragma unroll
                for (int bj = 0; bj < 2; ++bj) *(u32x4*)(rowp + bj * HALF) = pkh8(acc[ai][bj][m][0], acc[ai][bj][m][1]); }
    }
};
template <int MODE> struct EpiGate {
    static constexpr bool PERM = true, AFTER_DRAIN = false;
    const bf16_t* zG; bf16_t* out;
    __device__ __forceinline__ void operator()(const f32x4 (&acc)[2][2][4][2], const Unit& u, int wr, int wc, int fr, int fq) const {
        const int row0 = u.pm * BM + wr * 64 + fr, col0 = u.pn * BM + wc * 32 + 8 * fq;
#pragma unroll
        for (int ai = 0; ai < 2; ++ai)
#pragma unroll
            for (int m = 0; m < 4; ++m) { const size_t row = (size_t)(row0 + ai * HALF + m * 16);
#pragma unroll
                for (int bj = 0; bj < 2; ++bj) {
                    const u32x4 gw = *(const u32x4*)(zG + row * 4096 + MODE * 2048 + col0 + bj * HALF);
                    const f32x2 g0 = unpk(gw.x), g1 = unpk(gw.y), g2 = unpk(gw.z), g3 = unpk(gw.w);
                    f32x4 v0 = acc[ai][bj][m][0] * (f32x4){g0.x, g0.y, g1.x, g1.y}, v1 = acc[ai][bj][m][1] * (f32x4){g2.x, g2.y, g3.x, g3.y};
                    bf16_t* op = out + row * 2048 + col0 + bj * HALF;
                    if (MODE == 1) { const u32x4 pw = *(const u32x4*)op; const f32x2 p0 = unpk(pw.x), p1 = unpk(pw.y), p2 = unpk(pw.z), p3 = unpk(pw.w);
                        v0 += (f32x4){p0.x, p0.y, p1.x, p1.y}; v1 += (f32x4){p2.x, p2.y, p3.x, p3.y}; }
                    *(u32x4*)op = pkh8(v0, v1);
                    asm volatile("" ::: "memory"); } }
    }
};
struct EpiResid {
    static constexpr bool PERM = false, AFTER_DRAIN = false;
    const float* xi; float* xo; const float* gate;
    __device__ __forceinline__ void operator()(const f32x4 (&acc)[2][2][4][2], const Unit& u, int wr, int wc, int fr, int fq) const {
        const int row0 = u.pm * BM + wr * 64 + fr, col0 = u.pn * BM + wc * 32 + 4 * fq; const float* gp = gate + (size_t)(u.pm >> 4) * 12288 + col0;
        f32x4 gv[2][2];
#pragma unroll
        for (int bj = 0; bj < 2; ++bj)
#pragma unroll
            for (int n = 0; n < 2; ++n) gv[bj][n] = *(const f32x4*)(gp + bj * HALF + n * 16);
#pragma unroll
        for (int ai = 0; ai < 2; ++ai)
#pragma unroll
            for (int m = 0; m < 4; ++m) { const size_t off = (size_t)(row0 + ai * HALF + m * 16) * 2048 + col0;
#pragma unroll
                for (int bj = 0; bj < 2; ++bj)
#pragma unroll
                    for (int n = 0; n < 2; ++n) *(f32x4*)(xo + off + bj * HALF + n * 16) = *(const f32x4*)(xi + off + bj * HALF + n * 16) + gv[bj][n] * acc[ai][bj][m][n];
                asm volatile("" ::: "memory"); }
    }
};
struct EpiSwiGLU {
    static constexpr bool PERM = true, AFTER_DRAIN = false;
    bf16_t* act; const float* rs; const float* cs;
    __device__ __forceinline__ void operator()(const f32x4 (&acc)[2][2][4][2], const Unit& u, int wr, int wc, int fr, int fq) const {
        const int row0 = u.pm * BM + wr * 64 + fr, col0 = u.pn * HALF + wc * 32 + 8 * fq; const float* csp = cs + u.pn * BM + wc * 32 + 8 * fq;
        f32x4 cv[2][2];
#pragma unroll
        for (int bj = 0; bj < 2; ++bj)
#pragma unroll
            for (int n = 0; n < 2; ++n) cv[bj][n] = *(const f32x4*)(csp + bj * HALF + 4 * n);
#pragma unroll
        for (int ai = 0; ai < 2; ++ai)
#pragma unroll
            for (int m = 0; m < 4; ++m) { f32x4 o[2]; const int row = row0 + ai * HALF + m * 16; const float r = rs[row];
#pragma unroll
                for (int n = 0; n < 2; ++n) { const f32x4 g = i2f4(acc[ai][0][m][n]) * cv[0][n] * r, up = i2f4(acc[ai][1][m][n]) * cv[1][n] * r;
#pragma unroll
                    for (int j = 0; j < 4; ++j) o[n][j] = g[j] * sigm(g[j]) * up[j]; }
                *(u32x4*)(act + (size_t)row * 5632 + col0) = pkh8(o[0], o[1]); }
    }
};
template <class Epi, class Sched, bool ALIGN_EPI = false, bool SP2 = false, bool I8 = false>
__device__ __forceinline__ void gemm_phase(PG8_LAS unsigned char* lds, const Gemm g, const Sched& S, const Epi& E) {
    int tid_ = threadIdx.x; asm volatile("" : "+v"(tid_));
    const int tid = tid_, wid = __builtin_amdgcn_readfirstlane(tid >> 6), lane = tid & 63, wr = wid >> 2, wc = wid & 3, fr = lane & 15, fq = lane >> 4;
    const int K = g.K, nt = K / BK;
    unsigned voffA[2], voffB[2];
#pragma unroll
    for (int i = 0; i < 2; ++i) { int R, C; stage_rc(tid * 16 + i * 8192, R, C); const int Rb = Epi::PERM ? ((R & ~31) + perm32(R & 31)) : R;
        voffA[i] = (unsigned)(R * K + C) * 2u; voffB[i] = (unsigned)(Rb * K + C) * 2u; }
    const size_t kstep = (size_t)(BK * 2);
    const size_t hstep = (size_t)HALF * K * 2;
    const size_t tstep = 2 * hstep;
    const unsigned ldsw = (unsigned)wid * 1024u;
    const int aoff = lds_byte(wr * 64 + fr, fq * 8), boff = lds_byte(wc * 32 + fr, fq * 8);
#define PG8_SA(b, h) (((b) * 2 + (h)) * HTB)
#define PG8_SB(b, h) ((4 + (b) * 2 + (h)) * HTB)
#define PG8_STAGE(bufoff, gbase, voff) do { _Pragma("unroll") for (int _i = 0; _i < 2; ++_i) \
        __builtin_amdgcn_global_load_lds((const unsigned*)((const char*)(gbase) + (voff)[_i]), (PG8_LAS unsigned*)(lds + (bufoff) + ldsw + _i * 8192), 16, 0, 0); } while (0)
#define PG8_LDA(dst, b, h) do { _Pragma("unroll") for (int m = 0; m < 4; ++m) _Pragma("unroll") for (int k = 0; k < 2; ++k) dst[m][k] = *(const PG8_LAS bf16x8*)(lds + PG8_SA(b, h) + aoff + m * 2048 + k * 1024); } while (0)
#define PG8_LDB(dst, b, h) do { _Pragma("unroll") for (int n = 0; n < 2; ++n) _Pragma("unroll") for (int k = 0; k < 2; ++k) dst[n][k] = *(const PG8_LAS bf16x8*)(lds + PG8_SB(b, h) + boff + n * 2048 + k * 1024); } while (0)
#define PG8_MMA(ai, bj, At, Bt) do { __builtin_amdgcn_s_setprio(1); _Pragma("unroll") for (int m = 0; m < 4; ++m) _Pragma("unroll") for (int n = 0; n < 2; ++n) _Pragma("unroll") for (int k = 0; k < 2; ++k) { \
        if constexpr (I8) acc[ai][bj][m][n] = __builtin_bit_cast(f32x4, __builtin_amdgcn_mfma_i32_16x16x64_i8(__builtin_bit_cast(i32x4v, Bt[n][k]), __builtin_bit_cast(i32x4v, At[m][k]), __builtin_bit_cast(i32x4v, acc[ai][bj][m][n]), 0, 0, 0)); \
        else acc[ai][bj][m][n] = __builtin_amdgcn_mfma_f32_16x16x32_f16(Bt[n][k], At[m][k], acc[ai][bj][m][n], 0, 0, 0); } __builtin_amdgcn_s_setprio(0); } while (0)
#define PG8_WAIT_V(n) asm volatile("s_waitcnt vmcnt(" #n ")" ::: "memory")
#define PG8_WAIT_L(n) asm volatile("s_waitcnt lgkmcnt(" #n ")" ::: "memory")
#define PG8_BAR __builtin_amdgcn_s_barrier()
#define PG8_SCHED __builtin_amdgcn_sched_barrier(0)
    Unit cur, nxt; int ui = 0;
    if (!S.next(0, cur)) return;
    f32x4 acc[2][2][4][2];
#pragma unroll
    for (int a = 0; a < 2; ++a)
#pragma unroll
        for (int b = 0; b < 2; ++b)
#pragma unroll
            for (int m = 0; m < 4; ++m)
#pragma unroll
                for (int n = 0; n < 2; ++n) acc[a][b][m][n] = (f32x4){0.f, 0.f, 0.f, 0.f};
    bf16x8 At[4][2], B0[2][2], B1[2][2];
    const char* cA = (const char*)g.A + (size_t)cur.pm * tstep; const char* cB = (const char*)g.Bt + (size_t)cur.pn * tstep;
    S.a_ready(cur);
    if constexpr (SP2) {
        PG8_STAGE(PG8_SB(0, 0), cB, voffB); PG8_STAGE(PG8_SB(0, 1), cB + hstep, voffB); PG8_STAGE(PG8_SA(0, 0), cA, voffA); PG8_STAGE(PG8_SA(0, 1), cA + hstep, voffA);
        if (wr == 1) PG8_BAR;
        PG8_WAIT_V(2); PG8_BAR;
        PG8_STAGE(PG8_SB(1, 0), cB + kstep, voffB); PG8_STAGE(PG8_SA(1, 0), cA + kstep, voffA); PG8_STAGE(PG8_SB(1, 1), cB + hstep + kstep, voffB);
        PG8_WAIT_V(6); PG8_BAR;
    } else {
        PG8_STAGE(PG8_SB(0, 0), cB, voffB); PG8_STAGE(PG8_SA(0, 0), cA, voffA); PG8_STAGE(PG8_SB(0, 1), cB + hstep, voffB); PG8_STAGE(PG8_SA(0, 1), cA + hstep, voffA);
        if (wr == 1) PG8_BAR;
        PG8_WAIT_V(4); PG8_BAR;
        PG8_STAGE(PG8_SB(1, 0), cB + kstep, voffB); PG8_STAGE(PG8_SA(1, 0), cA + kstep, voffA); PG8_STAGE(PG8_SB(1, 1), cB + hstep + kstep, voffB);
        PG8_WAIT_V(6); PG8_BAR;
    }
    for (;;) {
        const bool has_next = S.next(ui + 1, nxt);
        const char* nA = has_next ? (const char*)g.A + (size_t)nxt.pm * tstep : cA; const char* nB = has_next ? (const char*)g.Bt + (size_t)nxt.pn * tstep : cB;
        for (int t = 0; t < nt; t += 2) {
            const bool last = (t == nt - 2);
            const char* a1 = cA + (size_t)(t + 1) * kstep;
            const char* a2 = last ? nA : cA + (size_t)(t + 2) * kstep; const char* b2 = last ? nB : cB + (size_t)(t + 2) * kstep;
            const char* a3 = a2 + kstep; const char* b3 = b2 + kstep;
            if (last && has_next) S.a_ready(nxt);
            if constexpr (SP2) {
            PG8_LDB(B0, 0, 0); PG8_LDB(B1, 0, 1); PG8_SCHED; PG8_LDA(At, 0, 0); PG8_STAGE(PG8_SA(1, 1), a1 + hstep, voffA);
            PG8_WAIT_V(8); PG8_WAIT_L(0); PG8_BAR; PG8_MMA(0, 0, At, B0); PG8_MMA(0, 1, At, B1); PG8_BAR; PG8_SCHED;
            PG8_LDA(At, 0, 1); PG8_STAGE(PG8_SB(0, 0), b2, voffB); PG8_STAGE(PG8_SB(0, 1), b2 + hstep, voffB); PG8_STAGE(PG8_SA(0, 0), a2, voffA);
            PG8_WAIT_V(8); PG8_WAIT_L(0); PG8_BAR; PG8_MMA(1, 0, At, B0); PG8_MMA(1, 1, At, B1); PG8_BAR; PG8_SCHED;
            PG8_LDB(B0, 1, 0); PG8_LDB(B1, 1, 1); PG8_SCHED; PG8_LDA(At, 1, 0); PG8_STAGE(PG8_SA(0, 1), a2 + hstep, voffA);
            PG8_WAIT_V(8); PG8_WAIT_L(0); PG8_BAR; PG8_MMA(0, 0, At, B0); PG8_MMA(0, 1, At, B1); PG8_BAR; PG8_SCHED;
            PG8_LDA(At, 1, 1); PG8_STAGE(PG8_SB(1, 0), b3, voffB); PG8_STAGE(PG8_SB(1, 1), b3 + hstep, voffB); PG8_STAGE(PG8_SA(1, 0), a3, voffA);
            PG8_WAIT_V(8); PG8_WAIT_L(0); PG8_BAR; PG8_MMA(1, 0, At, B0); PG8_MMA(1, 1, At, B1); PG8_BAR; PG8_SCHED;
            } else {
            PG8_LDB(B0, 0, 0); PG8_SCHED; PG8_LDA(At, 0, 0); PG8_STAGE(PG8_SA(1, 1), a1 + hstep, voffA);
            PG8_WAIT_L(8); PG8_BAR; PG8_WAIT_L(0); PG8_MMA(0, 0, At, B0); PG8_BAR; PG8_SCHED;
            PG8_LDB(B1, 0, 1); PG8_STAGE(PG8_SB(0, 0), b2, voffB);
            PG8_BAR; PG8_WAIT_L(0); PG8_MMA(0, 1, At, B1); PG8_BAR;
            PG8_LDA(At, 0, 1); PG8_STAGE(PG8_SA(0, 0), a2, voffA);
            PG8_BAR; PG8_WAIT_L(0); PG8_MMA(1, 0, At, B0); PG8_BAR; PG8_SCHED;
            PG8_STAGE(PG8_SB(0, 1), b2 + hstep, voffB);
            PG8_WAIT_V(6); PG8_BAR; PG8_MMA(1, 1, At, B1); PG8_BAR;
            PG8_LDB(B0, 1, 0); PG8_SCHED; PG8_LDA(At, 1, 0); PG8_STAGE(PG8_SA(0, 1), a2 + hstep, voffA);
            PG8_WAIT_L(8); PG8_BAR; PG8_WAIT_L(0); PG8_MMA(0, 0, At, B0); PG8_BAR; PG8_SCHED;
            PG8_LDB(B1, 1, 1); PG8_STAGE(PG8_SB(1, 0), b3, voffB);
            PG8_BAR; PG8_WAIT_L(0); PG8_MMA(0, 1, At, B1); PG8_BAR;
            PG8_LDA(At, 1, 1); PG8_STAGE(PG8_SA(1, 0), a3, voffA);
            PG8_BAR; PG8_WAIT_L(0); PG8_MMA(1, 0, At, B0); PG8_BAR; PG8_SCHED;
            PG8_STAGE(PG8_SB(1, 1), b3 + hstep, voffB);
            PG8_WAIT_V(6); PG8_BAR; PG8_MMA(1, 1, At, B1); PG8_BAR;
            }
        }
        if constexpr (ALIGN_EPI) { if (wr == 0) PG8_BAR; }
        if constexpr (!Epi::AFTER_DRAIN) { E(acc, cur, wr, wc, fr, fq); S.done(cur); }
        if (!has_next) break;
#pragma unroll
        for (int a = 0; a < 2; ++a)
#pragma unroll
            for (int b = 0; b < 2; ++b)
#pragma unroll
                for (int m = 0; m < 4; ++m)
#pragma unroll
                    for (int n = 0; n < 2; ++n) acc[a][b][m][n] = (f32x4){0.f, 0.f, 0.f, 0.f};
        cur = nxt; cA = nA; cB = nB; ++ui;
        if constexpr (ALIGN_EPI) { if (wr == 1) PG8_BAR; }
    }
    PG8_WAIT_V(0);
    if constexpr (!ALIGN_EPI) { if (wr == 0) PG8_BAR; }
    PG8_BAR;
    if constexpr (Epi::AFTER_DRAIN) { E.fused(acc, cur, wr, wc, fr, fq, lds, wid, lane); S.done(cur); }
#undef PG8_SA
#undef PG8_SB
#undef PG8_STAGE
#undef PG8_LDA
#undef PG8_LDB
#undef PG8_MMA
#undef PG8_WAIT_V
#undef PG8_WAIT_L
#undef PG8_BAR
#undef PG8_SCHED
}
}

constexpr int NB = 4, SEQ = 4096, M = NB * SEQ, D = 2048, DEPTH = 2;
constexpr int N_IN_SRC = 11088, NQ = 9984  , NF = 1280  ;
constexpr int NZA = 3584, NZB = 4608, NZG = 4096, NIN = 12288;
constexpr int KW_W = 64;
constexpr int DFF = 5632, NGU = 2 * DFF;
constexpr int NWAVES = 8;
constexpr float NORM_EPS = 1e-6f, NEG_INF = -1e30f;
constexpr int SC_BATCH = 8650752;

constexpr size_t MiB = 1u << 20;
constexpr size_t WS_CTL = 0, CTL_ZERO_BYTES = 1 * MiB;
constexpr size_t WS_MOD = 1 * MiB;
constexpr size_t WS_ROPE = 2 * MiB;
constexpr size_t WS_LUT = 2 * MiB + 768 * 1024;
constexpr size_t WS_LSE = 3 * MiB;
constexpr size_t WS_IDX = 4 * MiB;
constexpr size_t WS_W = 12 * MiB;
constexpr size_t WO_INQ = 0  , WO_INF = 24 * MiB  , WO_WUK = 32 * MiB  , WO_GU   = 48 * MiB, WO_DOWN = 92 * MiB, WO_OUT = 114 * MiB, WO_AUP = 122 * MiB, WO_BUP = 130 * MiB;
constexpr size_t WS_X = 144 * MiB;
constexpr size_t WS_H = 272 * MiB;
constexpr size_t WS_ZA = 336 * MiB;
constexpr size_t ZO_QLAT = 0, ZO_QI = 64 * MiB, ZO_CKV = 96 * MiB, ZO_KW = 104 * MiB;
constexpr size_t WS_ZB = 448 * MiB;
constexpr size_t WS_ZG = 592 * MiB;
constexpr size_t WS_H8 = 720 * MiB;
constexpr size_t WS_SCL = 2 * MiB + 512 * 1024;
constexpr size_t WS_END = 752 * MiB;
constexpr int CW_BAR = 4096;

constexpr int RING_BYTES = 131072;
constexpr int LDSCTL_OFF = RING_BYTES, MISC_OFF = LDSCTL_OFF + 320;
constexpr int SMALL_OFF = RING_BYTES + 1024;
constexpr int LDS_BYTES = 147456;

__device__ __forceinline__ unsigned off_b(unsigned row, unsigned ch) { return 256u * row + 16u * (ch ^ (((row & 3) << 2) | ((row >> 2) & 3))); }
__device__ __forceinline__ int rel_bucket_of(int n) {
    if (n < 16) return n;
    int b = 16;
    b += (n >= 22) + (n >= 30) + (n >= 40) + (n >= 54) + (n >= 73) + (n >= 99) + (n >= 134) + (n >= 182) + (n >= 246) + (n >= 332) + (n >= 450) + (n >= 609) + (n >= 825) + (n >= 1117) + (n >= 1513);
    return b;
}

struct Ptrs {
    const float *x, *c, *rel_bias, *w_ada, *b_ada, *norm1_g, *w_in, *kv_norm_g, *idx_ln_g, *idx_ln_b, *w_uk, *w_uv, *w_a_up, *w_b_up, *w_out, *norm2_g, *w_ff_gate, *w_ff_up, *w_ff_down, *final_g;
    float* out; unsigned char* ws;
};

__device__ __forceinline__ unsigned pkq4(float a, float b, float c, float d) {
    const int q0 = (int)__builtin_rintf(a), q1 = (int)__builtin_rintf(b), q2 = (int)__builtin_rintf(c), q3 = (int)__builtin_rintf(d);
    return (unsigned)(q0 & 255) | ((unsigned)(q1 & 255) << 8) | ((unsigned)(q2 & 255) << 16) | ((unsigned)q3 << 24); }
template <int MAP> __device__ __forceinline__ int map_row(int n, float& sc) {
    sc = 1.0f;
    if (MAP == 0) {
        if (n < 2304) return n - 1280;
        if (n < 2368) return 1024 + (n - 2304);
        sc = 0.03125f; return 1088 + (n - 2368);
    }
    return n;
}
template <int MAP> __device__ __forceinline__ void transpose_item(const float* W, int ldw, int k0, int n0, int nvalid, f16* WT, int K, LAS float* scr, int lane) {
#pragma unroll 8
    for (int i = 0; i < 32; ++i) { const int kk = 2 * i + (lane >> 5), n = lane & 31; scr[kk * 33 + n] = (n < nvalid) ? W[(size_t)(k0 + kk) * ldw + n0 + n] : 0.0f; }
    asm volatile("s_waitcnt lgkmcnt(0)" ::: "memory");
    const int c = lane & 7;
#pragma unroll
    for (int j = 0; j < 4; ++j) { const int n = (lane >> 3) + 8 * j; const LAS float* s = scr + (8 * c) * 33 + n;
        if (n < nvalid) { float sc; const int row = map_row<MAP>(n0 + n, sc);
            u32x4 o; o.x = pkh(s[0 * 33] * sc, s[1 * 33] * sc); o.y = pkh(s[2 * 33] * sc, s[3 * 33] * sc); o.z = pkh(s[4 * 33] * sc, s[5 * 33] * sc); o.w = pkh(s[6 * 33] * sc, s[7 * 33] * sc);
            *(u32x4*)(WT + (size_t)row * K + k0 + 8 * c) = o; } }
    asm volatile("s_waitcnt lgkmcnt(0)" ::: "memory");
}
__device__ __forceinline__ void quant_item(const float* W, int ldw, int n0, signed char* dst, int r0, float* sw, LAS unsigned char* lds, int tid) {
    LAS float* T = (LAS float*)lds; LAS float* pm = (LAS float*)(lds + SMALL_OFF);
#pragma unroll
    for (int i = 0; i < 16; ++i) { const int q = tid + 512 * i, k = q >> 2, c4 = q & 3; *(LAS f32x4*)(T + k * 16 + 4 * c4) = *(const f32x4*)(W + (size_t)k * ldw + n0 + 4 * c4); }
    __syncthreads();
    const int col = tid & 15, ks = tid >> 4; const LAS float* tp = T + (64 * ks) * 16 + col;
    float mx = 0.f;
#pragma unroll 16
    for (int j = 0; j < 64; ++j) mx = fmaxf(mx, __builtin_fabsf(tp[j * 16]));
    pm[ks * 16 + col] = mx;
    __syncthreads();
    mx = 0.f;
#pragma unroll
    for (int j = 0; j < 32; ++j) mx = fmaxf(mx, pm[j * 16 + col]);
    const float inv = mx > 0.f ? 127.0f / mx : 0.f;
    if (tid < 16) sw[r0 + col] = mx > 0.f ? mx * (1.0f / 127.0f) : 1.0f;
    signed char* dp = dst + (size_t)(r0 + col) * 2048 + 64 * ks;
#pragma unroll
    for (int i = 0; i < 4; ++i) { const LAS float* sp = tp + (16 * i) * 16; u32x4 o;
        o.x = pkq4(sp[0 * 16] * inv, sp[1 * 16] * inv, sp[2 * 16] * inv, sp[3 * 16] * inv); o.y = pkq4(sp[4 * 16] * inv, sp[5 * 16] * inv, sp[6 * 16] * inv, sp[7 * 16] * inv);
        o.z = pkq4(sp[8 * 16] * inv, sp[9 * 16] * inv, sp[10 * 16] * inv, sp[11 * 16] * inv); o.w = pkq4(sp[12 * 16] * inv, sp[13 * 16] * inv, sp[14 * 16] * inv, sp[15 * 16] * inv);
        *(u32x4*)(dp + 16 * i) = o; }
    __syncthreads();
}
__device__ __forceinline__ void minigemm_tile(const float* Asrc, int lda, const float* Bsrc, int ldb, f16* out, int ldo, float scale, LAS unsigned char* lds, int tid) {
    LAS float* As = (LAS float*)lds; LAS float* Bs = (LAS float*)(lds + 32768);
#pragma unroll
    for (int i = 0; i < 4; ++i) { const int q = tid + 512 * i, d = q >> 4, r4 = q & 15; *(LAS f32x4*)(As + d * 64 + 4 * r4) = *(const f32x4*)(Asrc + (size_t)d * lda + 4 * r4); }
#pragma unroll
    for (int i = 0; i < 4; ++i) { const int q = tid + 512 * i, col = q >> 5, d4 = q & 31; const f32x4 v = *(const f32x4*)(Bsrc + (size_t)col * ldb + 4 * d4);
        LAS float* bp = Bs + col * 129 + 4 * d4; bp[0] = v[0]; bp[1] = v[1]; bp[2] = v[2]; bp[3] = v[3]; }
    __syncthreads();
    const int tk = tid & 31, tc = tid >> 5;
    float a0[4] = {0.f, 0.f, 0.f, 0.f}, a1[4] = {0.f, 0.f, 0.f, 0.f};
#pragma unroll 8
    for (int d = 0; d < 128; ++d) { const f32x4 a = *(const LAS f32x4*)(As + d * 64 + 4 * tc); const float b0 = Bs[tk * 129 + d], b1 = Bs[(tk + 32) * 129 + d];
#pragma unroll
        for (int i = 0; i < 4; ++i) { a0[i] += a[i] * b0; a1[i] += a[i] * b1; } }
#pragma unroll
    for (int i = 0; i < 4; ++i) { f16* op = out + (size_t)(4 * tc + i) * ldo + tk; op[0] = (f16)(a0[i] * scale); op[32] = (f16)(a1[i] * scale); }
    __syncthreads();
}
__device__ __forceinline__ void p0_phase(const Ptrs& P, int l, LAS unsigned char* lds, int tid, int lane, int wave, int G, int bx) {
    __syncthreads();
    unsigned char* wsw = P.ws + WS_W;
    signed char* Winq = (signed char*)(wsw + WO_INQ); f16* Winf_t = (f16*)(wsw + WO_INF); signed char* Wguq = (signed char*)(wsw + WO_GU);
    float* sw_in = (float*)(P.ws + WS_SCL) + 16384; float* sw_gu = (float*)(P.ws + WS_SCL) + 32768; f16* Wdown_t = (f16*)(wsw + WO_DOWN); f16* Wout_t = (f16*)(wsw + WO_OUT); f16* Waup_t = (f16*)(wsw + WO_AUP); f16* Wbup_t = (f16*)(wsw + WO_BUP);
    const float* w_in = P.w_in + (size_t)l * D * N_IN_SRC; const float* w_uk = P.w_uk + (size_t)l * 8 * 128 * 256; const float* w_uv = P.w_uv + (size_t)l * 8 * 256 * 128;
    const float* w_a_up = P.w_a_up + (size_t)l * 1024 * D; const float* w_b_up = P.w_b_up + (size_t)l * 512 * D; const float* w_out = P.w_out + (size_t)l * D * D;
    const float* w_g = P.w_ff_gate + (size_t)l * D * DFF; const float* w_u = P.w_ff_up + (size_t)l * D * DFF; const float* w_d = P.w_ff_down + (size_t)l * DFF * D;
    if (l == 0 && bx < 192) {
        LAS float* sc = (LAS float*)lds; LAS float* red = (LAS float*)(lds + 32768);
        for (int i = tid; i < NB * D; i += 512) { const float v = P.c[i]; sc[i] = v / (1.0f + __expf(-v)); }
        __syncthreads();
        float* mod = (float*)(P.ws + WS_MOD);
        for (int it = bx; it < 192; it += G) {
            const int ll = it / 96, col0 = (it % 96) * 128, c4 = lane & 31, kh = lane >> 5;
            const float* wsrc = P.w_ada + (size_t)ll * D * 12288 + col0 + 4 * c4;
            f32x4 a[4];
#pragma unroll
            for (int b = 0; b < 4; ++b) a[b] = (f32x4){0.f, 0.f, 0.f, 0.f};
#pragma unroll 8
            for (int kk = 0; kk < 128; ++kk) { const int k = wave * 256 + 2 * kk + kh; const f32x4 wv = *(const f32x4*)(wsrc + (size_t)k * 12288);
#pragma unroll
                for (int b = 0; b < 4; ++b) a[b] += wv * sc[b * D + k]; }
#pragma unroll
            for (int b = 0; b < 4; ++b) {
#pragma unroll
                for (int e = 0; e < 4; ++e) a[b][e] += __shfl_xor(a[b][e], 32);
                if (kh == 0) *(LAS f32x4*)(red + (wave * 4 + b) * 128 + 4 * c4) = a[b]; }
            __syncthreads();
            { const int b = tid >> 7, col = tid & 127; float s2 = 0.f;
#pragma unroll
              for (int w = 0; w < 8; ++w) s2 += red[(w * 4 + b) * 128 + col];
              mod[(size_t)(ll * 4 + b) * 12288 + col0 + col] = s2 + P.b_ada[(size_t)ll * 12288 + col0 + col]; }
            __syncthreads();
        }
    }
    for (int it = bx; it < 1024; it += G) {
        const int h = it >> 7, rem = it & 127, n0 = (rem >> 2) * 64, c0 = (rem & 3) * 64;
        minigemm_tile(w_a_up + (size_t)(h * 128) * D + n0, D, w_uv + (size_t)(h * 256 + c0) * 128, 128, Waup_t + (size_t)n0 * D + h * 256 + c0, D, 1.0f, lds, tid);
    }
    constexpr int Q_QA = 64, Q_CKV = 16, Q_QKV = 288, Q_GATES = 256, Q_FF = 352, NQITEMS = Q_QA + Q_CKV + Q_QKV + Q_GATES + 2 * Q_FF;
    for (int it = bx; it < NQITEMS; it += G) {
        int r = it; const float* Wsrc = w_in; int ldw = N_IN_SRC, n0, r0; signed char* dq = Winq; float* sq = sw_in;
        if (r < Q_QA) { n0 = 16 * r; r0 = 16 * r; }
        else if ((r -= Q_QA) < Q_CKV) { n0 = 1024 + 16 * r; r0 = 1024 + 16 * r; }
        else if ((r -= Q_CKV) < Q_QKV) { n0 = 2384 + 16 * r; r0 = 1280 + 16 * r; }
        else if ((r -= Q_QKV) < Q_GATES) { n0 = 6992 + 16 * r; r0 = 5888 + 16 * r; }
        else { r -= Q_GATES; const int up = r >= Q_FF; if (up) r -= Q_FF; Wsrc = up ? w_u : w_g; ldw = DFF; n0 = 16 * r; r0 = 256 * (n0 >> 7) + 128 * up + (n0 & 127); dq = Wguq; sq = sw_gu; }
        quant_item(Wsrc, ldw, n0, dq, r0, sq, lds, tid);
    }
    LAS float* scr = (LAS float*)(lds + wave * 16384);
    const int gw = bx * NWAVES + wave, NGW = G * NWAVES;
    constexpr int I_IDX = 32 * 35, I_B = 8 * 64, I_O = 32 * 64, I_D = 88 * 64;
    constexpr int NITEMS = I_IDX + I_B + I_O + I_D;
    for (int it = gw; it < NITEMS; it += NGW) {
        int r = it;
        if (r < I_IDX) { const int kb = r / 35, nb = r % 35, n0 = 1280 + 32 * nb; const int nv = (2384 - n0) < 32 ? (2384 - n0) : 32; transpose_item<0>(w_in, N_IN_SRC, 64 * kb, n0, nv, Winf_t, D, scr, lane); continue; } r -= I_IDX;
        if (r < I_B) { transpose_item<1>(w_b_up, D, 64 * (r / 64), 32 * (r % 64), 32, Wbup_t, 512, scr, lane); continue; } r -= I_B;
        if (r < I_O) { transpose_item<1>(w_out, D, 64 * (r / 64), 32 * (r % 64), 32, Wout_t, D, scr, lane); continue; } r -= I_O;
        transpose_item<1>(w_d, D, 64 * (r / 64), 32 * (r % 64), 32, Wdown_t, DFF, scr, lane);
    }
    const int gt = bx * 512 + tid, NGT = G * 512;
    { u32x4* pz = (u32x4*)(Winf_t + (size_t)1104 * D); for (int i = gt; i < 176 * D / 8; i += NGT) pz[i] = (u32x4){0u, 0u, 0u, 0u}; }
    { f16* wukT = (f16*)(wsw + WO_WUK);
      for (int i = gt; i < 8 * 256 * 16; i += NGT) { const int c = i & 255, d8 = (i >> 8) & 15, h = i >> 12; const float* src = w_uk + (size_t)(h * 128 + 8 * d8) * 256 + c; float v[8];
#pragma unroll
          for (int j = 0; j < 8; ++j) v[j] = src[j * 256] * 0.08838834764831845f;
          *(u32x4*)(wukT + (size_t)(h * 256 + c) * 128 + 8 * d8) = pkh8((f32x4){v[0], v[1], v[2], v[3]}, (f32x4){v[4], v[5], v[6], v[7]}); } }
    if (l == 0) {
        f32x2* rope = (f32x2*)(P.ws + WS_ROPE);
        for (int e = gt; e < SEQ * 16; e += NGT) {
            const int pos = e >> 4, j = e & 15, a = j >> 2, b = j & 3;
            const double fa = a == 0 ? 1.0 : a == 1 ? 0.1 : a == 2 ? 0.01 : 0.001;
            const double fb = b == 0 ? 1.0 : b == 1 ? 0.5623413251903491 : b == 2 ? 0.31622776601683794 : 0.1778279410038923;
            const double ang = (double)pos * (fa * fb);
            const double q = __builtin_rint(ang * 0.15915494309189535);
            const double rr = __builtin_fma(-q, 2.4492935982947064e-16, __builtin_fma(-q, 6.283185307179586, ang));
            const float rf = (float)rr;
            rope[e] = (f32x2){cosf(rf), sinf(rf)};
        }
        unsigned char* lut = P.ws + WS_LUT;
        for (int n = gt; n < SEQ; n += NGT) lut[n] = (unsigned char)rel_bucket_of(n);
    }
}

template <bool F16OUT> __device__ __forceinline__ void norm_mod_phase(const float* x, const float* g, const float* shift, const float* scale, f16* out, signed char* out8, float* rs, int lane, int wave, int G, int bx) {
    const int gw = bx * NWAVES + wave, NGW = G * NWAVES;
    for (int blk = gw; blk < M / 8; blk += NGW) {
        const int row0 = blk * 8, b = row0 >> 12;
        f32x4 ca[8], cs[8];
#pragma unroll
        for (int j = 0; j < 8; ++j) { const int col = 4 * lane + 256 * j; const f32x4 gg = *(const f32x4*)(g + col), sc = *(const f32x4*)(scale + (size_t)b * 12288 + col); ca[j] = gg * (sc + 1.0f); cs[j] = *(const f32x4*)(shift + (size_t)b * 12288 + col); }
        for (int r = 0; r < 8; ++r) {
            const float* xr = x + (size_t)(row0 + r) * D + 4 * lane; f32x4 v[8]; float ss = 0.f;
#pragma unroll
            for (int j = 0; j < 8; ++j) { v[j] = *(const f32x4*)(xr + 256 * j); ss += (v[j].x * v[j].x + v[j].y * v[j].y) + (v[j].z * v[j].z + v[j].w * v[j].w); }
            const float rstd = 1.0f / sqrtf(wave_sum(ss) * (1.0f / D) + NORM_EPS);
            f16* orow = out + (size_t)(row0 + r) * D + 4 * lane; float mx = 0.f;
#pragma unroll
            for (int j = 0; j < 8; ++j) { const f32x4 o = v[j] * rstd * ca[j] + cs[j]; v[j] = o; mx = fmaxf(fmaxf(mx, fmaxf(__builtin_fabsf(o.x), __builtin_fabsf(o.y))), fmaxf(__builtin_fabsf(o.z), __builtin_fabsf(o.w)));
                if (F16OUT) { u32x2 w; w.x = pkh(o.x, o.y); w.y = pkh(o.z, o.w); *(u32x2*)(orow + 256 * j) = w; } }
#pragma unroll
            for (int o = 1; o < 64; o <<= 1) mx = fmaxf(mx, __shfl_xor(mx, o));
            const float inv = mx > 0.f ? 127.0f / mx : 0.f;
            if (lane == 0) rs[row0 + r] = mx > 0.f ? mx * (1.0f / 127.0f) : 1.0f;
            signed char* qrow = out8 + (size_t)(row0 + r) * D + 4 * lane;
#pragma unroll
            for (int j = 0; j < 8; ++j) *(unsigned*)(qrow + 256 * j) = pkq4(v[j].x * inv, v[j].y * inv, v[j].z * inv, v[j].w * inv);
        }
    }
}
__device__ __forceinline__ void final_norm_phase(float* xo, const float* g, int lane, int wave, int G, int bx) {
    const int gw = bx * NWAVES + wave, NGW = G * NWAVES;
    f32x4 cg[8];
#pragma unroll
    for (int j = 0; j < 8; ++j) cg[j] = *(const f32x4*)(g + 4 * lane + 256 * j);
    for (int row = gw; row < M; row += NGW) {
        float* xr = xo + (size_t)row * D + 4 * lane; f32x4 v[8]; float ss = 0.f;
#pragma unroll
        for (int j = 0; j < 8; ++j) { v[j] = *(const f32x4*)(xr + 256 * j); ss += (v[j].x * v[j].x + v[j].y * v[j].y) + (v[j].z * v[j].z + v[j].w * v[j].w); }
        const float rstd = 1.0f / sqrtf(wave_sum(ss) * (1.0f / D) + NORM_EPS);
#pragma unroll
        for (int j = 0; j < 8; ++j) *(f32x4*)(xr + 256 * j) = v[j] * rstd * cg[j];
    }
}

__device__ __forceinline__ void qlat_phase(const f16* qa, const f16* wukT, f16* qlat, int lane, int wave, int G, int bx) {
    const int gw = bx * NWAVES + wave, NGW = G * NWAVES, l15 = lane & 15, g4 = lane >> 4;
    for (int it = gw; it < (M / 64) * 8; it += NGW) {
        const int h = it & 7, t0 = (it >> 3) * 64;
        f16x8 bq[4][4];
#pragma unroll
        for (int tt = 0; tt < 4; ++tt)
#pragma unroll
            for (int k = 0; k < 4; ++k) bq[tt][k] = *(const f16x8*)(qa + (size_t)(t0 + 16 * tt + l15) * 1024 + h * 128 + 32 * k + 8 * g4);
        const f16* wp = wukT + (size_t)(h * 256 + l15) * 128 + 8 * g4;
        f16* op = qlat + (size_t)(t0 + l15) * 2048 + h * 256 + 4 * g4;
#pragma unroll 4
        for (int ct = 0; ct < 16; ++ct) {
            f16x8 aw[4];
#pragma unroll
            for (int k = 0; k < 4; ++k) aw[k] = *(const f16x8*)(wp + (size_t)(16 * ct) * 128 + 32 * k);
#pragma unroll
            for (int tt = 0; tt < 4; ++tt) { f32x4 acc = {0.f, 0.f, 0.f, 0.f};
#pragma unroll
                for (int k = 0; k < 4; ++k) acc = __builtin_amdgcn_mfma_f32_16x16x32_f16(aw[k], bq[tt][k], acc, 0, 0, 0);
                u32x2 w; w.x = pkh(acc[0], acc[1]); w.y = pkh(acc[2], acc[3]); *(u32x2*)(op + (size_t)(16 * tt) * 2048 + 16 * ct) = w; }
        }
    }
}

__device__ __forceinline__ void zfix_phase(f16* ckv, f16* qi, f16* kw, const float* kvg, const float* lng, const float* lnb, const f32x2* rope, int lane, int wave, int G, int bx) {
    const int gw = bx * NWAVES + wave, NGW = G * NWAVES;
    const f32x4 g4 = *(const f32x4*)(kvg + 4 * lane); const float lg = lng[lane], lb = lnb[lane];
    for (int blk = gw; blk < M / 8; blk += NGW)
        for (int r = 0; r < 8; ++r) {
            const int row = blk * 8 + r, pos = row & (SEQ - 1);
            { f16* z = ckv + (size_t)row * 256 + 4 * lane; const u32x2 w = *(const u32x2*)z; const f32x2 a = unpk(w.x), b = unpk(w.y);
              const float ss = wave_sum((a.x * a.x + a.y * a.y) + (b.x * b.x + b.y * b.y)); const float rstd = 1.0f / sqrtf(ss * (1.0f / 256.0f) + NORM_EPS);
              u32x2 o; o.x = pkh(a.x * rstd * g4.x, a.y * rstd * g4.y); o.y = pkh(b.x * rstd * g4.z, b.y * rstd * g4.w); *(u32x2*)z = o; }
            { f16* z = qi + (size_t)row * 1024 + 16 * lane; const u32x4 w0 = *(const u32x4*)z, w1 = *(const u32x4*)(z + 8);
              const unsigned mine[8] = {w0.x, w0.y, w0.z, w0.w, w1.x, w1.y, w1.z, w1.w}; unsigned res[8]; const int seg = lane & 3;
#pragma unroll
              for (int i = 0; i < 8; ++i) { const unsigned oth = (unsigned)__shfl_xor((int)mine[i], 1); const f32x2 me = unpk(mine[i]), ot = unpk(oth);
                  const f32x2 cs0 = rope[pos * 16 + 2 * i], cs1 = rope[pos * 16 + 2 * i + 1];
                  float r0, r1;
                  if (seg == 0) { r0 = me.x * cs0.x - ot.x * cs0.y; r1 = me.y * cs1.x - ot.y * cs1.y; }
                  else          { r0 = ot.x * cs0.y + me.x * cs0.x; r1 = ot.y * cs1.y + me.y * cs1.x; }
                  res[i] = seg < 2 ? pkh(r0, r1) : mine[i]; }
              *(u32x4*)z = (u32x4){res[0], res[1], res[2], res[3]}; *(u32x4*)(z + 8) = (u32x4){res[4], res[5], res[6], res[7]}; }
            { f16* z = kw + (size_t)row * 256 + lane; const float xv = (float)z[0]; const float mu = wave_sum(xv) * (1.0f / 64.0f); const float dv = xv - mu; const float var = wave_sum(dv * dv) * (1.0f / 64.0f);
              const float y = dv * (1.0f / sqrtf(var + NORM_EPS)) * lg + lb; const float oth = __shfl_xor(y, 16); const f32x2 cs = rope[pos * 16 + (lane & 15)];
              float o = y; if (lane < 16) o = y * cs.x - oth * cs.y; else if (lane < 32) o = oth * cs.y + y * cs.x;
              z[0] = (f16)o; }
        }
}

__device__ __forceinline__ void battn_phase(const f16* zB, const float* rel_bias, const unsigned char* lut, f16* ob, float* lse, LAS unsigned char* lds, int tid, int lane, int wave, int G, int bx) {
    LAS unsigned char* Kimg = lds; LAS unsigned char* Vimg = lds + 65536; LAS float* tb = (LAS float*)(lds + SMALL_OFF);
    const int g4 = lane >> 4, q15 = lane & 15;
    for (int uid = bx; uid < NB * 3 * 4 * 32; uid += G) {
        const int s = uid & 31, j = (uid >> 5) & 3, grp = (uid >> 7) % 3, b = uid / 384;
        const int dsh = 2 * grp, r = s & ((1 << dsh) - 1), n = s >> dsh;
        const f16* zb = zB + (size_t)b * SEQ * NZB; const int colQ = (grp * 4 + j) * 128, colK = ((3 + grp) * 4 + j) * 128, colV = ((6 + grp) * 4 + j) * 128;
#pragma unroll
        for (int i = 0; i < 8; ++i) { const int cidx = tid + 512 * i, u = cidx >> 4, ch = cidx & 15, mk = (n - 1) * 128 + u;
            u32x4 kv = {0u, 0u, 0u, 0u}, vv = {0u, 0u, 0u, 0u};
            if (mk >= 0) { const f16* rp = zb + (size_t)((mk << dsh) + r) * NZB + ch * 8; kv = *(const u32x4*)(rp + colK); vv = *(const u32x4*)(rp + colV); }
            *(LAS u32x4*)(Kimg + off_b(u, ch)) = kv; *(LAS u32x4*)(Vimg + off_b(u, ch)) = vv; }
        if (tid <= 128) tb[tid] = rel_bias[(int)lut[tid << dsh] * 20 + 8 + grp * 4 + j];
        __syncthreads();
        const int iq = 16 * wave + q15, tq = ((n * 128 + iq) << dsh) + r;
        const f16* qp = zb + (size_t)tq * NZB + colQ + 8 * g4;
        f16x8 qf[4];
#pragma unroll
        for (int k = 0; k < 4; ++k) qf[k] = *(const f16x8*)(qp + 32 * k);
        const int kstart = 32 * (wave >> 1);
        const int back0 = iq + 128 - (kstart + 8 * g4); const unsigned bmax = n > 0 ? 128u : (unsigned)iq;
        f32x4 sreg[5][2]; float mx = NEG_INF;
#pragma unroll
        for (int T = 0; T < 5; ++T)
#pragma unroll
            for (int hf = 0; hf < 2; ++hf) {
                const int krow = kstart + 32 * T + 8 * (q15 >> 2) + 4 * hf + (q15 & 3);
                f32x4 acc = {0.f, 0.f, 0.f, 0.f};
#pragma unroll
                for (int k = 0; k < 4; ++k) { const f16x8 kf = *(const LAS f16x8*)(Kimg + off_b(krow, 4 * k + g4)); acc = __builtin_amdgcn_mfma_f32_16x16x32_f16(kf, qf[k], acc, 0, 0, 0); }
#pragma unroll
                for (int e = 0; e < 4; ++e) { const unsigned back = (unsigned)(back0 - (32 * T + 4 * hf + e));
                    const bool valid = back <= bmax; const unsigned bi = back < 128u ? back : 128u;
                    const float sv = valid ? acc[e] * 0.08838834764831845f + tb[bi] : NEG_INF; acc[e] = sv; mx = fmaxf(mx, sv); }
                sreg[T][hf] = acc; }
        mx = fmaxf(mx, __shfl_xor(mx, 16)); mx = fmaxf(mx, __shfl_xor(mx, 32));
        float den = 0.f; f16x8 pf[5];
#pragma unroll
        for (int T = 0; T < 5; ++T) { float p[8];
#pragma unroll
            for (int e = 0; e < 8; ++e) { p[e] = __expf(sreg[T][e >> 2][e & 3] - mx); den += p[e]; }
            const u32x4 w = pkh8((f32x4){p[0], p[1], p[2], p[3]}, (f32x4){p[4], p[5], p[6], p[7]}); pf[T] = __builtin_bit_cast(f16x8, w); }
        den += __shfl_xor(den, 16); den += __shfl_xor(den, 32);
        const float rden = 1.0f / den;
        f16* op = ob + ((size_t)grp * M + (size_t)b * SEQ + tq) * 512 + j * 128 + 4 * g4;
        const unsigned trq = (unsigned)(q15 >> 2), trp = (unsigned)(lane & 3);
#pragma unroll
        for (int c = 0; c < 8; ++c) { f32x4 acc = {0.f, 0.f, 0.f, 0.f};
#pragma unroll
            for (int T = 0; T < 5; ++T) {
                const unsigned r0 = (unsigned)(kstart + 32 * T + 8 * g4) + trq;
                const s16x4 t0 = __builtin_amdgcn_ds_read_tr16_b64_v4i16((LAS s16x4*)(Vimg + off_b(r0, 2 * c + (trp >> 1)) + 8 * (trp & 1)));
                const s16x4 t1 = __builtin_amdgcn_ds_read_tr16_b64_v4i16((LAS s16x4*)(Vimg + off_b(r0 + 4, 2 * c + (trp >> 1)) + 8 * (trp & 1)));
                const f16x8 vf = __builtin_bit_cast(f16x8, __builtin_shufflevector(t0, t1, 0, 1, 2, 3, 4, 5, 6, 7));
                acc = __builtin_amdgcn_mfma_f32_16x16x32_f16(vf, pf[T], acc, 0, 0, 0); }
            u32x2 w; w.x = pkh(acc[0] * rden, acc[1] * rden); w.y = pkh(acc[2] * rden, acc[3] * rden); *(u32x2*)(op + 16 * c) = w; }
        if (lane < 16) lse[((size_t)grp * M + (size_t)b * SEQ + tq) * 4 + j] = mx + __logf(den);
        __syncthreads();
    }
}

__device__ __forceinline__ void score_phase(const f16* qi, const f16* kw, float* S, LAS unsigned char* lds, int tid, int lane, int wave, int G, int bx) {
    const int wq = wave & 3, wk = wave >> 2, l31 = lane & 31, lh = lane >> 5;
    LAS unsigned char* qbuf = lds + 32768; LAS f16* wS = (LAS f16*)(lds + 98304);
    for (int uid = (int)(((long)bx * (NB * 272)) / G), uend = (int)(((long)(bx + 1) * (NB * 272)) / G); uid < uend; ++uid) {
        const int b = uid / 272; int rem = uid % 272, qb = 0;
        for (;;) { const int cnt = (qb + 2) >> 1; if (rem < cnt) break; rem -= cnt; ++qb; }
        const f16* qrow0 = qi + (size_t)(b * SEQ + qb * 128) * 1024;
#define SC_DMA(hp, buf) do { _Pragma("unroll") for (int i_ = 0; i_ < 4; ++i_) { const int ii_ = 4 * wave + i_, j_ = ii_ >> 4, q_ = 8 * (ii_ & 15) + (lane >> 3), c_ = (lane & 7) ^ (q_ & 7); \
            __builtin_amdgcn_global_load_lds((const unsigned*)(qrow0 + (size_t)q_ * 1024 + (2 * (hp) + j_) * 64 + 8 * c_), (LAS unsigned*)(qbuf + (buf) * 32768 + ii_ * 1024), 16, 0, 0); } } while (0)
#pragma unroll
        for (int i = 0; i < 4; ++i) { const int q = tid + 512 * i, key = q >> 3, ch = q & 7; const int kg = 2 * rem * 128 + key;
            const u32x4 v = *(const u32x4*)(kw + (size_t)(b * SEQ + (kg < SEQ ? kg : SEQ - 1)) * 256 + 8 * ch);
            *(LAS u32x4*)(lds + key * 128 + ((ch ^ (key & 7)) << 4)) = v; }
        if (tid < 256) *(LAS u32x4*)(wS + (tid >> 1) * 16 + 8 * (tid & 1)) = *(const u32x4*)(kw + (size_t)(b * SEQ + qb * 128 + (tid >> 1)) * 256 + KW_W + 8 * (tid & 1));
        SC_DMA(0, 0);
        asm volatile("s_waitcnt vmcnt(0)" ::: "memory");
        __syncthreads();
        const int kb = 2 * rem + wk; const bool act = kb <= qb;
        f32x16 sc[4];
#pragma unroll
        for (int tl = 0; tl < 4; ++tl)
#pragma unroll
            for (int e = 0; e < 16; ++e) sc[tl][e] = 0.f;
        const LAS unsigned char* kbase = lds + (wk * 128 + l31) * 128;
        const int ql = 32 * wq + l31;
#pragma nounroll
        for (int hp = 0; hp < 8; ++hp) {
            if (hp < 7) SC_DMA(hp + 1, (hp + 1) & 1);
            if (act) {
                const LAS unsigned char* qb_ = qbuf + (hp & 1) * 32768 + ql * 128;
                f16x8 qf[2][4]; float wh[2];
#pragma unroll
                for (int j = 0; j < 2; ++j) {
#pragma unroll
                    for (int k = 0; k < 4; ++k) qf[j][k] = *(const LAS f16x8*)(qb_ + j * 16384 + (((2 * k + lh) ^ (ql & 7)) << 4));
                    wh[j] = (float)wS[ql * 16 + 2 * hp + j]; }
#pragma unroll
                for (int tl = 0; tl < 4; ++tl) {
                    f32x16 a[2];
#pragma unroll
                    for (int j = 0; j < 2; ++j)
#pragma unroll
                        for (int e = 0; e < 16; ++e) a[j][e] = 0.f;
#pragma unroll
                    for (int k = 0; k < 4; ++k) { const f16x8 kf = *(const LAS f16x8*)(kbase + tl * 4096 + (((2 * k + lh) ^ (l31 & 7)) << 4));
#pragma unroll
                        for (int j = 0; j < 2; ++j) a[j] = __builtin_amdgcn_mfma_f32_32x32x16_f16(kf, qf[j][k], a[j], 0, 0, 0); }
#pragma unroll
                    for (int j = 0; j < 2; ++j) { typedef int i32x16 __attribute__((ext_vector_type(16)));
                        const i32x16 zi = {0, 0, 0, 0, 0, 0, 0, 0, 0, 0, 0, 0, 0, 0, 0, 0};
                        const f32x16 r = __builtin_bit_cast(f32x16, __builtin_elementwise_max(__builtin_bit_cast(i32x16, a[j]), zi));
                        sc[tl] += r * wh[j]; }
                }
            }
            asm volatile("s_waitcnt vmcnt(0)" ::: "memory");
            __syncthreads();
        }
#undef SC_DMA
        if (act) {
            float* sp = S + (size_t)b * SC_BATCH + (size_t)16384 * (qb * (qb + 1) / 2) + (size_t)ql * ((qb + 1) * 128) + kb * 128 + 4 * lh;
#pragma unroll
            for (int tl = 0; tl < 4; ++tl)
#pragma unroll
                for (int a4 = 0; a4 < 4; ++a4) *(f32x4*)(sp + 32 * tl + 8 * a4) = (f32x4){sc[tl][4 * a4], sc[tl][4 * a4 + 1], sc[tl][4 * a4 + 2], sc[tl][4 * a4 + 3]};
        }
    }
}

__device__ __forceinline__ unsigned ord_key(float x) { const unsigned u = __builtin_bit_cast(unsigned, x); return u ^ ((unsigned)((int)u >> 31) | 0x80000000u); }
__device__ __forceinline__ int wave_total(int v) {
    v += __builtin_amdgcn_update_dpp(0, v, 0x111, 0xf, 0xf, true);
    v += __builtin_amdgcn_update_dpp(0, v, 0x112, 0xf, 0xf, true);
    v += __builtin_amdgcn_update_dpp(0, v, 0x114, 0xf, 0xf, true);
    v += __builtin_amdgcn_update_dpp(0, v, 0x118, 0xf, 0xf, true);
    v += __builtin_amdgcn_update_dpp(0, v, 0x142, 0xa, 0xf, true);
    v += __builtin_amdgcn_update_dpp(0, v, 0x143, 0xc, 0xf, true);
    return __builtin_amdgcn_readlane(v, 63);
}
template <int NCH> __device__ __forceinline__ void select_row(const float* src, int n, u16* orow, int lane) {
    unsigned key[4 * NCH];
#pragma unroll
    for (int j = 0; j < NCH; ++j) { const int base = 256 * j + 4 * lane; const f32x4 v = *(const f32x4*)(src + base);
#pragma unroll
        for (int e = 0; e < 4; ++e) key[4 * j + e] = ord_key(v[e]) & (unsigned)((base + e - n) >> 31); }
    unsigned tau = 0u;
    for (int bit = 31; bit >= 0; --bit) { const unsigned cand = tau | (1u << bit); int cnt = 0;
#pragma unroll
        for (int m = 0; m < 4 * NCH; ++m) cnt += (key[m] >= cand) ? 1 : 0;
        cnt = wave_total(cnt);
        if (cnt >= 256) { tau = cand; if (cnt == 256) break; } }
    int cgt = 0;
#pragma unroll
    for (int m = 0; m < 4 * NCH; ++m) cgt += (key[m] > tau) ? 1 : 0;
    cgt = wave_total(cgt);
    const int need = 256 - cgt; int og = 0, oe = 0;
    asm volatile("" : "+v"(tau));
#pragma unroll
    for (int m = 0; m < 4 * NCH; ++m) {
        const unsigned kidx = (unsigned)(256 * (m >> 2) + 4 * lane + (m & 3));
        const bool isg = key[m] > tau, ise = key[m] == tau;
        const unsigned long long bg = __ballot(isg), be = __ballot(ise);
        const unsigned lo_g = __builtin_amdgcn_mbcnt_hi((unsigned)(bg >> 32), __builtin_amdgcn_mbcnt_lo((unsigned)bg, 0u));
        const unsigned lo_e = __builtin_amdgcn_mbcnt_hi((unsigned)(be >> 32), __builtin_amdgcn_mbcnt_lo((unsigned)be, 0u));
        if (isg) orow[og + (int)lo_g] = (u16)kidx;
        else if (ise && (oe + (int)lo_e) < need) orow[cgt + oe + (int)lo_e] = (u16)kidx;
        og += __popcll(bg); oe += __popcll(be);
        __builtin_amdgcn_sched_barrier(0);
    }
}
__device__ __forceinline__ void select_one(const float* S, u16* idx, int row, int lane) {
    const int b = row >> 12, t = row & (SEQ - 1), qb = t >> 7, n = t + 1;
    u16* orow = idx + (size_t)row * 256;
    if (n <= 256) { u32x2 w; const int k = 4 * lane;
        w.x = (unsigned)(k < n ? k : 0xFFFF) | ((unsigned)(k + 1 < n ? k + 1 : 0xFFFF) << 16); w.y = (unsigned)(k + 2 < n ? k + 2 : 0xFFFF) | ((unsigned)(k + 3 < n ? k + 3 : 0xFFFF) << 16);
        *(u32x2*)(orow + k) = w; return; }
    const float* src = S + (size_t)b * SC_BATCH + (size_t)16384 * (qb * (qb + 1) / 2) + (size_t)(t & 127) * ((qb + 1) * 128);
    const int nch = (n + 255) >> 8;
    if (nch <= 2) select_row<2>(src, n, orow, lane); else if (nch <= 4) select_row<4>(src, n, orow, lane); else if (nch <= 6) select_row<6>(src, n, orow, lane);
    else if (nch <= 8) select_row<8>(src, n, orow, lane); else if (nch <= 10) select_row<10>(src, n, orow, lane); else if (nch <= 12) select_row<12>(src, n, orow, lane);
    else if (nch <= 14) select_row<14>(src, n, orow, lane); else select_row<16>(src, n, orow, lane);
}
__device__ __forceinline__ void bmerge_phase(const f16* ob, const float* lse, f16* yb, int lane, int wave, int G, int bx) {
    const int gw = bx * NWAVES + wave, NGW = G * NWAVES; const int js = lane >> 4, e0 = (lane & 15) * 8;
    for (int row = gw; row < M; row += NGW) {
        const float l0 = lse[((size_t)0 * M + row) * 4 + js], l1 = lse[((size_t)1 * M + row) * 4 + js], l2 = lse[((size_t)2 * M + row) * 4 + js];
        const float mx = fmaxf(l0, fmaxf(l1, l2)); float w0 = __expf(l0 - mx), w1 = __expf(l1 - mx), w2 = __expf(l2 - mx); const float inv = 1.0f / (w0 + w1 + w2); w0 *= inv; w1 *= inv; w2 *= inv;
        const size_t o = (size_t)row * 512 + js * 128 + e0;
        const u32x4 a = *(const u32x4*)(ob + o), bq = *(const u32x4*)(ob + (size_t)M * 512 + o), cq = *(const u32x4*)(ob + (size_t)2 * M * 512 + o);
        const unsigned aw[4] = {a.x, a.y, a.z, a.w}, bw[4] = {bq.x, bq.y, bq.z, bq.w}, cw[4] = {cq.x, cq.y, cq.z, cq.w}; unsigned rw[4];
#pragma unroll
        for (int i = 0; i < 4; ++i) { const f32x2 x0 = unpk(aw[i]), x1 = unpk(bw[i]), x2 = unpk(cw[i]); rw[i] = pkh(w0 * x0.x + w1 * x1.x + w2 * x2.x, w0 * x0.y + w1 * x1.y + w2 * x2.y); }
        *(u32x4*)(yb + o) = (u32x4){rw[0], rw[1], rw[2], rw[3]};
    }
}

template <int MODE  > __device__ __forceinline__ void dsa_phase(const float* Ssc, const f16* qlat, const f16* ckv, u16* idx, const float* rel_bias, const unsigned char* lut, f16* olat, LAS unsigned char* lds, int tid, int lane, int wave, int G, int bx) {
    LAS unsigned char* lutS = lds + SMALL_OFF; LAS float* biasS = (LAS float*)(lds + SMALL_OFF + 4096);
    for (int i = tid; i < SEQ / 4; i += 512) ((LAS unsigned*)lutS)[i] = ((const unsigned*)lut)[i];
    if (tid < 256) biasS[tid] = rel_bias[(tid >> 3) * 20 + (tid & 7)];
    __syncthreads();
    LAS unsigned char* kv = lds + wave * 16384;
    const int g4 = lane >> 4, head = lane & 15, hq = head & 7, l31 = lane & 31, lh = lane >> 5;
    const unsigned trq = (unsigned)(head >> 2), trp = (unsigned)(lane & 3);
    int tok0, tstride, ntok; const bool paired = G == 256;
    if (paired) { const int bsel = (bx & 7) >> 1, wib = (((bx & 7) & 1) + 2 * (bx >> 3)) * NWAVES + wave; tok0 = bsel * SEQ + wib; tstride = 512; ntok = 8; }
    else { tok0 = bx * NWAVES + wave; tstride = G * NWAVES; ntok = tok0 < M ? (M - tok0 + tstride - 1) / tstride : 0; }
#define DSA_TOK(it) (paired ? (((it) & 1) ? (tok0 & ~(SEQ - 1)) + SEQ - 1 - ((tok0 & (SEQ - 1)) + ((it) >> 1) * 512) : tok0 + ((it) >> 1) * 512) : tok0 + (it) * tstride)
    if (MODE == 0) {
        for (int it = 0; it < ntok; ++it) select_one(Ssc, idx, DSA_TOK(it), lane);
        __builtin_amdgcn_fence(__ATOMIC_SEQ_CST, "workgroup"); asm volatile("s_waitcnt vmcnt(0)" ::: "memory");
    }
    const int nsteps = ntok * 8;
    if (nsteps == 0) return;
    u32x4 GR[16]; f32x4 oacc[16]; f16x8 qf[8];
    float mrun = NEG_INF, lrun = 0.f, bvc[8];
    u16x8 my8n; int idxn;
#define DSA_ROW(st) DSA_TOK((st) >> 3)
#define DSA_IDX(st, m8, ix) do { const int st_ = (st) < nsteps ? (st) : nsteps - 1; const u16* ir_ = idx + (size_t)DSA_ROW(st_) * 256 + 32 * (st_ & 7); \
        m8 = *(const u16x8*)(ir_ + 8 * g4); ix = (int)ir_[l31]; } while (0)
#define DSA_GATHER(st, ix) do { const int st_ = (st) < nsteps ? (st) : nsteps - 1; const f16* zb_ = ckv + (size_t)(DSA_ROW(st_) >> 12) * SEQ * 256 + 8 * l31; \
        _Pragma("unroll") for (int p_ = 0; p_ < 16; ++p_) { const int ia_ = __builtin_amdgcn_readlane((ix), 2 * p_), ib_ = __builtin_amdgcn_readlane((ix), 2 * p_ + 1); int ir_ = lh ? ib_ : ia_; ir_ = ir_ == 0xFFFF ? 0 : ir_; GR[p_] = *(const u32x4*)(zb_ + (size_t)ir_ * 256); } } while (0)
#define DSA_BIAS(st, m8, bv) do { const int st_ = (st) < nsteps ? (st) : nsteps - 1; const int t_ = DSA_ROW(st_) & (SEQ - 1); int bk_[8]; \
        _Pragma("unroll") for (int e_ = 0; e_ < 8; ++e_) { const int k_ = (int)m8[e_]; const int d_ = k_ == 0xFFFF ? 0 : t_ - k_; bk_[e_] = (int)lutS[d_]; } \
        _Pragma("unroll") for (int e_ = 0; e_ < 8; ++e_) { const float b_ = biasS[bk_[e_] * 8 + hq]; bv[e_] = (int)m8[e_] == 0xFFFF ? NEG_INF : b_; } } while (0)
    { u16x8 m0; int ix0; DSA_IDX(0, m0, ix0); if (MODE != 1) DSA_GATHER(0, ix0); DSA_BIAS(0, m0, bvc); DSA_IDX(1, my8n, idxn); }
    for (int st = 0; st < nsteps; ++st) {
        const int row = DSA_ROW(st), ch = st & 7;
        if (ch == 0) {
            const f16* zq = qlat + (size_t)row * 2048;
#pragma unroll
            for (int s = 0; s < 8; ++s) { const u32x4 w = *(const u32x4*)(zq + hq * 256 + 32 * s + 8 * g4); qf[s] = head < 8 ? __builtin_bit_cast(f16x8, w) : (f16x8){0, 0, 0, 0, 0, 0, 0, 0}; }
#pragma unroll
            for (int c = 0; c < 16; ++c) oacc[c] = (f32x4){0.f, 0.f, 0.f, 0.f};
            mrun = NEG_INF; lrun = 0.f;
        }
        if (MODE != 1) {
#pragma unroll
            for (int p = 0; p < 16; ++p) *(LAS u32x4*)(kv + (l31 >> 4) * 8192 + off_b((unsigned)(2 * p + lh), (unsigned)(lane & 15))) = GR[p];
            DSA_GATHER(st + 1, idxn);
        }
        u16x8 my8nn; int idxnn; DSA_IDX(st + 2, my8nn, idxnn);
        float bvn[8]; DSA_BIAS(st + 1, my8n, bvn);
        if (MODE != 2) {
        f32x4 stl[2];
#pragma unroll
        for (int hf = 0; hf < 2; ++hf) { const unsigned krow = 8u * (unsigned)(head >> 2) + 4u * hf + (unsigned)(head & 3); f32x4 acc = {0.f, 0.f, 0.f, 0.f};
#pragma unroll
            for (int s = 0; s < 8; ++s) { const f16x8 kf = *(const LAS f16x8*)(kv + (s >> 2) * 8192 + off_b(krow, 4u * (s & 3) + (unsigned)g4)); acc = __builtin_amdgcn_mfma_f32_16x16x32_f16(kf, qf[s], acc, 0, 0, 0); }
            stl[hf] = acc; }
        float sv[8], cmax = NEG_INF;
#pragma unroll
        for (int e = 0; e < 8; ++e) { sv[e] = stl[e >> 2][e & 3] + bvc[e]; cmax = fmaxf(cmax, sv[e]); }
        cmax = fmaxf(cmax, __shfl_xor(cmax, 16)); cmax = fmaxf(cmax, __shfl_xor(cmax, 32));
        if (__any(cmax > mrun + 6.0f)) {
            const float mnew = fmaxf(mrun, cmax), alpha = __expf(mrun - mnew);
            lrun *= alpha; mrun = mnew;
            if (ch != 0) {
#pragma unroll
                for (int c = 0; c < 16; ++c) oacc[c] = oacc[c] * alpha; }
        }
        float p[8], ps = 0.f;
#pragma unroll
        for (int e = 0; e < 8; ++e) { p[e] = __expf(sv[e] - mrun); ps += p[e]; }
        ps += __shfl_xor(ps, 16); ps += __shfl_xor(ps, 32);
        lrun += ps;
        const f16x8 pf = __builtin_bit_cast(f16x8, pkh8((f32x4){p[0], p[1], p[2], p[3]}, (f32x4){p[4], p[5], p[6], p[7]}));
#pragma unroll
        for (int ct = 0; ct < 16; ++ct) {
            const unsigned r0 = 8u * (unsigned)g4 + trq, cch = 2u * (ct & 7) + (trp >> 1);
            LAS unsigned char* img = kv + (ct >> 3) * 8192;
            const s16x4 t0 = __builtin_amdgcn_ds_read_tr16_b64_v4i16((LAS s16x4*)(img + off_b(r0, cch) + 8 * (trp & 1)));
            const s16x4 t1 = __builtin_amdgcn_ds_read_tr16_b64_v4i16((LAS s16x4*)(img + off_b(r0 + 4, cch) + 8 * (trp & 1)));
            const f16x8 vf = __builtin_bit_cast(f16x8, __builtin_shufflevector(t0, t1, 0, 1, 2, 3, 4, 5, 6, 7));
            oacc[ct] = __builtin_amdgcn_mfma_f32_16x16x32_f16(vf, pf, oacc[ct], 0, 0, 0); }
        if (ch == 7) {
            const float rl = 1.0f / lrun;
            if (head < 8) { f16* op = olat + (size_t)row * 2048 + head * 256 + 4 * g4;
#pragma unroll
                for (int ct = 0; ct < 16; ++ct) { u32x2 w; w.x = pkh(oacc[ct][0] * rl, oacc[ct][1] * rl); w.y = pkh(oacc[ct][2] * rl, oacc[ct][3] * rl); *(u32x2*)(op + 16 * ct) = w; } }
        }
        }
        my8n = my8nn; idxn = idxnn;
#pragma unroll
        for (int e = 0; e < 8; ++e) bvc[e] = bvn[e];
    }
#undef DSA_ROW
#undef DSA_IDX
#undef DSA_GATHER
#undef DSA_BIAS
#undef DSA_TOK
}
#define XB_TMO      128
#define XB_XCNT(j)  (256  + 64 * (j))
#define XB_XSUB(j)  (1280 + 64 * (j))
#define XB_XGEN(j)  (2304 + 64 * (j))
#define XB_TOP      3328
#define XB_TOPGEN   3392
#define XCD_BAR_WORDS 3456
#define XB_SPIN_CAP (1u << 18)

__device__ __forceinline__ unsigned xb_ld(unsigned* p)              { return __hip_atomic_load(p, __ATOMIC_RELAXED, __HIP_MEMORY_SCOPE_AGENT); }
__device__ __forceinline__ unsigned xb_add(unsigned* p, unsigned v) { return __hip_atomic_fetch_add(p, v, __ATOMIC_RELAXED, __HIP_MEMORY_SCOPE_AGENT); }
__device__ __forceinline__ unsigned xb_xcc_id() { return (unsigned)__builtin_amdgcn_s_getreg((3 << 11) | 20) & 0xFu; }
#define XB_SPIN(cond, bar) do { unsigned _sp = 0; while (cond) { __builtin_amdgcn_s_sleep(1); \
    if ((++_sp & 255u) == 0u) { if (xb_ld(&(bar)[XB_TMO])) break; if (_sp > XB_SPIN_CAP) { atomicAdd(&(bar)[XB_TMO], 1u); break; } } } } while (0)

struct XcdBarrier {
    unsigned* bar; unsigned x;
    volatile LAS unsigned* st;
};

__device__ __forceinline__ XcdBarrier xcd_barrier_post(unsigned* bar, volatile LAS unsigned* st) {
    XcdBarrier b; b.bar = bar; b.x = xb_xcc_id(); b.st = st;
    if (threadIdx.x == 0) (void)xb_add(&bar[XB_XCNT(b.x)], 1u);
    return b;
}
__device__ __forceinline__ void xcd_barrier_complete(unsigned* bar, unsigned x, unsigned& nloc, unsigned& nx) {
    const unsigned G = gridDim.x * gridDim.y * gridDim.z;
    unsigned sum, cnt, mine, sp = 0u;
    for (;;) {
        sum = 0u; cnt = 0u; mine = 0u;
#pragma unroll
        for (unsigned j = 0; j < 16; ++j) { const unsigned c = xb_ld(&bar[XB_XCNT(j)]); sum += c; cnt += (c > 0u) ? 1u : 0u; mine = (j == x) ? c : mine; }
        if (sum == G) break;
        __builtin_amdgcn_s_sleep(1);
        if ((++sp & 255u) == 0u) { if (xb_ld(&bar[XB_TMO])) break; if (sp > XB_SPIN_CAP) { atomicAdd(&bar[XB_TMO], 1u); break; } }
    }
    nloc = mine > 0u ? mine : 1u; nx = cnt > 0u ? cnt : 1u;
}

__device__ __forceinline__ void xcd_barrier(const XcdBarrier& b) {
    asm volatile("s_waitcnt vmcnt(0)" ::: "memory");
    __syncthreads();
    if (threadIdx.x == 0) {
        unsigned* bar = b.bar;
        __builtin_amdgcn_s_waitcnt(0);
        unsigned nloc = b.st[0], nx = b.st[1];
        if (nloc == 0u) { xcd_barrier_complete(bar, b.x, nloc, nx); b.st[0] = nloc; b.st[1] = nx; }
        const unsigned old = xb_add(&bar[XB_XSUB(b.x)], 1u);
        const unsigned gen = old / nloc;
        if (old + 1u == (gen + 1u) * nloc) {
            __builtin_amdgcn_fence(__ATOMIC_RELEASE, "agent");
            asm volatile("s_waitcnt vmcnt(0)" ::: "memory");
            const unsigned og = xb_add(&bar[XB_TOP], 1u);
            const unsigned tg = og / nx;
            if (og + 1u == (tg + 1u) * nx) xb_add(&bar[XB_TOPGEN], 1u);
            else XB_SPIN(xb_ld(&bar[XB_TOPGEN]) == tg, bar);
            __builtin_amdgcn_fence(__ATOMIC_ACQUIRE, "agent");
            xb_add(&bar[XB_XGEN(b.x)], 1u);
            asm volatile("s_waitcnt vmcnt(0)" ::: "memory");
        } else {
            XB_SPIN(xb_ld(&bar[XB_XGEN(b.x)]) == gen, bar);
            __builtin_amdgcn_fence(__ATOMIC_ACQUIRE, "agent");
            asm volatile("s_waitcnt vmcnt(0)" ::: "memory");
        }
    }
    __syncthreads();
}

#ifndef MK_PER_PHASE
#define MK_PER_PHASE 0
#endif
constexpr int N_PHASES = 12 * DEPTH + 1;
struct Args { const float* in[20]; float* out; unsigned char* ws; int ph_lo, ph_hi; };
#ifndef REPMASK
#define REPMASK 0
#endif
#ifndef ONLY_PHASE
#define ONLY_PHASE -1
#endif
#define IN(k) ((ONLY_PHASE < 0 || ((k) == 12 * DEPTH ? 12 : (k) % 12) == ONLY_PHASE) && lo <= (k) && (k) < hi)
#define SEAM(k) do { if (IN(k) && IN((k) + 1)) { XcdBarrier bb = bar; asm volatile("" : "+s"(bb.bar), "+s"(bb.x)); xcd_barrier(bb); if ((REPMASK >> 12) & 1) xcd_barrier(bb); } } while (0)
#define CAS __attribute__((address_space(4)))
#define PH_IDS int tid = tid0; asm volatile("" : "+v"(tid)); const int lane = tid & 63, wave = __builtin_amdgcn_readfirstlane(tid >> 6); (void)lane; (void)wave; \
    int G = (int)gridDim.x, bx = (int)blockIdx.x; asm volatile("" : "+s"(G), "+s"(bx)); \
    const CAS Args* ap = (const CAS Args*)__builtin_amdgcn_kernarg_segment_ptr(); asm volatile("" : "+s"(ap)); unsigned char* ws = ap->ws
#define W_INQ ((const pg8::bf16_t*)(ws + WS_W + WO_INQ))
#define W_INF_T ((f16*)(ws + WS_W + WO_INF))
#define B_H8 ((signed char*)(ws + WS_H8))
#define B_RS ((float*)(ws + WS_SCL))
#define B_SWIN ((const float*)(ws + WS_SCL) + 16384)
#define B_SWGU ((const float*)(ws + WS_SCL) + 32768)
#define W_GUQ ((const pg8::bf16_t*)(ws + WS_W + WO_GU))
#define W_DOWN_T ((f16*)(ws + WS_W + WO_DOWN))
#define W_OUT_T ((f16*)(ws + WS_W + WO_OUT))
#define W_AUP_T ((f16*)(ws + WS_W + WO_AUP))
#define W_BUP_T ((f16*)(ws + WS_W + WO_BUP))
#define B_XA ((float*)(ws + WS_X))
#define B_H ((f16*)(ws + WS_H))
#define B_OB ((f16*)(ws + WS_H))
#define B_YB ((f16*)(ws + WS_H + 48 * MiB))
#define B_QLAT ((f16*)(ws + WS_ZA + ZO_QLAT))
#define B_QI ((f16*)(ws + WS_ZA + ZO_QI))
#define B_CKV ((f16*)(ws + WS_ZA + ZO_CKV))
#define B_KW ((f16*)(ws + WS_ZA + ZO_KW))
#define B_QA ((f16*)(ws + WS_X))
#define W_UKT ((const f16*)(ws + WS_W + WO_WUK))
#define B_ZB ((f16*)(ws + WS_ZB))
#define B_ZG ((f16*)(ws + WS_ZG))
#define B_SC ((float*)(ws + WS_ZB))
#define B_OLAT ((f16*)(ws + WS_X))
#define B_MERGED ((f16*)(ws + WS_ZB + 64 * MiB))
#define B_ACT ((f16*)(ws + WS_ZA))
#define B_LSE ((float*)(ws + WS_LSE))
#define B_IDX ((u16*)(ws + WS_IDX))
#define B_ROPE ((const f32x2*)(ws + WS_ROPE))
#define B_LUT ((const unsigned char*)(ws + WS_LUT))
#define B_MOD ((const float*)(ws + WS_MOD) + (size_t)l * NB * 12288)
#define X_IN (l == 0 ? ap->in[0] : (const float*)ap->out)
#ifndef REPMASK
#define REPMASK 0
#endif
#define RUN(k, ...) do { { PH_IDS; __VA_ARGS__ } if ((REPMASK >> (k)) & 1) { PH_IDS; __VA_ARGS__ } } while (0)
template <int l> __device__ __forceinline__ void layer_body(LAS unsigned char* lds, const int tid0, const int lo, const int hi, const XcdBarrier& bar) {
    const int pb = 12 * l;
    if (IN(pb + 0)) { RUN(0, Ptrs P;
        P.x = ap->in[0]; P.c = ap->in[1]; P.rel_bias = ap->in[2]; P.w_ada = ap->in[3]; P.b_ada = ap->in[4]; P.norm1_g = ap->in[5]; P.w_in = ap->in[6]; P.kv_norm_g = ap->in[7];
        P.idx_ln_g = ap->in[8]; P.idx_ln_b = ap->in[9]; P.w_uk = ap->in[10]; P.w_uv = ap->in[11]; P.w_a_up = ap->in[12]; P.w_b_up = ap->in[13]; P.w_out = ap->in[14]; P.norm2_g = ap->in[15];
        P.w_ff_gate = ap->in[16]; P.w_ff_up = ap->in[17]; P.w_ff_down = ap->in[18]; P.final_g = ap->in[19]; P.out = ap->out; P.ws = ws;
        p0_phase(P, l, lds, tid, lane, wave, G, bx);); SEAM(pb + 0); }
    if (IN(pb + 1)) { RUN(1, norm_mod_phase<true>(X_IN, ap->in[5] + (size_t)l * D, B_MOD, B_MOD + D, B_H, B_H8, B_RS, lane, wave, G, bx);); SEAM(pb + 1); }
    if (IN(pb + 2)) { RUN(2,
        { pg8::Gemm g{(const pg8::bf16_t*)B_H8, W_INQ, M, NQ, D / 2}; pg8::StaticOrder S; S.init(M, NQ, G, bx); pg8::EpiInQ E{B_QA, B_CKV, B_ZB, B_ZG, B_RS, B_SWIN};
          pg8::gemm_phase<pg8::EpiInQ, pg8::StaticOrder, true, true, true>(lds, g, S, E); }
        __syncthreads();
        { int tb2 = tid; asm volatile("" : "+v"(tb2)); (void)tb2; pg8::Gemm g{B_H, W_INF_T, M, NF, D}; pg8::StaticOrder S; S.init(M, NF, G, G == 256 ? ((bx + 64) & 255) : bx);
          pg8::EpiInF E{B_QI, B_KW}; pg8::gemm_phase<pg8::EpiInF, pg8::StaticOrder, true, true, false>(lds, g, S, E); }
        __syncthreads();); SEAM(pb + 2); }
    if (IN(pb + 3)) { if ((REPMASK >> 14) & 1) { PH_IDS; zfix_phase((f16*)(ws + WS_X + 64 * MiB), (f16*)(ws + WS_X + 64 * MiB) + 8 * MiB, (f16*)(ws + WS_X + 64 * MiB) + 16 * MiB, ap->in[7] + (size_t)l * 256, ap->in[8] + (size_t)l * 64, ap->in[9] + (size_t)l * 64, B_ROPE, lane, wave, G, bx); }
        { PH_IDS; qlat_phase(B_QA, W_UKT, B_QLAT, lane, wave, G, bx); }
        { PH_IDS; zfix_phase(B_CKV, B_QI, B_KW, ap->in[7] + (size_t)l * 256, ap->in[8] + (size_t)l * 64, ap->in[9] + (size_t)l * 64, B_ROPE, lane, wave, G, bx); }
        RUN(3, battn_phase(B_ZB, ap->in[2], B_LUT, B_OB, B_LSE, lds, tid, lane, wave, G, bx);); SEAM(pb + 3); }
    if (IN(pb + 4)) { RUN(4, score_phase(B_QI, B_KW, B_SC, lds, tid, lane, wave, G, bx);); SEAM(pb + 4); }
    if (IN(pb + 5)) { RUN(13, bmerge_phase(B_OB, B_LSE, B_YB, lane, wave, G, bx););
        RUN(5, dsa_phase<0>(B_SC, B_QLAT, B_CKV, B_IDX, ap->in[2], B_LUT, B_OLAT, lds, tid, lane, wave, G, bx););
        if ((REPMASK >> 15) & 1) { PH_IDS; dsa_phase<1>(B_SC, B_QLAT, B_CKV, B_IDX, ap->in[2], B_LUT, (f16*)(ws + WS_X + 64 * MiB), lds, tid, lane, wave, G, bx); }
        if ((REPMASK >> 16) & 1) { PH_IDS; dsa_phase<2>(B_SC, B_QLAT, B_CKV, B_IDX, ap->in[2], B_LUT, (f16*)(ws + WS_X + 64 * MiB), lds, tid, lane, wave, G, bx); }
        SEAM(pb + 5); }
    if (IN(pb + 7)) { RUN(7,
        { pg8::Gemm g{B_OLAT, W_AUP_T, M, D, D}; pg8::StaticOrder S; S.init(M, D, G, bx); pg8::EpiGate<0> E{B_ZG, B_MERGED};
          pg8::gemm_phase<pg8::EpiGate<0>, pg8::StaticOrder, true, true>(lds, g, S, E); }
        __syncthreads();
        { int tb2 = tid; asm volatile("" : "+v"(tb2)); (void)tb2; pg8::Gemm g{B_YB, W_BUP_T, M, D, 512}; pg8::StaticOrder S; S.init(M, D, G, bx); pg8::EpiGate<1> E{B_ZG, B_MERGED};
          pg8::gemm_phase<pg8::EpiGate<1>, pg8::StaticOrder, true, true>(lds, g, S, E); }
        __syncthreads();); SEAM(pb + 7); }
    if (IN(pb + 8)) { RUN(8, pg8::Gemm g{B_MERGED, W_OUT_T, M, D, D}; pg8::StaticOrder S; S.init(M, D, G, bx); pg8::EpiResid E{X_IN, B_XA, B_MOD + 2 * D};
        pg8::gemm_phase<pg8::EpiResid, pg8::StaticOrder, true, true>(lds, g, S, E);); SEAM(pb + 8); }
    if (IN(pb + 9)) { RUN(9, norm_mod_phase<false>(B_XA, ap->in[15] + (size_t)l * D, B_MOD + 3 * D, B_MOD + 4 * D, B_H, B_H8, B_RS, lane, wave, G, bx);); SEAM(pb + 9); }
    if (IN(pb + 10)) { RUN(10, pg8::Gemm g{(const pg8::bf16_t*)B_H8, W_GUQ, M, NGU, D / 2}; pg8::StaticOrder S; S.init(M, NGU, G, bx); pg8::EpiSwiGLU E{B_ACT, B_RS, B_SWGU};
        pg8::gemm_phase<pg8::EpiSwiGLU, pg8::StaticOrder, true, true, true>(lds, g, S, E);); SEAM(pb + 10); }
    if (IN(pb + 11)) { RUN(11, pg8::Gemm g{B_ACT, W_DOWN_T, M, D, DFF}; pg8::StaticOrder S; S.init(M, D, G, bx); pg8::EpiResid E{B_XA, ap->out, B_MOD + 5 * D};
        pg8::gemm_phase<pg8::EpiResid, pg8::StaticOrder, true, true>(lds, g, S, E);); SEAM(pb + 11); }
}
__global__ void __launch_bounds__(NWAVES * 64, 2) fwd(Args args) {
    extern __shared__ __attribute__((aligned(16))) unsigned char lds_raw[];
    LAS unsigned char* lds = (LAS unsigned char*)lds_raw;
    const int tid0 = threadIdx.x;
    for (int u = tid0; u < (LDS_BYTES - LDSCTL_OFF) / 4; u += NWAVES * 64) ((LAS unsigned*)(lds + LDSCTL_OFF))[u] = 0u;
    __syncthreads();
    const int lo = args.ph_lo, hi = args.ph_hi;
    XcdBarrier bar; bar.bar = (unsigned*)(args.ws + WS_CTL) + CW_BAR; bar.x = 0; bar.st = nullptr;
    if (hi - lo > 1) bar = xcd_barrier_post((unsigned*)(args.ws + WS_CTL) + CW_BAR, (volatile LAS unsigned*)(lds + MISC_OFF) + 8);
    layer_body<0>(lds, tid0, lo, hi, bar);
    layer_body<1>(lds, tid0, lo, hi, bar);
    if (IN(12 * DEPTH)) { PH_IDS; final_norm_phase(ap->out, ap->in[19], lane, wave, G, bx); }
#undef IN
#undef SEAM
}

extern "C" void kernel_launch(void* const* d_in, const int* in_sizes, int n_in, void* d_out, int out_size, void* d_ws, size_t ws_size, hipStream_t stream) {
    static int grid = 0;
    if (grid == 0) {
        if (n_in != 20 || in_sizes[0] != M * D || out_size != M * D || ws_size < WS_END) { fprintf(stderr, "kernel_launch: built for 20 inputs, x/out of %d floats, >= %zu bytes of workspace; got n_in %d, in0 %d, out %d, ws %zu; nothing launched\n", M * D, (size_t)WS_END, n_in, n_in > 0 ? in_sizes[0] : -1, out_size, ws_size); grid = -1; return; }
        int dev = 0, cus = 0, per_cu = 0;
        if (hipGetDevice(&dev) != hipSuccess || hipDeviceGetAttribute(&cus, hipDeviceAttributeMultiprocessorCount, dev) != hipSuccess) { fprintf(stderr, "kernel_launch: device query failed\n"); grid = -1; return; }
        if (hipFuncSetAttribute((const void*)fwd, hipFuncAttributeMaxDynamicSharedMemorySize, LDS_BYTES) != hipSuccess) { fprintf(stderr, "kernel_launch: hipFuncSetAttribute failed\n"); grid = -1; return; }
        if (hipOccupancyMaxActiveBlocksPerMultiprocessor(&per_cu, (const void*)fwd, NWAVES * 64, LDS_BYTES) != hipSuccess || per_cu < 1)
            fprintf(stderr, "kernel_launch: note: occupancy query reports %d workgroups per CU\n", per_cu);
        (void)hipGetLastError();
        grid = cus;
    }
    if (grid < 0) return;
    if (hipMemsetAsync((char*)d_ws + WS_CTL, 0, CTL_ZERO_BYTES, stream) != hipSuccess) { fprintf(stderr, "kernel_launch: memset failed\n"); return; }
    Args a{};
    for (int i = 0; i < 20; ++i) a.in[i] = (const float*)d_in[i];
    a.out = (float*)d_out; a.ws = (unsigned char*)d_ws;
#if MK_PER_PHASE
    for (int p = 0; p < N_PHASES; ++p) { a.ph_lo = p; a.ph_hi = p + 1; hipLaunchKernelGGL(fwd, dim3(grid), dim3(NWAVES * 64), LDS_BYTES, stream, a); }
#else
    a.ph_lo = 0; a.ph_hi = N_PHASES;
    hipLaunchKernelGGL(fwd, dim3(grid), dim3(NWAVES * 64), LDS_BYTES, stream, a);
#endif
    const hipError_t le = hipPeekAtLastError();
    if (le != hipSuccess) fprintf(stderr, "kernel_launch: launch failed: %s\n", hipGetErrorName(le));
}
```

```cpp
#include <hip/hip_runtime.h>
#include <cstdio>
#include <cstdint>

#define LAS __attribute__((address_space(3)))
#define GAS __attribute__((address_space(1)))
typedef _Float16 f16;
typedef _Float16 f16x2 __attribute__((ext_vector_type(2)));
typedef _Float16 f16x4 __attribute__((ext_vector_type(4)));
typedef _Float16 f16x8 __attribute__((ext_vector_type(8)));
typedef float f32x2 __attribute__((ext_vector_type(2)));
typedef float f32x4 __attribute__((ext_vector_type(4)));
typedef float f32x16 __attribute__((ext_vector_type(16)));
typedef unsigned u32x2 __attribute__((ext_vector_type(2)));
typedef unsigned u32x4 __attribute__((ext_vector_type(4)));
typedef short s16x4 __attribute__((ext_vector_type(4)));
typedef unsigned short u16x8 __attribute__((ext_vector_type(8)));
typedef unsigned short u16;

__device__ __forceinline__ unsigned pkh(float a, float b) { f32x2 v = {a, b}; return __builtin_bit_cast(unsigned, __builtin_convertvector(v, f16x2)); }
__device__ __forceinline__ u32x4 pkh8(f32x4 a, f32x4 b) { u32x4 w; w.x = pkh(a[0], a[1]); w.y = pkh(a[2], a[3]); w.z = pkh(b[0], b[1]); w.w = pkh(b[2], b[3]); return w; }
__device__ __forceinline__ f32x2 unpk(unsigned w) { return __builtin_convertvector(__builtin_bit_cast(f16x2, w), f32x2); }
__device__ __forceinline__ float sigm(float x) { return __builtin_amdgcn_rcpf(1.0f + __expf(-x)); }
__device__ __forceinline__ float wave_sum(float v) {
#pragma unroll
    for (int o = 1; o < 64; o <<= 1) v += __shfl_xor(v, o);
    return v;
}
namespace pg8 {
#define PG8_LAS __attribute__((address_space(3)))
typedef _Float16 bf16_t;
typedef _Float16 bf16x8 __attribute__((ext_vector_type(8)));
typedef float f32x4 __attribute__((ext_vector_type(4)));
typedef unsigned u32x4 __attribute__((ext_vector_type(4)));
constexpr int BM = 256, BK = 64, HALF = 128, HTB = HALF * BK * 2  , STAGE_BYTES = 8 * HTB, NXCD = 8, WGM = 8;

__host__ __device__ __forceinline__ int lds_byte(int r, int c) { const int st = (r >> 4) * 2 + (c >> 5), rr = r & 15, cc = c & 31, ob = rr * 64 + cc * 2; return st * 1024 + (ob ^ (((ob >> 9) & 1) << 5)); }
__host__ __device__ __forceinline__ void stage_rc(int b, int& R, int& C) { const int st = b / 1024, sb = b % 1024, swz = sb ^ (((sb >> 9) & 1) << 5); R = (st >> 1) * 16 + swz / 64; C = (st & 1) * 32 + (swz % 64) / 2; }
__host__ __device__ __forceinline__ int perm32(int rho) { const int n = rho >> 4, i = rho & 15; return 8 * (i >> 2) + 4 * n + (i & 3); }

struct Unit { int pm, pn; };
struct Gemm { const bf16_t* A; const bf16_t* Bt; int M, N, K; };
typedef int i32x4v __attribute__((ext_vector_type(4)));

struct StaticOrder {
    int nM, nN, nwg, G, c;
    __host__ __device__ void init(int M, int N, int G_, int c_) { nM = M / BM; nN = N / BM; nwg = nM * nN; G = G_; c = c_; }
    __host__ __device__ bool next(int i, Unit& u) const {
        const long L = (long)i * G + c; if (L >= nwg) return false;
        int wgid = (int)L; { const int q = nwg / NXCD, r = nwg % NXCD, xcd = wgid % NXCD, off = wgid / NXCD; wgid = (xcd < r ? xcd * (q + 1) : r * (q + 1) + (xcd - r) * q) + off; }
        const int nig = WGM * nN, gid = wgid / nig, fm = gid * WGM, gsz = (nM - fm) < WGM ? (nM - fm) : WGM;
        u.pm = fm + ((wgid % nig) % gsz); u.pn = (wgid % nig) / gsz; return true;
    }
    __device__ __forceinline__ void a_ready(const Unit&) const {}
    __device__ __forceinline__ void done(const Unit&) const {}
};

__device__ __forceinline__ f32x4 i2f4(f32x4 a) { const i32x4v v = __builtin_bit_cast(i32x4v, a); return (f32x4){(float)v[0], (float)v[1], (float)v[2], (float)v[3]}; }
struct EpiInQ {
    static constexpr bool PERM = true, AFTER_DRAIN = false;
    bf16_t *qa, *ckv, *zB, *zG; const float* rs; const float* cs;
    __device__ __forceinline__ void operator()(const f32x4 (&acc)[2][2][4][2], const Unit& u, int wr, int wc, int fr, int fq) const {
        const int row0 = u.pm * BM + wr * 64 + fr; bf16_t* base; int ld, colt; bool sg = false;
        if (u.pn < 4) { base = qa; ld = 1024; colt = u.pn * BM; } else if (u.pn < 5) { base = ckv; ld = 256; colt = 0; } else if (u.pn < 23) { base = zB; ld = 4608; colt = (u.pn - 5) * BM; } else { base = zG; ld = 4096; colt = (u.pn - 23) * BM; sg = true; }
        const int col0 = colt + wc * 32 + 8 * fq; const float* csp = cs + u.pn * BM + wc * 32 + 8 * fq;
        f32x4 cv[2][2];
#pragma unroll
        for (int bj = 0; bj < 2; ++bj)
#pragma unroll
            for (int n = 0; n < 2; ++n) cv[bj][n] = *(const f32x4*)(csp + bj * HALF + 4 * n);
#pragma unroll
        for (int ai = 0; ai < 2; ++ai)
#pragma unroll
            for (int m = 0; m < 4; ++m) { const int row = row0 + ai * HALF + m * 16; const float r = rs[row]; bf16_t* rowp = base + (size_t)row * ld + col0;
#pragma unroll
                for (int bj = 0; bj < 2; ++bj) { f32x4 v0 = i2f4(acc[ai][bj][m][0]) * cv[bj][0] * r, v1 = i2f4(acc[ai][bj][m][1]) * cv[bj][1] * r;
                    if (sg) {
#pragma unroll
                        for (int j = 0; j < 4; ++j) { v0[j] = sigm(v0[j]); v1[j] = sigm(v1[j]); } }
                    *(u32x4*)(rowp + bj * HALF) = pkh8(v0, v1); } }
    }
};
struct EpiInF {
    static constexpr bool PERM = true, AFTER_DRAIN = false;
    bf16_t *qi, *kw;
    __device__ __forceinline__ void operator()(const f32x4 (&acc)[2][2][4][2], const Unit& u, int wr, int wc, int fr, int fq) const {
        bf16_t* base; int ld, colt;
        if (u.pn < 4) { base = qi; ld = 1024; colt = u.pn * BM; } else { base = kw; ld = 256; colt = 0; }
        const int row0 = u.pm * BM + wr * 64 + fr, col0 = colt + wc * 32 + 8 * fq;
#pragma unroll
        for (int ai = 0; ai < 2; ++ai)
#pragma unroll
            for (int m = 0; m < 4; ++m) { bf16_t* rowp = base + (size_t)(row0 + ai * HALF + m * 16) * ld + col0;
#pragma unroll
                for (int bj = 0; bj < 2; ++bj) *(u32x4*)(rowp + bj * HALF) = pkh8(acc[ai][bj][m][0], acc[ai][bj][m][1]); }
    }
};
template <int MODE> struct EpiGate {
    static constexpr bool PERM = true, AFTER_DRAIN = false;
    const bf16_t* zG; bf16_t* out; const float* rs; const float* cs;
    __device__ __forceinline__ void operator()(const f32x4 (&acc)[2][2][4][2], const Unit& u, int wr, int wc, int fr, int fq) const {
        const int row0 = u.pm * BM + wr * 64 + fr, col0 = u.pn * BM + wc * 32 + 8 * fq;
        f32x4 cv[2][2];
        if (MODE == 0) {
#pragma unroll
            for (int bj = 0; bj < 2; ++bj)
#pragma unroll
                for (int n = 0; n < 2; ++n) cv[bj][n] = *(const f32x4*)(cs + col0 + bj * HALF + 4 * n); }
#pragma unroll
        for (int ai = 0; ai < 2; ++ai)
#pragma unroll
            for (int m = 0; m < 4; ++m) { const size_t row = (size_t)(row0 + ai * HALF + m * 16); const float r = MODE == 0 ? rs[row] : 1.0f;
#pragma unroll
                for (int bj = 0; bj < 2; ++bj) {
                    const u32x4 gw = *(const u32x4*)(zG + row * 4096 + MODE * 2048 + col0 + bj * HALF);
                    const f32x2 g0 = unpk(gw.x), g1 = unpk(gw.y), g2 = unpk(gw.z), g3 = unpk(gw.w);
                    f32x4 v0, v1;
                    if (MODE == 0) { v0 = i2f4(acc[ai][bj][m][0]) * cv[bj][0] * r; v1 = i2f4(acc[ai][bj][m][1]) * cv[bj][1] * r; } else { v0 = acc[ai][bj][m][0]; v1 = acc[ai][bj][m][1]; }
                    v0 = v0 * (f32x4){g0.x, g0.y, g1.x, g1.y}; v1 = v1 * (f32x4){g2.x, g2.y, g3.x, g3.y};
                    bf16_t* op = out + row * 2048 + col0 + bj * HALF;
                    if (MODE == 1) { const u32x4 pw = *(const u32x4*)op; const f32x2 p0 = unpk(pw.x), p1 = unpk(pw.y), p2 = unpk(pw.z), p3 = unpk(pw.w);
                        v0 += (f32x4){p0.x, p0.y, p1.x, p1.y}; v1 += (f32x4){p2.x, p2.y, p3.x, p3.y}; }
                    *(u32x4*)op = pkh8(v0, v1);
                    asm volatile("" ::: "memory"); } }
    }
};
struct EpiResid {
    static constexpr bool PERM = false, AFTER_DRAIN = false;
    const float* xi; float* xo; const float* gate;
    __device__ __forceinline__ void operator()(const f32x4 (&acc)[2][2][4][2], const Unit& u, int wr, int wc, int fr, int fq) const {
        const int row0 = u.pm * BM + wr * 64 + fr, col0 = u.pn * BM + wc * 32 + 4 * fq; const float* gp = gate + (size_t)(u.pm >> 4) * 12288 + col0;
        f32x4 gv[2][2];
#pragma unroll
        for (int bj = 0; bj < 2; ++bj)
#pragma unroll
            for (int n = 0; n < 2; ++n) gv[bj][n] = *(const f32x4*)(gp + bj * HALF + n * 16);
#pragma unroll
        for (int ai = 0; ai < 2; ++ai)
#pragma unroll
            for (int m = 0; m < 4; ++m) { const size_t off = (size_t)(row0 + ai * HALF + m * 16) * 2048 + col0;
#pragma unroll
                for (int bj = 0; bj < 2; ++bj)
#pragma unroll
                    for (int n = 0; n < 2; ++n) *(f32x4*)(xo + off + bj * HALF + n * 16) = *(const f32x4*)(xi + off + bj * HALF + n * 16) + gv[bj][n] * acc[ai][bj][m][n];
                asm volatile("" ::: "memory"); }
    }
};
struct EpiSwiGLU {
    static constexpr bool PERM = true, AFTER_DRAIN = false;
    bf16_t* act; const float* rs; const float* cs;
    __device__ __forceinline__ void operator()(const f32x4 (&acc)[2][2][4][2], const Unit& u, int wr, int wc, int fr, int fq) const {
        const int row0 = u.pm * BM + wr * 64 + fr, col0 = u.pn * HALF + wc * 32 + 8 * fq; const float* csp = cs + u.pn * BM + wc * 32 + 8 * fq;
        f32x4 cv[2][2];
#pragma unroll
        for (int bj = 0; bj < 2; ++bj)
#pragma unroll
            for (int n = 0; n < 2; ++n) cv[bj][n] = *(const f32x4*)(csp + bj * HALF + 4 * n);
#pragma unroll
        for (int ai = 0; ai < 2; ++ai)
#pragma unroll
            for (int m = 0; m < 4; ++m) { f32x4 o[2]; const int row = row0 + ai * HALF + m * 16; const float r = rs[row];
#pragma unroll
                for (int n = 0; n < 2; ++n) { const f32x4 g = i2f4(acc[ai][0][m][n]) * cv[0][n] * r, up = i2f4(acc[ai][1][m][n]) * cv[1][n] * r;
#pragma unroll
                    for (int j = 0; j < 4; ++j) o[n][j] = g[j] * sigm(g[j]) * up[j]; }
                *(u32x4*)(act + (size_t)row * 5632 + col0) = pkh8(o[0], o[1]); }
    }
};
template <class Epi, class Sched, bool ALIGN_EPI = false, bool SP2 = false, bool I8 = false>
__device__ __forceinline__ void gemm_phase(PG8_LAS unsigned char* lds, const Gemm g, const Sched& S, const Epi& E) {
    int tid_ = threadIdx.x; asm volatile("" : "+v"(tid_));
    const int tid = tid_, wid = __builtin_amdgcn_readfirstlane(tid >> 6), lane = tid & 63, wr = wid >> 2, wc = wid & 3, fr = lane & 15, fq = lane >> 4;
    const int K = g.K, nt = K / BK;
    unsigned voffA[2], voffB[2];
#pragma unroll
    for (int i = 0; i < 2; ++i) { int R, C; stage_rc(tid * 16 + i * 8192, R, C); const int Rb = Epi::PERM ? ((R & ~31) + perm32(R & 31)) : R;
        voffA[i] = (unsigned)(R * K + C) * 2u; voffB[i] = (unsigned)(Rb * K + C) * 2u; }
    const size_t kstep = (size_t)(BK * 2);
    const size_t hstep = (size_t)HALF * K * 2;
    const size_t tstep = 2 * hstep;
    const unsigned ldsw = (unsigned)wid * 1024u;
    const int aoff = lds_byte(wr * 64 + fr, fq * 8), boff = lds_byte(wc * 32 + fr, fq * 8);
#define PG8_SA(b, h) (((b) * 2 + (h)) * HTB)
#define PG8_SB(b, h) ((4 + (b) * 2 + (h)) * HTB)
#define PG8_STAGE(bufoff, gbase, voff) do { _Pragma("unroll") for (int _i = 0; _i < 2; ++_i) \
        __builtin_amdgcn_global_load_lds((const unsigned*)((const char*)(gbase) + (voff)[_i]), (PG8_LAS unsigned*)(lds + (bufoff) + ldsw + _i * 8192), 16, 0, 0); } while (0)
#define PG8_LDA(dst, b, h) do { _Pragma("unroll") for (int m = 0; m < 4; ++m) _Pragma("unroll") for (int k = 0; k < 2; ++k) dst[m][k] = *(const PG8_LAS bf16x8*)(lds + PG8_SA(b, h) + aoff + m * 2048 + k * 1024); } while (0)
#define PG8_LDB(dst, b, h) do { _Pragma("unroll") for (int n = 0; n < 2; ++n) _Pragma("unroll") for (int k = 0; k < 2; ++k) dst[n][k] = *(const PG8_LAS bf16x8*)(lds + PG8_SB(b, h) + boff + n * 2048 + k * 1024); } while (0)
#define PG8_MMA(ai, bj, At, Bt) do { __builtin_amdgcn_s_setprio(1); _Pragma("unroll") for (int m = 0; m < 4; ++m) _Pragma("unroll") for (int n = 0; n < 2; ++n) _Pragma("unroll") for (int k = 0; k < 2; ++k) { \
        if constexpr (I8) acc[ai][bj][m][n] = __builtin_bit_cast(f32x4, __builtin_amdgcn_mfma_i32_16x16x64_i8(__builtin_bit_cast(i32x4v, Bt[n][k]), __builtin_bit_cast(i32x4v, At[m][k]), __builtin_bit_cast(i32x4v, acc[ai][bj][m][n]), 0, 0, 0)); \
        else acc[ai][bj][m][n] = __builtin_amdgcn_mfma_f32_16x16x32_f16(Bt[n][k], At[m][k], acc[ai][bj][m][n], 0, 0, 0); } __builtin_amdgcn_s_setprio(0); } while (0)
#define PG8_WAIT_V(n) asm volatile("s_waitcnt vmcnt(" #n ")" ::: "memory")
#define PG8_WAIT_L(n) asm volatile("s_waitcnt lgkmcnt(" #n ")" ::: "memory")
#define PG8_BAR __builtin_amdgcn_s_barrier()
#define PG8_SCHED __builtin_amdgcn_sched_barrier(0)
    Unit cur, nxt; int ui = 0;
    if (!S.next(0, cur)) return;
    f32x4 acc[2][2][4][2];
#pragma unroll
    for (int a = 0; a < 2; ++a)
#pragma unroll
        for (int b = 0; b < 2; ++b)
#pragma unroll
            for (int m = 0; m < 4; ++m)
#pragma unroll
                for (int n = 0; n < 2; ++n) acc[a][b][m][n] = (f32x4){0.f, 0.f, 0.f, 0.f};
    bf16x8 At[4][2], B0[2][2], B1[2][2];
    const char* cA = (const char*)g.A + (size_t)cur.pm * tstep; const char* cB = (const char*)g.Bt + (size_t)cur.pn * tstep;
    S.a_ready(cur);
    if constexpr (SP2) {
        PG8_STAGE(PG8_SB(0, 0), cB, voffB); PG8_STAGE(PG8_SB(0, 1), cB + hstep, voffB); PG8_STAGE(PG8_SA(0, 0), cA, voffA); PG8_STAGE(PG8_SA(0, 1), cA + hstep, voffA);
        if (wr == 1) PG8_BAR;
        PG8_WAIT_V(2); PG8_BAR;
        PG8_STAGE(PG8_SB(1, 0), cB + kstep, voffB); PG8_STAGE(PG8_SA(1, 0), cA + kstep, voffA); PG8_STAGE(PG8_SB(1, 1), cB + hstep + kstep, voffB);
        PG8_WAIT_V(6); PG8_BAR;
    } else {
        PG8_STAGE(PG8_SB(0, 0), cB, voffB); PG8_STAGE(PG8_SA(0, 0), cA, voffA); PG8_STAGE(PG8_SB(0, 1), cB + hstep, voffB); PG8_STAGE(PG8_SA(0, 1), cA + hstep, voffA);
        if (wr == 1) PG8_BAR;
        PG8_WAIT_V(4); PG8_BAR;
        PG8_STAGE(PG8_SB(1, 0), cB + kstep, voffB); PG8_STAGE(PG8_SA(1, 0), cA + kstep, voffA); PG8_STAGE(PG8_SB(1, 1), cB + hstep + kstep, voffB);
        PG8_WAIT_V(6); PG8_BAR;
    }
    for (;;) {
        const bool has_next = S.next(ui + 1, nxt);
        const char* nA = has_next ? (const char*)g.A + (size_t)nxt.pm * tstep : cA; const char* nB = has_next ? (const char*)g.Bt + (size_t)nxt.pn * tstep : cB;
        for (int t = 0; t < nt; t += 2) {
            const bool last = (t == nt - 2);
            const char* a1 = cA + (size_t)(t + 1) * kstep;
            const char* a2 = last ? nA : cA + (size_t)(t + 2) * kstep; const char* b2 = last ? nB : cB + (size_t)(t + 2) * kstep;
            const char* a3 = a2 + kstep; const char* b3 = b2 + kstep;
            if (last && has_next) S.a_ready(nxt);
            if constexpr (SP2) {
            PG8_LDB(B0, 0, 0); PG8_LDB(B1, 0, 1); PG8_SCHED; PG8_LDA(At, 0, 0); PG8_STAGE(PG8_SA(1, 1), a1 + hstep, voffA);
            PG8_WAIT_V(8); PG8_WAIT_L(0); PG8_BAR; PG8_MMA(0, 0, At, B0); PG8_MMA(0, 1, At, B1); PG8_BAR; PG8_SCHED;
            PG8_LDA(At, 0, 1); PG8_STAGE(PG8_SB(0, 0), b2, voffB); PG8_STAGE(PG8_SB(0, 1), b2 + hstep, voffB); PG8_STAGE(PG8_SA(0, 0), a2, voffA);
            PG8_WAIT_V(8); PG8_WAIT_L(0); PG8_BAR; PG8_MMA(1, 0, At, B0); PG8_MMA(1, 1, At, B1); PG8_BAR; PG8_SCHED;
            PG8_LDB(B0, 1, 0); PG8_LDB(B1, 1, 1); PG8_SCHED; PG8_LDA(At, 1, 0); PG8_STAGE(PG8_SA(0, 1), a2 + hstep, voffA);
            PG8_WAIT_V(8); PG8_WAIT_L(0); PG8_BAR; PG8_MMA(0, 0, At, B0); PG8_MMA(0, 1, At, B1); PG8_BAR; PG8_SCHED;
            PG8_LDA(At, 1, 1); PG8_STAGE(PG8_SB(1, 0), b3, voffB); PG8_STAGE(PG8_SB(1, 1), b3 + hstep, voffB); PG8_STAGE(PG8_SA(1, 0), a3, voffA);
            PG8_WAIT_V(8); PG8_WAIT_L(0); PG8_BAR; PG8_MMA(1, 0, At, B0); PG8_MMA(1, 1, At, B1); PG8_BAR; PG8_SCHED;
            } else {
            PG8_LDB(B0, 0, 0); PG8_SCHED; PG8_LDA(At, 0, 0); PG8_STAGE(PG8_SA(1, 1), a1 + hstep, voffA);
            PG8_WAIT_L(8); PG8_BAR; PG8_WAIT_L(0); PG8_MMA(0, 0, At, B0); PG8_BAR; PG8_SCHED;
            PG8_LDB(B1, 0, 1); PG8_STAGE(PG8_SB(0, 0), b2, voffB);
            PG8_BAR; PG8_WAIT_L(0); PG8_MMA(0, 1, At, B1); PG8_BAR;
            PG8_LDA(At, 0, 1); PG8_STAGE(PG8_SA(0, 0), a2, voffA);
            PG8_BAR; PG8_WAIT_L(0); PG8_MMA(1, 0, At, B0); PG8_BAR; PG8_SCHED;
            PG8_STAGE(PG8_SB(0, 1), b2 + hstep, voffB);
            PG8_WAIT_V(6); PG8_BAR; PG8_MMA(1, 1, At, B1); PG8_BAR;
            PG8_LDB(B0, 1, 0); PG8_SCHED; PG8_LDA(At, 1, 0); PG8_STAGE(PG8_SA(0, 1), a2 + hstep, voffA);
            PG8_WAIT_L(8); PG8_BAR; PG8_WAIT_L(0); PG8_MMA(0, 0, At, B0); PG8_BAR; PG8_SCHED;
            PG8_LDB(B1, 1, 1); PG8_STAGE(PG8_SB(1, 0), b3, voffB);
            PG8_BAR; PG8_WAIT_L(0); PG8_MMA(0, 1, At, B1); PG8_BAR;
            PG8_LDA(At, 1, 1); PG8_STAGE(PG8_SA(1, 0), a3, voffA);
            PG8_BAR; PG8_WAIT_L(0); PG8_MMA(1, 0, At, B0); PG8_BAR; PG8_SCHED;
            PG8_STAGE(PG8_SB(1, 1), b3 + hstep, voffB);
            PG8_WAIT_V(6); PG8_BAR; PG8_MMA(1, 1, At, B1); PG8_BAR;
            }
        }
        if constexpr (ALIGN_EPI) { if (wr == 0) PG8_BAR; }
        if constexpr (!Epi::AFTER_DRAIN) { E(acc, cur, wr, wc, fr, fq); S.done(cur); }
        if (!has_next) break;
#pragma unroll
        for (int a = 0; a < 2; ++a)
#pragma unroll
            for (int b = 0; b < 2; ++b)
#pragma unroll
                for (int m = 0; m < 4; ++m)
#pragma unroll
                    for (int n = 0; n < 2; ++n) acc[a][b][m][n] = (f32x4){0.f, 0.f, 0.f, 0.f};
        cur = nxt; cA = nA; cB = nB; ++ui;
        if constexpr (ALIGN_EPI) { if (wr == 1) PG8_BAR; }
    }
    PG8_WAIT_V(0);
    if constexpr (!ALIGN_EPI) { if (wr == 0) PG8_BAR; }
    PG8_BAR;
    if constexpr (Epi::AFTER_DRAIN) { E.fused(acc, cur, wr, wc, fr, fq, lds, wid, lane); S.done(cur); }
#undef PG8_SA
#undef PG8_SB
#undef PG8_STAGE
#undef PG8_LDA
#undef PG8_LDB
#undef PG8_MMA
#undef PG8_WAIT_V
#undef PG8_WAIT_L
#undef PG8_BAR
#undef PG8_SCHED
}
}

constexpr int NB = 4, SEQ = 4096, M = NB * SEQ, D = 2048, DEPTH = 2;
constexpr int N_IN_SRC = 11088, NQ = 9984  , NF = 1280  ;
constexpr int NZA = 3584, NZB = 4608, NZG = 4096, NIN = 12288;
constexpr int KW_W = 64;
constexpr int DFF = 5632, NGU = 2 * DFF;
constexpr int NWAVES = 8;
constexpr float NORM_EPS = 1e-6f, NEG_INF = -1e30f;
constexpr int SC_BATCH = 8650752;

constexpr size_t MiB = 1u << 20;
constexpr size_t WS_CTL = 0, CTL_ZERO_BYTES = 1 * MiB;
constexpr size_t WS_MOD = 1 * MiB;
constexpr size_t WS_ROPE = 2 * MiB;
constexpr size_t WS_LUT = 2 * MiB + 768 * 1024;
constexpr size_t WS_LSE = 3 * MiB;
constexpr size_t WS_IDX = 4 * MiB;
constexpr size_t WS_W = 12 * MiB;
constexpr size_t WO_INQ = 0  , WO_INF = 24 * MiB  , WO_WUK = 32 * MiB  , WO_AUPQ = 36 * MiB  , WO_GU   = 48 * MiB, WO_DOWN = 92 * MiB, WO_OUT = 114 * MiB, WO_AUP = 122 * MiB, WO_BUP = 130 * MiB;
constexpr size_t WS_X = 144 * MiB;
constexpr size_t WS_H = 272 * MiB;
constexpr size_t WS_ZA = 336 * MiB;
constexpr size_t ZO_QLAT = 0, ZO_QI = 64 * MiB, ZO_CKV = 96 * MiB, ZO_KW = 104 * MiB;
constexpr size_t WS_ZB = 448 * MiB;
constexpr size_t WS_ZG = 592 * MiB;
constexpr size_t WS_H8 = 720 * MiB;
constexpr size_t WS_SCL = 2 * MiB + 512 * 1024;
constexpr size_t WS_END = 752 * MiB;
constexpr int CW_BAR = 4096;

constexpr int RING_BYTES = 131072;
constexpr int LDSCTL_OFF = RING_BYTES, MISC_OFF = LDSCTL_OFF + 320;
constexpr int SMALL_OFF = RING_BYTES + 1024;
constexpr int LDS_BYTES = 147456;

__device__ __forceinline__ unsigned off_b(unsigned row, unsigned ch) { return 256u * row + 16u * (ch ^ (((row & 3) << 2) | ((row >> 2) & 3))); }
__device__ __forceinline__ int rel_bucket_of(int n) {
    if (n < 16) return n;
    int b = 16;
    b += (n >= 22) + (n >= 30) + (n >= 40) + (n >= 54) + (n >= 73) + (n >= 99) + (n >= 134) + (n >= 182) + (n >= 246) + (n >= 332) + (n >= 450) + (n >= 609) + (n >= 825) + (n >= 1117) + (n >= 1513);
    return b;
}

struct Ptrs {
    const float *x, *c, *rel_bias, *w_ada, *b_ada, *norm1_g, *w_in, *kv_norm_g, *idx_ln_g, *idx_ln_b, *w_uk, *w_uv, *w_a_up, *w_b_up, *w_out, *norm2_g, *w_ff_gate, *w_ff_up, *w_ff_down, *final_g;
    float* out; unsigned char* ws;
};

__device__ __forceinline__ unsigned pkq4(float a, float b, float c, float d) {
    const int q0 = (int)__builtin_rintf(a), q1 = (int)__builtin_rintf(b), q2 = (int)__builtin_rintf(c), q3 = (int)__builtin_rintf(d);
    return (unsigned)(q0 & 255) | ((unsigned)(q1 & 255) << 8) | ((unsigned)(q2 & 255) << 16) | ((unsigned)q3 << 24); }
template <int MAP> __device__ __forceinline__ int map_row(int n, float& sc) {
    sc = 1.0f;
    if (MAP == 0) {
        if (n < 2304) return n - 1280;
        if (n < 2368) return 1024 + (n - 2304);
        sc = 0.03125f; return 1088 + (n - 2368);
    }
    return n;
}
template <int MAP> __device__ __forceinline__ void transpose_item(const float* W, int ldw, int k0, int n0, int nvalid, f16* WT, int K, LAS float* scr, int lane) {
    const int c4 = lane & 7, kr = lane >> 3; f32x4 v[8];
#pragma unroll
    for (int i = 0; i < 8; ++i) v[i] = (4 * c4 < nvalid) ? *(const f32x4*)(W + (size_t)(k0 + 8 * i + kr) * ldw + n0 + 4 * c4) : (f32x4){0.f, 0.f, 0.f, 0.f};
#pragma unroll
    for (int i = 0; i < 8; ++i) { LAS float* sp = scr + (8 * i + kr) * 33 + 4 * c4; sp[0] = v[i][0]; sp[1] = v[i][1]; sp[2] = v[i][2]; sp[3] = v[i][3]; }
    asm volatile("s_waitcnt lgkmcnt(0)" ::: "memory");
    const int c = lane & 7;
#pragma unroll
    for (int j = 0; j < 4; ++j) { const int n = (lane >> 3) + 8 * j; const LAS float* s = scr + (8 * c) * 33 + n;
        if (n < nvalid) { float sc; const int row = map_row<MAP>(n0 + n, sc);
            u32x4 o; o.x = pkh(s[0 * 33] * sc, s[1 * 33] * sc); o.y = pkh(s[2 * 33] * sc, s[3 * 33] * sc); o.z = pkh(s[4 * 33] * sc, s[5 * 33] * sc); o.w = pkh(s[6 * 33] * sc, s[7 * 33] * sc);
            *(u32x4*)(WT + (size_t)row * K + k0 + 8 * c) = o; } }
    asm volatile("s_waitcnt lgkmcnt(0)" ::: "memory");
}
__device__ __forceinline__ void quant_item(const float* W, int ldw, int n0, signed char* dst, int r0, float* sw, LAS unsigned char* lds, int tid) {
    LAS f16* T = (LAS f16*)lds; LAS float* pm = (LAS float*)(lds + SMALL_OFF);
#pragma unroll
    for (int hb = 0; hb < 2; ++hb) { f32x4 v[16];
#pragma unroll
        for (int i = 0; i < 16; ++i) { const int q = tid + 512 * (16 * hb + i), k = q >> 3, c4 = q & 7; v[i] = *(const f32x4*)(W + (size_t)k * ldw + n0 + 4 * c4); }
#pragma unroll
        for (int i = 0; i < 16; ++i) { const int q = tid + 512 * (16 * hb + i), k = q >> 3, c4 = q & 7; u32x2 w; w.x = pkh(v[i][0], v[i][1]); w.y = pkh(v[i][2], v[i][3]); *(LAS u32x2*)(T + k * 32 + 4 * c4) = w; } }
    __syncthreads();
    const int c2 = tid & 15, ks = tid >> 4; const LAS unsigned* tp = (const LAS unsigned*)(T + (64 * ks) * 32 + 2 * c2);
    float mx0 = 0.f, mx1 = 0.f;
#pragma unroll 16
    for (int j = 0; j < 64; ++j) { const f32x2 p = unpk(tp[j * 16]); mx0 = fmaxf(mx0, __builtin_fabsf(p.x)); mx1 = fmaxf(mx1, __builtin_fabsf(p.y)); }
    pm[ks * 32 + 2 * c2] = mx0; pm[ks * 32 + 2 * c2 + 1] = mx1;
    __syncthreads();
    mx0 = 0.f; mx1 = 0.f;
#pragma unroll
    for (int j = 0; j < 32; ++j) { mx0 = fmaxf(mx0, pm[j * 32 + 2 * c2]); mx1 = fmaxf(mx1, pm[j * 32 + 2 * c2 + 1]); }
    const float inv0 = mx0 > 0.f ? 127.0f / mx0 : 0.f, inv1 = mx1 > 0.f ? 127.0f / mx1 : 0.f;
    if (tid < 16) { sw[r0 + 2 * c2] = mx0 > 0.f ? mx0 * (1.0f / 127.0f) : 1.0f; sw[r0 + 2 * c2 + 1] = mx1 > 0.f ? mx1 * (1.0f / 127.0f) : 1.0f; }
    signed char* dp = dst + (size_t)(r0 + 2 * c2) * 2048 + 64 * ks;
#pragma unroll
    for (int i = 0; i < 4; ++i) { float a[16], b[16];
#pragma unroll
        for (int j = 0; j < 16; ++j) { const f32x2 p = unpk(tp[(16 * i + j) * 16]); a[j] = p.x * inv0; b[j] = p.y * inv1; }
        u32x4 oa, ob;
        oa.x = pkq4(a[0], a[1], a[2], a[3]); oa.y = pkq4(a[4], a[5], a[6], a[7]); oa.z = pkq4(a[8], a[9], a[10], a[11]); oa.w = pkq4(a[12], a[13], a[14], a[15]);
        ob.x = pkq4(b[0], b[1], b[2], b[3]); ob.y = pkq4(b[4], b[5], b[6], b[7]); ob.z = pkq4(b[8], b[9], b[10], b[11]); ob.w = pkq4(b[12], b[13], b[14], b[15]);
        *(u32x4*)(dp + 16 * i) = oa; *(u32x4*)(dp + 2048 + 16 * i) = ob; }
    __syncthreads();
}
__device__ __forceinline__ void minigemm_tile(const float* Asrc, int lda, const float* Bsrc, int ldb, f16* out, int ldo, float scale, LAS unsigned char* lds, int tid) {
    LAS float* As = (LAS float*)lds; LAS float* Bs = (LAS float*)(lds + 32768);
#pragma unroll
    for (int i = 0; i < 4; ++i) { const int q = tid + 512 * i, d = q >> 4, r4 = q & 15; *(LAS f32x4*)(As + d * 64 + 4 * r4) = *(const f32x4*)(Asrc + (size_t)d * lda + 4 * r4); }
#pragma unroll
    for (int i = 0; i < 4; ++i) { const int q = tid + 512 * i, col = q >> 5, d4 = q & 31; const f32x4 v = *(const f32x4*)(Bsrc + (size_t)col * ldb + 4 * d4);
        LAS float* bp = Bs + col * 129 + 4 * d4; bp[0] = v[0]; bp[1] = v[1]; bp[2] = v[2]; bp[3] = v[3]; }
    __syncthreads();
    const int tk = tid & 31, tc = tid >> 5;
    float a0[4] = {0.f, 0.f, 0.f, 0.f}, a1[4] = {0.f, 0.f, 0.f, 0.f};
#pragma unroll 8
    for (int d = 0; d < 128; ++d) { const f32x4 a = *(const LAS f32x4*)(As + d * 64 + 4 * tc); const float b0 = Bs[tk * 129 + d], b1 = Bs[(tk + 32) * 129 + d];
#pragma unroll
        for (int i = 0; i < 4; ++i) { a0[i] += a[i] * b0; a1[i] += a[i] * b1; } }
#pragma unroll
    for (int i = 0; i < 4; ++i) { f16* op = out + (size_t)(4 * tc + i) * ldo + tk; op[0] = (f16)(a0[i] * scale); op[32] = (f16)(a1[i] * scale); }
    __syncthreads();
}
template <int SEC  > __device__ __forceinline__ void p0_phase(const Ptrs& P, int l, LAS unsigned char* lds, int tid, int lane, int wave, int G, int bx) {
    __syncthreads();
    unsigned char* wsw = P.ws + WS_W;
    signed char* Winq = (signed char*)(wsw + WO_INQ); f16* Winf_t = (f16*)(wsw + WO_INF); signed char* Wguq = (signed char*)(wsw + WO_GU);
    float* sw_in = (float*)(P.ws + WS_SCL) + 16384; float* sw_gu = (float*)(P.ws + WS_SCL) + 32768; f16* Wdown_t = (f16*)(wsw + WO_DOWN); f16* Wout_t = (f16*)(wsw + WO_OUT); f16* Waup_t = (f16*)(wsw + WO_AUP); f16* Wbup_t = (f16*)(wsw + WO_BUP);
    const float* w_in = P.w_in + (size_t)l * D * N_IN_SRC; const float* w_uk = P.w_uk + (size_t)l * 8 * 128 * 256; const float* w_uv = P.w_uv + (size_t)l * 8 * 256 * 128;
    const float* w_a_up = P.w_a_up + (size_t)l * 1024 * D; const float* w_b_up = P.w_b_up + (size_t)l * 512 * D; const float* w_out = P.w_out + (size_t)l * D * D;
    const float* w_g = P.w_ff_gate + (size_t)l * D * DFF; const float* w_u = P.w_ff_up + (size_t)l * D * DFF; const float* w_d = P.w_ff_down + (size_t)l * DFF * D;
    if ((SEC & 1) && l == 0 && bx < 192) {
        LAS float* sc = (LAS float*)lds; LAS float* red = (LAS float*)(lds + 32768);
        for (int i = tid; i < NB * D; i += 512) { const float v = P.c[i]; sc[i] = v / (1.0f + __expf(-v)); }
        __syncthreads();
        float* mod = (float*)(P.ws + WS_MOD);
        for (int it = bx; it < 192; it += G) {
            const int ll = it / 96, col0 = (it % 96) * 128, c4 = lane & 31, kh = lane >> 5;
            const float* wsrc = P.w_ada + (size_t)ll * D * 12288 + col0 + 4 * c4;
            f32x4 a[4];
#pragma unroll
            for (int b = 0; b < 4; ++b) a[b] = (f32x4){0.f, 0.f, 0.f, 0.f};
#pragma unroll 8
            for (int kk = 0; kk < 128; ++kk) { const int k = wave * 256 + 2 * kk + kh; const f32x4 wv = *(const f32x4*)(wsrc + (size_t)k * 12288);
#pragma unroll
                for (int b = 0; b < 4; ++b) a[b] += wv * sc[b * D + k]; }
#pragma unroll
            for (int b = 0; b < 4; ++b) {
#pragma unroll
                for (int e = 0; e < 4; ++e) a[b][e] += __shfl_xor(a[b][e], 32);
                if (kh == 0) *(LAS f32x4*)(red + (wave * 4 + b) * 128 + 4 * c4) = a[b]; }
            __syncthreads();
            { const int b = tid >> 7, col = tid & 127; float s2 = 0.f;
#pragma unroll
              for (int w = 0; w < 8; ++w) s2 += red[(w * 4 + b) * 128 + col];
              mod[(size_t)(ll * 4 + b) * 12288 + col0 + col] = s2 + P.b_ada[(size_t)ll * 12288 + col0 + col]; }
            __syncthreads();
        }
    }
    if (SEC & 2)
    for (int it = bx; it < 1024; it += G) {
        const int h = it >> 7, rem = it & 127, n0 = (rem >> 2) * 64, c0 = (rem & 3) * 64;
        minigemm_tile(w_a_up + (size_t)(h * 128) * D + n0, D, w_uv + (size_t)(h * 256 + c0) * 128, 128, Waup_t + (size_t)n0 * D + h * 256 + c0, D, 1.0f, lds, tid);
    }
    constexpr int Q_QA = 32, Q_CKV = 8, Q_QKV = 144, Q_GATES = 128, Q_FF = 176, NQITEMS = Q_QA + Q_CKV + Q_QKV + Q_GATES + 2 * Q_FF;
    if (SEC & 4)
    for (int it = bx; it < NQITEMS; it += G) {
        int r = it; const float* Wsrc = w_in; int ldw = N_IN_SRC, n0, r0; signed char* dq = Winq; float* sq = sw_in;
        if (r < Q_QA) { n0 = 32 * r; r0 = 32 * r; }
        else if ((r -= Q_QA) < Q_CKV) { n0 = 1024 + 32 * r; r0 = 1024 + 32 * r; }
        else if ((r -= Q_CKV) < Q_QKV) { n0 = 2384 + 32 * r; r0 = 1280 + 32 * r; }
        else if ((r -= Q_QKV) < Q_GATES) { n0 = 6992 + 32 * r; r0 = 5888 + 32 * r; }
        else { r -= Q_GATES; const int up = r >= Q_FF; if (up) r -= Q_FF; Wsrc = up ? w_u : w_g; ldw = DFF; n0 = 32 * r; r0 = 256 * (n0 >> 7) + 128 * up + (n0 & 127); dq = Wguq; sq = sw_gu; }
        quant_item(Wsrc, ldw, n0, dq, r0, sq, lds, tid);
    }
    LAS float* scr = (LAS float*)(lds + wave * 16384);
    const int gw = bx * NWAVES + wave, NGW = G * NWAVES;
    constexpr int I_IDX = 32 * 35, I_B = 8 * 64, I_O = 32 * 64, I_D = 88 * 64;
    constexpr int NITEMS = I_IDX + I_B + I_O + I_D;
    if (SEC & 8)
    for (int it = gw; it < NITEMS; it += NGW) {
        int r = it;
        if (r < I_IDX) { const int kb = r / 35, nb = r % 35, n0 = 1280 + 32 * nb; const int nv = (2384 - n0) < 32 ? (2384 - n0) : 32; transpose_item<0>(w_in, N_IN_SRC, 64 * kb, n0, nv, Winf_t, D, scr, lane); continue; } r -= I_IDX;
        if (r < I_B) { transpose_item<1>(w_b_up, D, 64 * (r / 64), 32 * (r % 64), 32, Wbup_t, 512, scr, lane); continue; } r -= I_B;
        if (r < I_O) { transpose_item<1>(w_out, D, 64 * (r / 64), 32 * (r % 64), 32, Wout_t, D, scr, lane); continue; } r -= I_O;
        transpose_item<1>(w_d, D, 64 * (r / 64), 32 * (r % 64), 32, Wdown_t, DFF, scr, lane);
    }
    if (!(SEC & 16)) return;
    const int gt = bx * 512 + tid, NGT = G * 512;
    { u32x4* pz = (u32x4*)(Winf_t + (size_t)1104 * D); for (int i = gt; i < 176 * D / 8; i += NGT) pz[i] = (u32x4){0u, 0u, 0u, 0u}; }
    { f16* wukT = (f16*)(wsw + WO_WUK);
      for (int i = gt; i < 8 * 256 * 16; i += NGT) { const int c = i & 255, d8 = (i >> 8) & 15, h = i >> 12; const float* src = w_uk + (size_t)(h * 128 + 8 * d8) * 256 + c; float v[8];
#pragma unroll
          for (int j = 0; j < 8; ++j) v[j] = src[j * 256] * 0.08838834764831845f;
          *(u32x4*)(wukT + (size_t)(h * 256 + c) * 128 + 8 * d8) = pkh8((f32x4){v[0], v[1], v[2], v[3]}, (f32x4){v[4], v[5], v[6], v[7]}); } }
    if (l == 0) {
        f32x2* rope = (f32x2*)(P.ws + WS_ROPE);
        for (int e = gt; e < SEQ * 16; e += NGT) {
            const int pos = e >> 4, j = e & 15, a = j >> 2, b = j & 3;
            const double fa = a == 0 ? 1.0 : a == 1 ? 0.1 : a == 2 ? 0.01 : 0.001;
            const double fb = b == 0 ? 1.0 : b == 1 ? 0.5623413251903491 : b == 2 ? 0.31622776601683794 : 0.1778279410038923;
            const double ang = (double)pos * (fa * fb);
            const double q = __builtin_rint(ang * 0.15915494309189535);
            const double rr = __builtin_fma(-q, 2.4492935982947064e-16, __builtin_fma(-q, 6.283185307179586, ang));
            const float rf = (float)rr;
            rope[e] = (f32x2){cosf(rf), sinf(rf)};
        }
        unsigned char* lut = P.ws + WS_LUT;
        for (int n = gt; n < SEQ; n += NGT) lut[n] = (unsigned char)rel_bucket_of(n);
    }
}

template <bool F16OUT> __device__ __forceinline__ void norm_mod_phase(const float* x, const float* g, const float* shift, const float* scale, f16* out, signed char* out8, float* rs, int lane, int wave, int G, int bx) {
    const int gw = bx * NWAVES + wave, NGW = G * NWAVES;
    for (int blk = gw; blk < M / 8; blk += NGW) {
        const int row0 = blk * 8, b = row0 >> 12;
        f32x4 ca[8], cs[8];
#pragma unroll
        for (int j = 0; j < 8; ++j) { const int col = 4 * lane + 256 * j; const f32x4 gg = *(const f32x4*)(g + col), sc = *(const f32x4*)(scale + (size_t)b * 12288 + col); ca[j] = gg * (sc + 1.0f); cs[j] = *(const f32x4*)(shift + (size_t)b * 12288 + col); }
        for (int r = 0; r < 8; ++r) {
            const float* xr = x + (size_t)(row0 + r) * D + 4 * lane; f32x4 v[8]; float ss = 0.f;
#pragma unroll
            for (int j = 0; j < 8; ++j) { v[j] = *(const f32x4*)(xr + 256 * j); ss += (v[j].x * v[j].x + v[j].y * v[j].y) + (v[j].z * v[j].z + v[j].w * v[j].w); }
            const float rstd = 1.0f / sqrtf(wave_sum(ss) * (1.0f / D) + NORM_EPS);
            f16* orow = out + (size_t)(row0 + r) * D + 4 * lane; float mx = 0.f;
#pragma unroll
            for (int j = 0; j < 8; ++j) { const f32x4 o = v[j] * rstd * ca[j] + cs[j]; v[j] = o; mx = fmaxf(fmaxf(mx, fmaxf(__builtin_fabsf(o.x), __builtin_fabsf(o.y))), fmaxf(__builtin_fabsf(o.z), __builtin_fabsf(o.w)));
                if (F16OUT) { u32x2 w; w.x = pkh(o.x, o.y); w.y = pkh(o.z, o.w); *(u32x2*)(orow + 256 * j) = w; } }
#pragma unroll
            for (int o = 1; o < 64; o <<= 1) mx = fmaxf(mx, __shfl_xor(mx, o));
            const float inv = mx > 0.f ? 127.0f / mx : 0.f;
            if (lane == 0) rs[row0 + r] = mx > 0.f ? mx * (1.0f / 127.0f) : 1.0f;
            signed char* qrow = out8 + (size_t)(row0 + r) * D + 4 * lane;
#pragma unroll
            for (int j = 0; j < 8; ++j) *(unsigned*)(qrow + 256 * j) = pkq4(v[j].x * inv, v[j].y * inv, v[j].z * inv, v[j].w * inv);
        }
    }
}
__device__ __forceinline__ void final_norm_phase(float* xo, const float* g, int lane, int wave, int G, int bx) {
    const int gw = bx * NWAVES + wave, NGW = G * NWAVES;
    f32x4 cg[8];
#pragma unroll
    for (int j = 0; j < 8; ++j) cg[j] = *(const f32x4*)(g + 4 * lane + 256 * j);
    for (int row = gw; row < M; row += NGW) {
        float* xr = xo + (size_t)row * D + 4 * lane; f32x4 v[8]; float ss = 0.f;
#pragma unroll
        for (int j = 0; j < 8; ++j) { v[j] = *(const f32x4*)(xr + 256 * j); ss += (v[j].x * v[j].x + v[j].y * v[j].y) + (v[j].z * v[j].z + v[j].w * v[j].w); }
        const float rstd = 1.0f / sqrtf(wave_sum(ss) * (1.0f / D) + NORM_EPS);
#pragma unroll
        for (int j = 0; j < 8; ++j) *(f32x4*)(xr + 256 * j) = v[j] * rstd * cg[j];
    }
}

__device__ __forceinline__ void wrowq_phase(const f16* W, signed char* Wq, float* sw, int lane, int wave, int G, int bx) {
    const int gw = bx * NWAVES + wave, NGW = G * NWAVES;
    for (int row = gw; row < 2048; row += NGW) {
        const f16* wr = W + (size_t)row * 2048 + 8 * lane; float v[32]; float mx = 0.f;
#pragma unroll
        for (int j = 0; j < 4; ++j) { const u32x4 w = *(const u32x4*)(wr + 512 * j); const unsigned ww[4] = {w.x, w.y, w.z, w.w};
#pragma unroll
            for (int i = 0; i < 4; ++i) { const f32x2 p = unpk(ww[i]); v[8 * j + 2 * i] = p.x; v[8 * j + 2 * i + 1] = p.y; mx = fmaxf(mx, fmaxf(__builtin_fabsf(p.x), __builtin_fabsf(p.y))); } }
#pragma unroll
        for (int o = 1; o < 64; o <<= 1) mx = fmaxf(mx, __shfl_xor(mx, o));
        const float inv = mx > 0.f ? 127.0f / mx : 0.f;
        if (lane == 0) sw[row] = mx > 0.f ? mx * (1.0f / 127.0f) : 1.0f;
#pragma unroll
        for (int j = 0; j < 4; ++j) { u32x2 o; o.x = pkq4(v[8 * j] * inv, v[8 * j + 1] * inv, v[8 * j + 2] * inv, v[8 * j + 3] * inv); o.y = pkq4(v[8 * j + 4] * inv, v[8 * j + 5] * inv, v[8 * j + 6] * inv, v[8 * j + 7] * inv);
            *(u32x2*)(Wq + (size_t)row * 2048 + 8 * lane + 512 * j) = o; }
    }
}

__device__ __forceinline__ void qlat_phase(const f16* qa, const f16* wukT, f16* qlat, int lane, int wave, int G, int bx) {
    const int gw = bx * NWAVES + wave, NGW = G * NWAVES, l15 = lane & 15, g4 = lane >> 4;
    for (int it = gw; it < (M / 64) * 8; it += NGW) {
        const int h = it & 7, t0 = (it >> 3) * 64;
        f16x8 bq[4][4];
#pragma unroll
        for (int tt = 0; tt < 4; ++tt)
#pragma unroll
            for (int k = 0; k < 4; ++k) bq[tt][k] = *(const f16x8*)(qa + (size_t)(t0 + 16 * tt + l15) * 1024 + h * 128 + 32 * k + 8 * g4);
        const f16* wp = wukT + (size_t)(h * 256 + l15) * 128 + 8 * g4;
        f16* op = qlat + (size_t)(t0 + l15) * 2048 + h * 256 + 4 * g4;
#pragma unroll 4
        for (int ct = 0; ct < 16; ++ct) {
            f16x8 aw[4];
#pragma unroll
            for (int k = 0; k < 4; ++k) aw[k] = *(const f16x8*)(wp + (size_t)(16 * ct) * 128 + 32 * k);
#pragma unroll
            for (int tt = 0; tt < 4; ++tt) { f32x4 acc = {0.f, 0.f, 0.f, 0.f};
#pragma unroll
                for (int k = 0; k < 4; ++k) acc = __builtin_amdgcn_mfma_f32_16x16x32_f16(aw[k], bq[tt][k], acc, 0, 0, 0);
                u32x2 w; w.x = pkh(acc[0], acc[1]); w.y = pkh(acc[2], acc[3]); *(u32x2*)(op + (size_t)(16 * tt) * 2048 + 16 * ct) = w; }
        }
    }
}

__device__ __forceinline__ void zfix_phase(f16* ckv, f16* qi, f16* kw, const float* kvg, const float* lng, const float* lnb, const f32x2* rope, int lane, int wave, int G, int bx) {
    const int gw = bx * NWAVES + wave, NGW = G * NWAVES;
    const f32x4 g4 = *(const f32x4*)(kvg + 4 * lane); const float lg = lng[lane], lb = lnb[lane];
    for (int blk = gw; blk < M / 8; blk += NGW)
        for (int r = 0; r < 8; ++r) {
            const int row = blk * 8 + r, pos = row & (SEQ - 1);
            { f16* z = ckv + (size_t)row * 256 + 4 * lane; const u32x2 w = *(const u32x2*)z; const f32x2 a = unpk(w.x), b = unpk(w.y);
              const float ss = wave_sum((a.x * a.x + a.y * a.y) + (b.x * b.x + b.y * b.y)); const float rstd = 1.0f / sqrtf(ss * (1.0f / 256.0f) + NORM_EPS);
              u32x2 o; o.x = pkh(a.x * rstd * g4.x, a.y * rstd * g4.y); o.y = pkh(b.x * rstd * g4.z, b.y * rstd * g4.w); *(u32x2*)z = o; }
            { f16* z = qi + (size_t)row * 1024 + 16 * lane; const u32x4 w0 = *(const u32x4*)z, w1 = *(const u32x4*)(z + 8);
              const unsigned mine[8] = {w0.x, w0.y, w0.z, w0.w, w1.x, w1.y, w1.z, w1.w}; unsigned res[8]; const int seg = lane & 3;
#pragma unroll
              for (int i = 0; i < 8; ++i) { const unsigned oth = (unsigned)__shfl_xor((int)mine[i], 1); const f32x2 me = unpk(mine[i]), ot = unpk(oth);
                  const f32x2 cs0 = rope[pos * 16 + 2 * i], cs1 = rope[pos * 16 + 2 * i + 1];
                  float r0, r1;
                  if (seg == 0) { r0 = me.x * cs0.x - ot.x * cs0.y; r1 = me.y * cs1.x - ot.y * cs1.y; }
                  else          { r0 = ot.x * cs0.y + me.x * cs0.x; r1 = ot.y * cs1.y + me.y * cs1.x; }
                  res[i] = seg < 2 ? pkh(r0, r1) : mine[i]; }
              *(u32x4*)z = (u32x4){res[0], res[1], res[2], res[3]}; *(u32x4*)(z + 8) = (u32x4){res[4], res[5], res[6], res[7]}; }
            { f16* z = kw + (size_t)row * 256 + lane; const float xv = (float)z[0]; const float mu = wave_sum(xv) * (1.0f / 64.0f); const float dv = xv - mu; const float var = wave_sum(dv * dv) * (1.0f / 64.0f);
              const float y = dv * (1.0f / sqrtf(var + NORM_EPS)) * lg + lb; const float oth = __shfl_xor(y, 16); const f32x2 cs = rope[pos * 16 + (lane & 15)];
              float o = y; if (lane < 16) o = y * cs.x - oth * cs.y; else if (lane < 32) o = oth * cs.y + y * cs.x;
              z[0] = (f16)o; }
        }
}

__device__ __forceinline__ void battn_phase(const f16* zB, const float* rel_bias, const unsigned char* lut, f16* ob, float* lse, LAS unsigned char* lds, int tid, int lane, int wave, int G, int bx) {
    LAS unsigned char* Kimg = lds; LAS unsigned char* Vimg = lds + 65536; LAS float* tb = (LAS float*)(lds + SMALL_OFF);
    const int g4 = lane >> 4, q15 = lane & 15;
    for (int uid = bx; uid < NB * 3 * 4 * 32; uid += G) {
        const int s = uid & 31, j = (uid >> 5) & 3, grp = (uid >> 7) % 3, b = uid / 384;
        const int dsh = 2 * grp, r = s & ((1 << dsh) - 1), n = s >> dsh;
        const f16* zb = zB + (size_t)b * SEQ * NZB; const int colQ = (grp * 4 + j) * 128, colK = ((3 + grp) * 4 + j) * 128, colV = ((6 + grp) * 4 + j) * 128;
#pragma unroll
        for (int i = 0; i < 8; ++i) { const int cidx = tid + 512 * i, u = cidx >> 4, ch = cidx & 15, mk = (n - 1) * 128 + u;
            u32x4 kv = {0u, 0u, 0u, 0u}, vv = {0u, 0u, 0u, 0u};
            if (mk >= 0) { const f16* rp = zb + (size_t)((mk << dsh) + r) * NZB + ch * 8; kv = *(const u32x4*)(rp + colK); vv = *(const u32x4*)(rp + colV); }
            *(LAS u32x4*)(Kimg + off_b(u, ch)) = kv; *(LAS u32x4*)(Vimg + off_b(u, ch)) = vv; }
        if (tid <= 128) tb[tid] = rel_bias[(int)lut[tid << dsh] * 20 + 8 + grp * 4 + j];
        __syncthreads();
        const int iq = 16 * wave + q15, tq = ((n * 128 + iq) << dsh) + r;
        const f16* qp = zb + (size_t)tq * NZB + colQ + 8 * g4;
        f16x8 qf[4];
#pragma unroll
        for (int k = 0; k < 4; ++k) qf[k] = *(const f16x8*)(qp + 32 * k);
        const int kstart = 32 * (wave >> 1);
        const int back0 = iq + 128 - (kstart + 8 * g4); const unsigned bmax = n > 0 ? 128u : (unsigned)iq;
        f32x4 sreg[5][2]; float mx = NEG_INF;
#pragma unroll
        for (int T = 0; T < 5; ++T)
#pragma unroll
            for (int hf = 0; hf < 2; ++hf) {
                const int krow = kstart + 32 * T + 8 * (q15 >> 2) + 4 * hf + (q15 & 3);
                f32x4 acc = {0.f, 0.f, 0.f, 0.f};
#pragma unroll
                for (int k = 0; k < 4; ++k) { const f16x8 kf = *(const LAS f16x8*)(Kimg + off_b(krow, 4 * k + g4)); acc = __builtin_amdgcn_mfma_f32_16x16x32_f16(kf, qf[k], acc, 0, 0, 0); }
#pragma unroll
                for (int e = 0; e < 4; ++e) { const unsigned back = (unsigned)(back0 - (32 * T + 4 * hf + e));
                    const bool valid = back <= bmax; const unsigned bi = back < 128u ? back : 128u;
                    const float sv = valid ? acc[e] * 0.08838834764831845f + tb[bi] : NEG_INF; acc[e] = sv; mx = fmaxf(mx, sv); }
                sreg[T][hf] = acc; }
        mx = fmaxf(mx, __shfl_xor(mx, 16)); mx = fmaxf(mx, __shfl_xor(mx, 32));
        float den = 0.f; f16x8 pf[5];
#pragma unroll
        for (int T = 0; T < 5; ++T) { float p[8];
#pragma unroll
            for (int e = 0; e < 8; ++e) { p[e] = __expf(sreg[T][e >> 2][e & 3] - mx); den += p[e]; }
            const u32x4 w = pkh8((f32x4){p[0], p[1], p[2], p[3]}, (f32x4){p[4], p[5], p[6], p[7]}); pf[T] = __builtin_bit_cast(f16x8, w); }
        den += __shfl_xor(den, 16); den += __shfl_xor(den, 32);
        const float rden = 1.0f / den;
        f16* op = ob + ((size_t)grp * M + (size_t)b * SEQ + tq) * 512 + j * 128 + 4 * g4;
        const unsigned trq = (unsigned)(q15 >> 2), trp = (unsigned)(lane & 3);
#pragma unroll
        for (int c = 0; c < 8; ++c) { f32x4 acc = {0.f, 0.f, 0.f, 0.f};
#pragma unroll
            for (int T = 0; T < 5; ++T) {
                const unsigned r0 = (unsigned)(kstart + 32 * T + 8 * g4) + trq;
                const s16x4 t0 = __builtin_amdgcn_ds_read_tr16_b64_v4i16((LAS s16x4*)(Vimg + off_b(r0, 2 * c + (trp >> 1)) + 8 * (trp & 1)));
                const s16x4 t1 = __builtin_amdgcn_ds_read_tr16_b64_v4i16((LAS s16x4*)(Vimg + off_b(r0 + 4, 2 * c + (trp >> 1)) + 8 * (trp & 1)));
                const f16x8 vf = __builtin_bit_cast(f16x8, __builtin_shufflevector(t0, t1, 0, 1, 2, 3, 4, 5, 6, 7));
                acc = __builtin_amdgcn_mfma_f32_16x16x32_f16(vf, pf[T], acc, 0, 0, 0); }
            u32x2 w; w.x = pkh(acc[0] * rden, acc[1] * rden); w.y = pkh(acc[2] * rden, acc[3] * rden); *(u32x2*)(op + 16 * c) = w; }
        if (lane < 16) lse[((size_t)grp * M + (size_t)b * SEQ + tq) * 4 + j] = mx + __logf(den);
        __syncthreads();
    }
}

__device__ __forceinline__ void score_phase(const f16* qi, const f16* kw, float* S, LAS unsigned char* lds, int tid, int lane, int wave, int G, int bx) {
    const int wq = wave & 3, wk = wave >> 2, l31 = lane & 31, lh = lane >> 5;
    LAS unsigned char* qbuf = lds + 32768; LAS f16* wS = (LAS f16*)(lds + 98304);
    for (int uid = (int)(((long)bx * (NB * 272)) / G), uend = (int)(((long)(bx + 1) * (NB * 272)) / G); uid < uend; ++uid) {
        const int b = uid / 272; int rem = uid % 272, qb = 0;
        for (;;) { const int cnt = (qb + 2) >> 1; if (rem < cnt) break; rem -= cnt; ++qb; }
        const f16* qrow0 = qi + (size_t)(b * SEQ + qb * 128) * 1024;
#define SC_DMA(hp, buf) do { _Pragma("unroll") for (int i_ = 0; i_ < 4; ++i_) { const int ii_ = 4 * wave + i_, j_ = ii_ >> 4, q_ = 8 * (ii_ & 15) + (lane >> 3), c_ = (lane & 7) ^ (q_ & 7); \
            __builtin_amdgcn_global_load_lds((const unsigned*)(qrow0 + (size_t)q_ * 1024 + (2 * (hp) + j_) * 64 + 8 * c_), (LAS unsigned*)(qbuf + (buf) * 32768 + ii_ * 1024), 16, 0, 0); } } while (0)
#pragma unroll
        for (int i = 0; i < 4; ++i) { const int q = tid + 512 * i, key = q >> 3, ch = q & 7; const int kg = 2 * rem * 128 + key;
            const u32x4 v = *(const u32x4*)(kw + (size_t)(b * SEQ + (kg < SEQ ? kg : SEQ - 1)) * 256 + 8 * ch);
            *(LAS u32x4*)(lds + key * 128 + ((ch ^ (key & 7)) << 4)) = v; }
        if (tid < 256) *(LAS u32x4*)(wS + (tid >> 1) * 16 + 8 * (tid & 1)) = *(const u32x4*)(kw + (size_t)(b * SEQ + qb * 128 + (tid >> 1)) * 256 + KW_W + 8 * (tid & 1));
        SC_DMA(0, 0);
        asm volatile("s_waitcnt vmcnt(0)" ::: "memory");
        __syncthreads();
        const int kb = 2 * rem + wk; const bool act = kb <= qb;
        f32x16 sc[4];
#pragma unroll
        for (int tl = 0; tl < 4; ++tl)
#pragma unroll
            for (int e = 0; e < 16; ++e) sc[tl][e] = 0.f;
        const LAS unsigned char* kbase = lds + (wk * 128 + l31) * 128;
        const int ql = 32 * wq + l31;
#pragma nounroll
        for (int hp = 0; hp < 8; ++hp) {
            if (hp < 7) SC_DMA(hp + 1, (hp + 1) & 1);
            if (act) {
                const LAS unsigned char* qb_ = qbuf + (hp & 1) * 32768 + ql * 128;
                f16x8 qf[2][4]; float wh[2];
#pragma unroll
                for (int j = 0; j < 2; ++j) {
#pragma unroll
                    for (int k = 0; k < 4; ++k) qf[j][k] = *(const LAS f16x8*)(qb_ + j * 16384 + (((2 * k + lh) ^ (ql & 7)) << 4));
                    wh[j] = (float)wS[ql * 16 + 2 * hp + j]; }
#pragma unroll
                for (int tl = 0; tl < 4; ++tl) {
                    f32x16 a[2];
#pragma unroll
                    for (int j = 0; j < 2; ++j)
#pragma unroll
                        for (int e = 0; e < 16; ++e) a[j][e] = 0.f;
#pragma unroll
                    for (int k = 0; k < 4; ++k) { const f16x8 kf = *(const LAS f16x8*)(kbase + tl * 4096 + (((2 * k + lh) ^ (l31 & 7)) << 4));
#pragma unroll
                        for (int j = 0; j < 2; ++j) a[j] = __builtin_amdgcn_mfma_f32_32x32x16_f16(kf, qf[j][k], a[j], 0, 0, 0); }
#pragma unroll
                    for (int j = 0; j < 2; ++j) { typedef int i32x16 __attribute__((ext_vector_type(16)));
                        const i32x16 zi = {0, 0, 0, 0, 0, 0, 0, 0, 0, 0, 0, 0, 0, 0, 0, 0};
                        const f32x16 r = __builtin_bit_cast(f32x16, __builtin_elementwise_max(__builtin_bit_cast(i32x16, a[j]), zi));
                        sc[tl] += r * wh[j]; }
                }
            }
            asm volatile("s_waitcnt vmcnt(0)" ::: "memory");
            __syncthreads();
        }
#undef SC_DMA
        if (act) {
            float* sp = S + (size_t)b * SC_BATCH + (size_t)16384 * (qb * (qb + 1) / 2) + (size_t)ql * ((qb + 1) * 128) + kb * 128 + 4 * lh;
#pragma unroll
            for (int tl = 0; tl < 4; ++tl)
#pragma unroll
                for (int a4 = 0; a4 < 4; ++a4) *(f32x4*)(sp + 32 * tl + 8 * a4) = (f32x4){sc[tl][4 * a4], sc[tl][4 * a4 + 1], sc[tl][4 * a4 + 2], sc[tl][4 * a4 + 3]};
        }
    }
}

__device__ __forceinline__ unsigned ord_key(float x) { const unsigned u = __builtin_bit_cast(unsigned, x); return u ^ ((unsigned)((int)u >> 31) | 0x80000000u); }
__device__ __forceinline__ int wave_total(int v) {
    v += __builtin_amdgcn_update_dpp(0, v, 0x111, 0xf, 0xf, true);
    v += __builtin_amdgcn_update_dpp(0, v, 0x112, 0xf, 0xf, true);
    v += __builtin_amdgcn_update_dpp(0, v, 0x114, 0xf, 0xf, true);
    v += __builtin_amdgcn_update_dpp(0, v, 0x118, 0xf, 0xf, true);
    v += __builtin_amdgcn_update_dpp(0, v, 0x142, 0xa, 0xf, true);
    v += __builtin_amdgcn_update_dpp(0, v, 0x143, 0xc, 0xf, true);
    return __builtin_amdgcn_readlane(v, 63);
}
template <int NCH> __device__ __forceinline__ void select_row(const float* src, int n, u16* orow, int lane) {
    unsigned key[4 * NCH];
#pragma unroll
    for (int j = 0; j < NCH; ++j) { const int base = 256 * j + 4 * lane; const f32x4 v = *(const f32x4*)(src + base);
#pragma unroll
        for (int e = 0; e < 4; ++e) key[4 * j + e] = ord_key(v[e]) & (unsigned)((base + e - n) >> 31); }
    unsigned tau = 0u;
    for (int bit = 31; bit >= 0; --bit) { const unsigned cand = tau | (1u << bit); int cnt = 0;
#pragma unroll
        for (int m = 0; m < 4 * NCH; ++m) cnt += (key[m] >= cand) ? 1 : 0;
        cnt = wave_total(cnt);
        if (cnt >= 256) { tau = cand; if (cnt == 256) break; } }
    int cgt = 0;
#pragma unroll
    for (int m = 0; m < 4 * NCH; ++m) cgt += (key[m] > tau) ? 1 : 0;
    cgt = wave_total(cgt);
    const int need = 256 - cgt; int og = 0, oe = 0;
    asm volatile("" : "+v"(tau));
#pragma unroll
    for (int m = 0; m < 4 * NCH; ++m) {
        const unsigned kidx = (unsigned)(256 * (m >> 2) + 4 * lane + (m & 3));
        const bool isg = key[m] > tau, ise = key[m] == tau;
        const unsigned long long bg = __ballot(isg), be = __ballot(ise);
        const unsigned lo_g = __builtin_amdgcn_mbcnt_hi((unsigned)(bg >> 32), __builtin_amdgcn_mbcnt_lo((unsigned)bg, 0u));
        const unsigned lo_e = __builtin_amdgcn_mbcnt_hi((unsigned)(be >> 32), __builtin_amdgcn_mbcnt_lo((unsigned)be, 0u));
        if (isg) orow[og + (int)lo_g] = (u16)kidx;
        else if (ise && (oe + (int)lo_e) < need) orow[cgt + oe + (int)lo_e] = (u16)kidx;
        og += __popcll(bg); oe += __popcll(be);
        __builtin_amdgcn_sched_barrier(0);
    }
}
__device__ __forceinline__ void select_one(const float* S, u16* idx, int row, int lane) {
    const int b = row >> 12, t = row & (SEQ - 1), qb = t >> 7, n = t + 1;
    u16* orow = idx + (size_t)row * 256;
    if (n <= 256) { u32x2 w; const int k = 4 * lane;
        w.x = (unsigned)(k < n ? k : 0xFFFF) | ((unsigned)(k + 1 < n ? k + 1 : 0xFFFF) << 16); w.y = (unsigned)(k + 2 < n ? k + 2 : 0xFFFF) | ((unsigned)(k + 3 < n ? k + 3 : 0xFFFF) << 16);
        *(u32x2*)(orow + k) = w; return; }
    const float* src = S + (size_t)b * SC_BATCH + (size_t)16384 * (qb * (qb + 1) / 2) + (size_t)(t & 127) * ((qb + 1) * 128);
    const int nch = (n + 255) >> 8;
    if (nch <= 2) select_row<2>(src, n, orow, lane); else if (nch <= 4) select_row<4>(src, n, orow, lane); else if (nch <= 6) select_row<6>(src, n, orow, lane);
    else if (nch <= 8) select_row<8>(src, n, orow, lane); else if (nch <= 10) select_row<10>(src, n, orow, lane); else if (nch <= 12) select_row<12>(src, n, orow, lane);
    else if (nch <= 14) select_row<14>(src, n, orow, lane); else select_row<16>(src, n, orow, lane);
}
__device__ __forceinline__ void bmerge_phase(const f16* ob, const float* lse, f16* yb, int lane, int wave, int G, int bx) {
    const int gw = bx * NWAVES + wave, NGW = G * NWAVES; const int js = lane >> 4, e0 = (lane & 15) * 8;
    for (int row = gw; row < M; row += NGW) {
        const float l0 = lse[((size_t)0 * M + row) * 4 + js], l1 = lse[((size_t)1 * M + row) * 4 + js], l2 = lse[((size_t)2 * M + row) * 4 + js];
        const float mx = fmaxf(l0, fmaxf(l1, l2)); float w0 = __expf(l0 - mx), w1 = __expf(l1 - mx), w2 = __expf(l2 - mx); const float inv = 1.0f / (w0 + w1 + w2); w0 *= inv; w1 *= inv; w2 *= inv;
        const size_t o = (size_t)row * 512 + js * 128 + e0;
        const u32x4 a = *(const u32x4*)(ob + o), bq = *(const u32x4*)(ob + (size_t)M * 512 + o), cq = *(const u32x4*)(ob + (size_t)2 * M * 512 + o);
        const unsigned aw[4] = {a.x, a.y, a.z, a.w}, bw[4] = {bq.x, bq.y, bq.z, bq.w}, cw[4] = {cq.x, cq.y, cq.z, cq.w}; unsigned rw[4];
#pragma unroll
        for (int i = 0; i < 4; ++i) { const f32x2 x0 = unpk(aw[i]), x1 = unpk(bw[i]), x2 = unpk(cw[i]); rw[i] = pkh(w0 * x0.x + w1 * x1.x + w2 * x2.x, w0 * x0.y + w1 * x1.y + w2 * x2.y); }
        *(u32x4*)(yb + o) = (u32x4){rw[0], rw[1], rw[2], rw[3]};
    }
}

template <int MODE  > __device__ __forceinline__ void dsa_phase(const float* Ssc, const f16* qlat, const f16* ckv, u16* idx, const float* rel_bias, const unsigned char* lut, signed char* olat, float* ors, LAS unsigned char* lds, int tid, int lane, int wave, int G, int bx) {
    LAS unsigned char* lutS = lds + SMALL_OFF; LAS float* biasS = (LAS float*)(lds + SMALL_OFF + 4096);
    for (int i = tid; i < SEQ / 4; i += 512) ((LAS unsigned*)lutS)[i] = ((const unsigned*)lut)[i];
    if (tid < 256) biasS[tid] = rel_bias[(tid >> 3) * 20 + (tid & 7)];
    __syncthreads();
    LAS unsigned char* kv = lds + wave * 16384;
    const int g4 = lane >> 4, head = lane & 15, hq = head & 7, l31 = lane & 31, lh = lane >> 5;
    const unsigned trq = (unsigned)(head >> 2), trp = (unsigned)(lane & 3);
    int tok0, tstride, ntok; const bool paired = G == 256;
    if (paired) { const int bsel = (bx & 7) >> 1, wib = (((bx & 7) & 1) + 2 * (bx >> 3)) * NWAVES + wave; tok0 = bsel * SEQ + wib; tstride = 512; ntok = 8; }
    else { tok0 = bx * NWAVES + wave; tstride = G * NWAVES; ntok = tok0 < M ? (M - tok0 + tstride - 1) / tstride : 0; }
#define DSA_TOK(it) (paired ? (((it) & 1) ? (tok0 & ~(SEQ - 1)) + SEQ - 1 - ((tok0 & (SEQ - 1)) + ((it) >> 1) * 512) : tok0 + ((it) >> 1) * 512) : tok0 + (it) * tstride)
    if (MODE == 0) {
        for (int it = 0; it < ntok; ++it) select_one(Ssc, idx, DSA_TOK(it), lane);
        __builtin_amdgcn_fence(__ATOMIC_SEQ_CST, "workgroup"); asm volatile("s_waitcnt vmcnt(0)" ::: "memory");
    }
    const int nsteps = ntok * 8;
    if (nsteps == 0) return;
    u32x4 GR[16]; f32x4 oacc[16]; f16x8 qf[8];
    float mrun = NEG_INF, lrun = 0.f, bvc[8];
    u16x8 my8n; int idxn;
#define DSA_ROW(st) DSA_TOK((st) >> 3)
#define DSA_IDX(st, m8, ix) do { const int st_ = (st) < nsteps ? (st) : nsteps - 1; const u16* ir_ = idx + (size_t)DSA_ROW(st_) * 256 + 32 * (st_ & 7); \
        m8 = *(const u16x8*)(ir_ + 8 * g4); ix = (int)ir_[l31]; } while (0)
#define DSA_GATHER(st, ix) do { const int st_ = (st) < nsteps ? (st) : nsteps - 1; const f16* zb_ = ckv + (size_t)(DSA_ROW(st_) >> 12) * SEQ * 256 + 8 * l31; \
        _Pragma("unroll") for (int p_ = 0; p_ < 16; ++p_) { const int ia_ = __builtin_amdgcn_readlane((ix), 2 * p_), ib_ = __builtin_amdgcn_readlane((ix), 2 * p_ + 1); int ir_ = lh ? ib_ : ia_; ir_ = ir_ == 0xFFFF ? 0 : ir_; GR[p_] = *(const u32x4*)(zb_ + (size_t)ir_ * 256); } } while (0)
#define DSA_BIAS(st, m8, bv) do { const int st_ = (st) < nsteps ? (st) : nsteps - 1; const int t_ = DSA_ROW(st_) & (SEQ - 1); int bk_[8]; \
        _Pragma("unroll") for (int e_ = 0; e_ < 8; ++e_) { const int k_ = (int)m8[e_]; const int d_ = k_ == 0xFFFF ? 0 : t_ - k_; bk_[e_] = (int)lutS[d_]; } \
        _Pragma("unroll") for (int e_ = 0; e_ < 8; ++e_) { const float b_ = biasS[bk_[e_] * 8 + hq]; bv[e_] = (int)m8[e_] == 0xFFFF ? NEG_INF : b_; } } while (0)
    { u16x8 m0; int ix0; DSA_IDX(0, m0, ix0); if (MODE != 1) DSA_GATHER(0, ix0); DSA_BIAS(0, m0, bvc); DSA_IDX(1, my8n, idxn); }
    for (int st = 0; st < nsteps; ++st) {
        const int row = DSA_ROW(st), ch = st & 7;
        if (ch == 0) {
            const f16* zq = qlat + (size_t)row * 2048;
#pragma unroll
            for (int s = 0; s < 8; ++s) { const u32x4 w = *(const u32x4*)(zq + hq * 256 + 32 * s + 8 * g4); qf[s] = head < 8 ? __builtin_bit_cast(f16x8, w) : (f16x8){0, 0, 0, 0, 0, 0, 0, 0}; }
#pragma unroll
            for (int c = 0; c < 16; ++c) oacc[c] = (f32x4){0.f, 0.f, 0.f, 0.f};
            mrun = NEG_INF; lrun = 0.f;
        }
        if (MODE != 1) {
#pragma unroll
            for (int p = 0; p < 16; ++p) *(LAS u32x4*)(kv + (l31 >> 4) * 8192 + off_b((unsigned)(2 * p + lh), (unsigned)(lane & 15))) = GR[p];
            DSA_GATHER(st + 1, idxn);
        }
        u16x8 my8nn; int idxnn; DSA_IDX(st + 2, my8nn, idxnn);
        float bvn[8]; DSA_BIAS(st + 1, my8n, bvn);
        if (MODE != 2) {
        f32x4 stl[2];
#pragma unroll
        for (int hf = 0; hf < 2; ++hf) { const unsigned krow = 8u * (unsigned)(head >> 2) + 4u * hf + (unsigned)(head & 3); f32x4 acc = {0.f, 0.f, 0.f, 0.f};
#pragma unroll
            for (int s = 0; s < 8; ++s) { const f16x8 kf = *(const LAS f16x8*)(kv + (s >> 2) * 8192 + off_b(krow, 4u * (s & 3) + (unsigned)g4)); acc = __builtin_amdgcn_mfma_f32_16x16x32_f16(kf, qf[s], acc, 0, 0, 0); }
            stl[hf] = acc; }
        float sv[8], cmax = NEG_INF;
#pragma unroll
        for (int e = 0; e < 8; ++e) { sv[e] = stl[e >> 2][e & 3] + bvc[e]; cmax = fmaxf(cmax, sv[e]); }
        if (__any(cmax > mrun + 6.0f)) {
            cmax = fmaxf(cmax, __shfl_xor(cmax, 16)); cmax = fmaxf(cmax, __shfl_xor(cmax, 32));
            const float mnew = fmaxf(mrun, cmax), alpha = __expf(mrun - mnew);
            lrun *= alpha; mrun = mnew;
            if (ch != 0) {
#pragma unroll
                for (int c = 0; c < 16; ++c) oacc[c] = oacc[c] * alpha; }
        }
        float p[8], ps = 0.f;
#pragma unroll
        for (int e = 0; e < 8; ++e) { p[e] = __expf(sv[e] - mrun); ps += p[e]; }
        lrun += ps;
        const f16x8 pf = __builtin_bit_cast(f16x8, pkh8((f32x4){p[0], p[1], p[2], p[3]}, (f32x4){p[4], p[5], p[6], p[7]}));
#pragma unroll
        for (int ct = 0; ct < 16; ++ct) {
            const unsigned r0 = 8u * (unsigned)g4 + trq, cch = 2u * (ct & 7) + (trp >> 1);
            LAS unsigned char* img = kv + (ct >> 3) * 8192;
            const s16x4 t0 = __builtin_amdgcn_ds_read_tr16_b64_v4i16((LAS s16x4*)(img + off_b(r0, cch) + 8 * (trp & 1)));
            const s16x4 t1 = __builtin_amdgcn_ds_read_tr16_b64_v4i16((LAS s16x4*)(img + off_b(r0 + 4, cch) + 8 * (trp & 1)));
            const f16x8 vf = __builtin_bit_cast(f16x8, __builtin_shufflevector(t0, t1, 0, 1, 2, 3, 4, 5, 6, 7));
            oacc[ct] = __builtin_amdgcn_mfma_f32_16x16x32_f16(vf, pf, oacc[ct], 0, 0, 0); }
        if (ch == 7) {
            lrun += __shfl_xor(lrun, 16); lrun += __shfl_xor(lrun, 32);
            const float rl = 1.0f / lrun; float mx = 0.f;
#pragma unroll
            for (int ct = 0; ct < 16; ++ct) { oacc[ct] = oacc[ct] * rl; mx = fmaxf(fmaxf(mx, fmaxf(__builtin_fabsf(oacc[ct][0]), __builtin_fabsf(oacc[ct][1]))), fmaxf(__builtin_fabsf(oacc[ct][2]), __builtin_fabsf(oacc[ct][3]))); }
            if (head >= 8) mx = 0.f;
#pragma unroll
            for (int o = 1; o < 64; o <<= 1) mx = fmaxf(mx, __shfl_xor(mx, o));
            const float inv = mx > 0.f ? 127.0f / mx : 0.f;
            if (lane == 0) ors[row] = mx > 0.f ? mx * (1.0f / 127.0f) : 1.0f;
            if (head < 8) { signed char* op = olat + (size_t)row * 2048 + head * 256 + 4 * g4;
#pragma unroll
                for (int ct = 0; ct < 16; ++ct) *(unsigned*)(op + 16 * ct) = pkq4(oacc[ct][0] * inv, oacc[ct][1] * inv, oacc[ct][2] * inv, oacc[ct][3] * inv); }
        }
        }
        my8n = my8nn; idxn = idxnn;
#pragma unroll
        for (int e = 0; e < 8; ++e) bvc[e] = bvn[e];
    }
#undef DSA_ROW
#undef DSA_IDX
#undef DSA_GATHER
#undef DSA_BIAS
#undef DSA_TOK
}
#define XB_TMO      128
#define XB_XCNT(j)  (256  + 64 * (j))
#define XB_XSUB(j)  (1280 + 64 * (j))
#define XB_XGEN(j)  (2304 + 64 * (j))
#define XB_TOP      3328
#define XB_TOPGEN   3392
#define XCD_BAR_WORDS 3456
#define XB_SPIN_CAP (1u << 18)

__device__ __forceinline__ unsigned xb_ld(unsigned* p)              { return __hip_atomic_load(p, __ATOMIC_RELAXED, __HIP_MEMORY_SCOPE_AGENT); }
__device__ __forceinline__ unsigned xb_add(unsigned* p, unsigned v) { return __hip_atomic_fetch_add(p, v, __ATOMIC_RELAXED, __HIP_MEMORY_SCOPE_AGENT); }
__device__ __forceinline__ unsigned xb_xcc_id() { return (unsigned)__builtin_amdgcn_s_getreg((3 << 11) | 20) & 0xFu; }
#define XB_SPIN(cond, bar) do { unsigned _sp = 0; while (cond) { __builtin_amdgcn_s_sleep(1); \
    if ((++_sp & 255u) == 0u) { if (xb_ld(&(bar)[XB_TMO])) break; if (_sp > XB_SPIN_CAP) { atomicAdd(&(bar)[XB_TMO], 1u); break; } } } } while (0)

struct XcdBarrier {
    unsigned* bar; unsigned x;
    volatile LAS unsigned* st;
};

__device__ __forceinline__ XcdBarrier xcd_barrier_post(unsigned* bar, volatile LAS unsigned* st) {
    XcdBarrier b; b.bar = bar; b.x = xb_xcc_id(); b.st = st;
    if (threadIdx.x == 0) (void)xb_add(&bar[XB_XCNT(b.x)], 1u);
    return b;
}
__device__ __forceinline__ void xcd_barrier_complete(unsigned* bar, unsigned x, unsigned& nloc, unsigned& nx) {
    const unsigned G = gridDim.x * gridDim.y * gridDim.z;
    unsigned sum, cnt, mine, sp = 0u;
    for (;;) {
        sum = 0u; cnt = 0u; mine = 0u;
#pragma unroll
        for (unsigned j = 0; j < 16; ++j) { const unsigned c = xb_ld(&bar[XB_XCNT(j)]); sum += c; cnt += (c > 0u) ? 1u : 0u; mine = (j == x) ? c : mine; }
        if (sum == G) break;
        __builtin_amdgcn_s_sleep(1);
        if ((++sp & 255u) == 0u) { if (xb_ld(&bar[XB_TMO])) break; if (sp > XB_SPIN_CAP) { atomicAdd(&bar[XB_TMO], 1u); break; } }
    }
    nloc = mine > 0u ? mine : 1u; nx = cnt > 0u ? cnt : 1u;
}

__device__ __forceinline__ void xcd_barrier(const XcdBarrier& b) {
    asm volatile("s_waitcnt vmcnt(0)" ::: "memory");
    __syncthreads();
    if (threadIdx.x == 0) {
        unsigned* bar = b.bar;
        __builtin_amdgcn_s_waitcnt(0);
        unsigned nloc = b.st[0], nx = b.st[1];
        if (nloc == 0u) { xcd_barrier_complete(bar, b.x, nloc, nx); b.st[0] = nloc; b.st[1] = nx; }
        const unsigned old = xb_add(&bar[XB_XSUB(b.x)], 1u);
        const unsigned gen = old / nloc;
        if (old + 1u == (gen + 1u) * nloc) {
            __builtin_amdgcn_fence(__ATOMIC_RELEASE, "agent");
            asm volatile("s_waitcnt vmcnt(0)" ::: "memory");
            const unsigned og = xb_add(&bar[XB_TOP], 1u);
            const unsigned tg = og / nx;
            if (og + 1u == (tg + 1u) * nx) xb_add(&bar[XB_TOPGEN], 1u);
            else XB_SPIN(xb_ld(&bar[XB_TOPGEN]) == tg, bar);
            __builtin_amdgcn_fence(__ATOMIC_ACQUIRE, "agent");
            xb_add(&bar[XB_XGEN(b.x)], 1u);
            asm volatile("s_waitcnt vmcnt(0)" ::: "memory");
        } else {
            XB_SPIN(xb_ld(&bar[XB_XGEN(b.x)]) == gen, bar);
            __builtin_amdgcn_fence(__ATOMIC_ACQUIRE, "agent");
            asm volatile("s_waitcnt vmcnt(0)" ::: "memory");
        }
    }
    __syncthreads();
}

#ifndef MK_PER_PHASE
#define MK_PER_PHASE 0
#endif
constexpr int N_PHASES = 12 * DEPTH + 1;
struct Args { const float* in[20]; float* out; unsigned char* ws; int ph_lo, ph_hi; };
#ifndef REPMASK
#define REPMASK 0
#endif
#ifndef ONLY_PHASE
#define ONLY_PHASE -1
#endif
#define IN(k) ((ONLY_PHASE < 0 || ((k) == 12 * DEPTH ? 12 : (k) % 12) == ONLY_PHASE) && lo <= (k) && (k) < hi)
#define SEAM(k) do { if (IN(k) && IN((k) + 1)) { XcdBarrier bb = bar; asm volatile("" : "+s"(bb.bar), "+s"(bb.x)); xcd_barrier(bb); if ((REPMASK >> 12) & 1) xcd_barrier(bb); } } while (0)
#define CAS __attribute__((address_space(4)))
#define PH_IDS int tid = tid0; asm volatile("" : "+v"(tid)); const int lane = tid & 63, wave = __builtin_amdgcn_readfirstlane(tid >> 6); (void)lane; (void)wave; \
    int G = (int)gridDim.x, bx = (int)blockIdx.x; asm volatile("" : "+s"(G), "+s"(bx)); \
    const CAS Args* ap = (const CAS Args*)__builtin_amdgcn_kernarg_segment_ptr(); asm volatile("" : "+s"(ap)); unsigned char* ws = ap->ws
#define W_INQ ((const pg8::bf16_t*)(ws + WS_W + WO_INQ))
#define W_INF_T ((f16*)(ws + WS_W + WO_INF))
#define B_H8 ((signed char*)(ws + WS_H8))
#define B_RS ((float*)(ws + WS_SCL))
#define B_SWIN ((const float*)(ws + WS_SCL) + 16384)
#define B_SWGU ((const float*)(ws + WS_SCL) + 32768)
#define B_SWA ((float*)(ws + WS_SCL) + 45056)
#define B_ORS ((float*)(ws + WS_SCL) + 49152)
#define W_AUPQ ((signed char*)(ws + WS_W + WO_AUPQ))
#define W_GUQ ((const pg8::bf16_t*)(ws + WS_W + WO_GU))
#define W_DOWN_T ((f16*)(ws + WS_W + WO_DOWN))
#define W_OUT_T ((f16*)(ws + WS_W + WO_OUT))
#define W_AUP_T ((f16*)(ws + WS_W + WO_AUP))
#define W_BUP_T ((f16*)(ws + WS_W + WO_BUP))
#define B_XA ((float*)(ws + WS_X))
#define B_H ((f16*)(ws + WS_H))
#define B_OB ((f16*)(ws + WS_H))
#define B_YB ((f16*)(ws + WS_H + 48 * MiB))
#define B_QLAT ((f16*)(ws + WS_ZA + ZO_QLAT))
#define B_QI ((f16*)(ws + WS_ZA + ZO_QI))
#define B_CKV ((f16*)(ws + WS_ZA + ZO_CKV))
#define B_KW ((f16*)(ws + WS_ZA + ZO_KW))
#define B_QA ((f16*)(ws + WS_X))
#define W_UKT ((const f16*)(ws + WS_W + WO_WUK))
#define B_ZB ((f16*)(ws + WS_ZB))
#define B_ZG ((f16*)(ws + WS_ZG))
#define B_SC ((float*)(ws + WS_ZB))
#define B_OLAT ((signed char*)(ws + WS_X))
#define B_MERGED ((f16*)(ws + WS_ZB + 64 * MiB))
#define B_ACT ((f16*)(ws + WS_ZA))
#define B_LSE ((float*)(ws + WS_LSE))
#define B_IDX ((u16*)(ws + WS_IDX))
#define B_ROPE ((const f32x2*)(ws + WS_ROPE))
#define B_LUT ((const unsigned char*)(ws + WS_LUT))
#define B_MOD ((const float*)(ws + WS_MOD) + (size_t)l * NB * 12288)
#define X_IN (l == 0 ? ap->in[0] : (const float*)ap->out)
#ifndef REPMASK
#define REPMASK 0
#endif
#define RUN(k, ...) do { { PH_IDS; __VA_ARGS__ } if ((REPMASK >> (k)) & 1) { PH_IDS; __VA_ARGS__ } } while (0)
template <int l> __device__ __forceinline__ void layer_body(LAS unsigned char* lds, const int tid0, const int lo, const int hi, const XcdBarrier& bar) {
    const int pb = 12 * l;
    if (IN(pb + 0)) { RUN(0, Ptrs P;
        P.x = ap->in[0]; P.c = ap->in[1]; P.rel_bias = ap->in[2]; P.w_ada = ap->in[3]; P.b_ada = ap->in[4]; P.norm1_g = ap->in[5]; P.w_in = ap->in[6]; P.kv_norm_g = ap->in[7];
        P.idx_ln_g = ap->in[8]; P.idx_ln_b = ap->in[9]; P.w_uk = ap->in[10]; P.w_uv = ap->in[11]; P.w_a_up = ap->in[12]; P.w_b_up = ap->in[13]; P.w_out = ap->in[14]; P.norm2_g = ap->in[15];
        P.w_ff_gate = ap->in[16]; P.w_ff_up = ap->in[17]; P.w_ff_down = ap->in[18]; P.final_g = ap->in[19]; P.out = ap->out; P.ws = ws;
        p0_phase<31>(P, l, lds, tid, lane, wave, G, bx);
        if ((REPMASK >> 20) & 1) p0_phase<1>(P, l, lds, tid, lane, wave, G, bx);
        if ((REPMASK >> 21) & 1) p0_phase<2>(P, l, lds, tid, lane, wave, G, bx);
        if ((REPMASK >> 22) & 1) p0_phase<4>(P, l, lds, tid, lane, wave, G, bx);
        if ((REPMASK >> 23) & 1) p0_phase<8>(P, l, lds, tid, lane, wave, G, bx););
        SEAM(pb + 0); }
    if (IN(pb + 1)) { RUN(1, norm_mod_phase<true>(X_IN, ap->in[5] + (size_t)l * D, B_MOD, B_MOD + D, B_H, B_H8, B_RS, lane, wave, G, bx);); { PH_IDS; wrowq_phase(W_AUP_T, W_AUPQ, B_SWA, lane, wave, G, bx); } SEAM(pb + 1); }
    if (IN(pb + 2)) { RUN(2,
        { pg8::Gemm g{(const pg8::bf16_t*)B_H8, W_INQ, M, NQ, D / 2}; pg8::StaticOrder S; S.init(M, NQ, G, bx); pg8::EpiInQ E{B_QA, B_CKV, B_ZB, B_ZG, B_RS, B_SWIN};
          pg8::gemm_phase<pg8::EpiInQ, pg8::StaticOrder, true, true, true>(lds, g, S, E); }
        __syncthreads();
        { int tb2 = tid; asm volatile("" : "+v"(tb2)); (void)tb2; pg8::Gemm g{B_H, W_INF_T, M, NF, D}; pg8::StaticOrder S; S.init(M, NF, G, G == 256 ? ((bx + 64) & 255) : bx);
          pg8::EpiInF E{B_QI, B_KW}; pg8::gemm_phase<pg8::EpiInF, pg8::StaticOrder, true, true, false>(lds, g, S, E); }
        __syncthreads();); SEAM(pb + 2); }
    if (IN(pb + 3)) { if ((REPMASK >> 14) & 1) { PH_IDS; zfix_phase((f16*)(ws + WS_X + 64 * MiB), (f16*)(ws + WS_X + 64 * MiB) + 8 * MiB, (f16*)(ws + WS_X + 64 * MiB) + 16 * MiB, ap->in[7] + (size_t)l * 256, ap->in[8] + (size_t)l * 64, ap->in[9] + (size_t)l * 64, B_ROPE, lane, wave, G, bx); }
        { PH_IDS; qlat_phase(B_QA, W_UKT, B_QLAT, lane, wave, G, bx); }
        { PH_IDS; zfix_phase(B_CKV, B_QI, B_KW, ap->in[7] + (size_t)l * 256, ap->in[8] + (size_t)l * 64, ap->in[9] + (size_t)l * 64, B_ROPE, lane, wave, G, bx); }
        RUN(3, battn_phase(B_ZB, ap->in[2], B_LUT, B_OB, B_LSE, lds, tid, lane, wave, G, bx);); SEAM(pb + 3); }
    if (IN(pb + 4)) { RUN(4, score_phase(B_QI, B_KW, B_SC, lds, tid, lane, wave, G, bx);); SEAM(pb + 4); }
    if (IN(pb + 5)) { RUN(13, bmerge_phase(B_OB, B_LSE, B_YB, lane, wave, G, bx););
        RUN(5, dsa_phase<0>(B_SC, B_QLAT, B_CKV, B_IDX, ap->in[2], B_LUT, B_OLAT, B_ORS, lds, tid, lane, wave, G, bx););
        if ((REPMASK >> 15) & 1) { PH_IDS; dsa_phase<1>(B_SC, B_QLAT, B_CKV, B_IDX, ap->in[2], B_LUT, (signed char*)(ws + WS_X + 64 * MiB), (float*)(ws + WS_X + 100 * MiB), lds, tid, lane, wave, G, bx); }
        if ((REPMASK >> 16) & 1) { PH_IDS; dsa_phase<2>(B_SC, B_QLAT, B_CKV, B_IDX, ap->in[2], B_LUT, (signed char*)(ws + WS_X + 64 * MiB), (float*)(ws + WS_X + 100 * MiB), lds, tid, lane, wave, G, bx); }
        SEAM(pb + 5); }
    if (IN(pb + 7)) { RUN(7,
        { pg8::Gemm g{(const pg8::bf16_t*)B_OLAT, (const pg8::bf16_t*)W_AUPQ, M, D, D / 2}; pg8::StaticOrder S; S.init(M, D, G, bx); pg8::EpiGate<0> E{B_ZG, B_MERGED, B_ORS, B_SWA};
          pg8::gemm_phase<pg8::EpiGate<0>, pg8::StaticOrder, true, true, true>(lds, g, S, E); }
        __syncthreads();
        { int tb2 = tid; asm volatile("" : "+v"(tb2)); (void)tb2; pg8::Gemm g{B_YB, W_BUP_T, M, D, 512}; pg8::StaticOrder S; S.init(M, D, G, bx); pg8::EpiGate<1> E{B_ZG, B_MERGED, nullptr, nullptr};
          pg8::gemm_phase<pg8::EpiGate<1>, pg8::StaticOrder, true, true>(lds, g, S, E); }
        __syncthreads();); SEAM(pb + 7); }
    if (IN(pb + 8)) { RUN(8, pg8::Gemm g{B_MERGED, W_OUT_T, M, D, D}; pg8::StaticOrder S; S.init(M, D, G, bx); pg8::EpiResid E{X_IN, B_XA, B_MOD + 2 * D};
        pg8::gemm_phase<pg8::EpiResid, pg8::StaticOrder, true, true>(lds, g, S, E);); SEAM(pb + 8); }
    if (IN(pb + 9)) { RUN(9, norm_mod_phase<false>(B_XA, ap->in[15] + (size_t)l * D, B_MOD + 3 * D, B_MOD + 4 * D, B_H, B_H8, B_RS, lane, wave, G, bx);); SEAM(pb + 9); }
    if (IN(pb + 10)) { RUN(10, pg8::Gemm g{(const pg8::bf16_t*)B_H8, W_GUQ, M, NGU, D / 2}; pg8::StaticOrder S; S.init(M, NGU, G, bx); pg8::EpiSwiGLU E{B_ACT, B_RS, B_SWGU};
        pg8::gemm_phase<pg8::EpiSwiGLU, pg8::StaticOrder, true, true, true>(lds, g, S, E);); SEAM(pb + 10); }
    if (IN(pb + 11)) { RUN(11, pg8::Gemm g{B_ACT, W_DOWN_T, M, D, DFF}; pg8::StaticOrder S; S.init(M, D, G, bx); pg8::EpiResid E{B_XA, ap->out, B_MOD + 5 * D};
        pg8::gemm_phase<pg8::EpiResid, pg8::StaticOrder, true, true>(lds, g, S, E);); SEAM(pb + 11); }
}
__global__ void __launch_bounds__(NWAVES * 64, 2) fwd(Args args) {
    extern __shared__ __attribute__((aligned(16))) unsigned char lds_raw[];
    LAS unsigned char* lds = (LAS unsigned char*)lds_raw;
    const int tid0 = threadIdx.x;
    for (int u = tid0; u < (LDS_BYTES - LDSCTL_OFF) / 4; u += NWAVES * 64) ((LAS unsigned*)(lds + LDSCTL_OFF))[u] = 0u;
    __syncthreads();
    const int lo = args.ph_lo, hi = args.ph_hi;
    XcdBarrier bar; bar.bar = (unsigned*)(args.ws + WS_CTL) + CW_BAR; bar.x = 0; bar.st = nullptr;
    if (hi - lo > 1) bar = xcd_barrier_post((unsigned*)(args.ws + WS_CTL) + CW_BAR, (volatile LAS unsigned*)(lds + MISC_OFF) + 8);
    layer_body<0>(lds, tid0, lo, hi, bar);
    layer_body<1>(lds, tid0, lo, hi, bar);
    if (IN(12 * DEPTH)) { PH_IDS; final_norm_phase(ap->out, ap->in[19], lane, wave, G, bx); }
#undef IN
#undef SEAM
}

extern "C" void kernel_launch(void* const* d_in, const int* in_sizes, int n_in, void* d_out, int out_size, void* d_ws, size_t ws_size, hipStream_t stream) {
    static int grid = 0;
    if (grid == 0) {
        if (n_in != 20 || in_sizes[0] != M * D || out_size != M * D || ws_size < WS_END) { fprintf(stderr, "kernel_launch: built for 20 inputs, x/out of %d floats, >= %zu bytes of workspace; got n_in %d, in0 %d, out %d, ws %zu; nothing launched\n", M * D, (size_t)WS_END, n_in, n_in > 0 ? in_sizes[0] : -1, out_size, ws_size); grid = -1; return; }
        int dev = 0, cus = 0, per_cu = 0;
        if (hipGetDevice(&dev) != hipSuccess || hipDeviceGetAttribute(&cus, hipDeviceAttributeMultiprocessorCount, dev) != hipSuccess) { fprintf(stderr, "kernel_launch: device query failed\n"); grid = -1; return; }
        if (hipFuncSetAttribute((const void*)fwd, hipFuncAttributeMaxDynamicSharedMemorySize, LDS_BYTES) != hipSuccess) { fprintf(stderr, "kernel_launch: hipFuncSetAttribute failed\n"); grid = -1; return; }
        if (hipOccupancyMaxActiveBlocksPerMultiprocessor(&per_cu, (const void*)fwd, NWAVES * 64, LDS_BYTES) != hipSuccess || per_cu < 1)
            fprintf(stderr, "kernel_launch: note: occupancy query reports %d workgroups per CU\n", per_cu);
        (void)hipGetLastError();
        grid = cus;
    }
    if (grid < 0) return;
    if (hipMemsetAsync((char*)d_ws + WS_CTL, 0, CTL_ZERO_BYTES, stream) != hipSuccess) { fprintf(stderr, "kernel_launch: memset failed\n"); return; }
    Args a{};
    for (int i = 0; i < 20; ++i) a.in[i] = (const float*)d_in[i];
    a.out = (float*)d_out; a.ws = (unsigned char*)d_ws;
#if MK_PER_PHASE
    for (int p = 0; p < N_PHASES; ++p) { a.ph_lo = p; a.ph_hi = p + 1; hipLaunchKernelGGL(fwd, dim3(grid), dim3(NWAVES * 64), LDS_BYTES, stream, a); }
#else
    a.ph_lo = 0; a.ph_hi = N_PHASES;
    hipLaunchKernelGGL(fwd, dim3(grid), dim3(NWAVES * 64), LDS_BYTES, stream, a);
#endif
    const hipError_t le = hipPeekAtLastError();
    if (le != hipSuccess) fprintf(stderr, "kernel_launch: launch failed: %s\n", hipGetErrorName(le));
}
```

```cpp
#include <hip/hip_runtime.h>
#include <cstdio>
#include <cstdint>

#define LAS __attribute__((address_space(3)))
#define GAS __attribute__((address_space(1)))
typedef _Float16 f16;
typedef _Float16 f16x2 __attribute__((ext_vector_type(2)));
typedef _Float16 f16x4 __attribute__((ext_vector_type(4)));
typedef _Float16 f16x8 __attribute__((ext_vector_type(8)));
typedef float f32x2 __attribute__((ext_vector_type(2)));
typedef float f32x4 __attribute__((ext_vector_type(4)));
typedef float f32x16 __attribute__((ext_vector_type(16)));
typedef unsigned u32x2 __attribute__((ext_vector_type(2)));
typedef unsigned u32x4 __attribute__((ext_vector_type(4)));
typedef short s16x4 __attribute__((ext_vector_type(4)));
typedef unsigned short u16x8 __attribute__((ext_vector_type(8)));
typedef unsigned short u16;

__device__ __forceinline__ unsigned pkh(float a, float b) { f32x2 v = {a, b}; return __builtin_bit_cast(unsigned, __builtin_convertvector(v, f16x2)); }
__device__ __forceinline__ u32x4 pkh8(f32x4 a, f32x4 b) { u32x4 w; w.x = pkh(a[0], a[1]); w.y = pkh(a[2], a[3]); w.z = pkh(b[0], b[1]); w.w = pkh(b[2], b[3]); return w; }
__device__ __forceinline__ f32x2 unpk(unsigned w) { return __builtin_convertvector(__builtin_bit_cast(f16x2, w), f32x2); }
__device__ __forceinline__ float sigm(float x) { return __builtin_amdgcn_rcpf(1.0f + __expf(-x)); }
__device__ __forceinline__ float wave_sum(float v) {
#pragma unroll
    for (int o = 1; o < 64; o <<= 1) v += __shfl_xor(v, o);
    return v;
}
namespace pg8 {
#define PG8_LAS __attribute__((address_space(3)))
typedef _Float16 bf16_t;
typedef _Float16 bf16x8 __attribute__((ext_vector_type(8)));
typedef float f32x4 __attribute__((ext_vector_type(4)));
typedef unsigned u32x4 __attribute__((ext_vector_type(4)));
constexpr int BM = 256, BK = 64, HALF = 128, HTB = HALF * BK * 2  , STAGE_BYTES = 8 * HTB, NXCD = 8, WGM = 8;

__host__ __device__ __forceinline__ int lds_byte(int r, int c) { const int st = (r >> 4) * 2 + (c >> 5), rr = r & 15, cc = c & 31, ob = rr * 64 + cc * 2; return st * 1024 + (ob ^ (((ob >> 9) & 1) << 5)); }
__host__ __device__ __forceinline__ void stage_rc(int b, int& R, int& C) { const int st = b / 1024, sb = b % 1024, swz = sb ^ (((sb >> 9) & 1) << 5); R = (st >> 1) * 16 + swz / 64; C = (st & 1) * 32 + (swz % 64) / 2; }
__host__ __device__ __forceinline__ int perm32(int rho) { const int n = rho >> 4, i = rho & 15; return 8 * (i >> 2) + 4 * n + (i & 3); }

struct Unit { int pm, pn; };
struct Gemm { const bf16_t* A; const bf16_t* Bt; int M, N, K; };
typedef int i32x4v __attribute__((ext_vector_type(4)));

struct StaticOrder {
    int nM, nN, nwg, G, c;
    __host__ __device__ void init(int M, int N, int G_, int c_) { nM = M / BM; nN = N / BM; nwg = nM * nN; G = G_; c = c_; }
    __host__ __device__ bool next(int i, Unit& u) const {
        const long L = (long)i * G + c; if (L >= nwg) return false;
        int wgid = (int)L; { const int q = nwg / NXCD, r = nwg % NXCD, xcd = wgid % NXCD, off = wgid / NXCD; wgid = (xcd < r ? xcd * (q + 1) : r * (q + 1) + (xcd - r) * q) + off; }
        const int nig = WGM * nN, gid = wgid / nig, fm = gid * WGM, gsz = (nM - fm) < WGM ? (nM - fm) : WGM;
        u.pm = fm + ((wgid % nig) % gsz); u.pn = (wgid % nig) / gsz; return true;
    }
    __device__ __forceinline__ void a_ready(const Unit&) const {}
    __device__ __forceinline__ void done(const Unit&) const {}
};

__device__ __forceinline__ f32x4 i2f4(f32x4 a) { const i32x4v v = __builtin_bit_cast(i32x4v, a); return (f32x4){(float)v[0], (float)v[1], (float)v[2], (float)v[3]}; }
struct EpiInQ {
    static constexpr bool PERM = true, AFTER_DRAIN = false;
    bf16_t *qa, *ckv, *zB, *zG; const float* rs; const float* cs;
    __device__ __forceinline__ void operator()(const f32x4 (&acc)[2][2][4][2], const Unit& u, int wr, int wc, int fr, int fq) const {
        const int row0 = u.pm * BM + wr * 64 + fr; bf16_t* base; int ld, colt; bool sg = false;
        if (u.pn < 4) { base = qa; ld = 1024; colt = u.pn * BM; } else if (u.pn < 5) { base = ckv; ld = 256; colt = 0; } else if (u.pn < 23) { base = zB; ld = 4608; colt = (u.pn - 5) * BM; } else { base = zG; ld = 4096; colt = (u.pn - 23) * BM; sg = true; }
        const int col0 = colt + wc * 32 + 8 * fq; const float* csp = cs + u.pn * BM + wc * 32 + 8 * fq;
        f32x4 cv[2][2];
#pragma unroll
        for (int bj = 0; bj < 2; ++bj)
#pragma unroll
            for (int n = 0; n < 2; ++n) cv[bj][n] = *(const f32x4*)(csp + bj * HALF + 4 * n);
#pragma unroll
        for (int ai = 0; ai < 2; ++ai)
#pragma unroll
            for (int m = 0; m < 4; ++m) { const int row = row0 + ai * HALF + m * 16; const float r = rs[row]; bf16_t* rowp = base + (size_t)row * ld + col0;
#pragma unroll
                for (int bj = 0; bj < 2; ++bj) { f32x4 v0 = i2f4(acc[ai][bj][m][0]) * cv[bj][0] * r, v1 = i2f4(acc[ai][bj][m][1]) * cv[bj][1] * r;
                    if (sg) {
#pragma unroll
                        for (int j = 0; j < 4; ++j) { v0[j] = sigm(v0[j]); v1[j] = sigm(v1[j]); } }
                    *(u32x4*)(rowp + bj * HALF) = pkh8(v0, v1); } }
    }
};
struct EpiInF {
    static constexpr bool PERM = true, AFTER_DRAIN = false;
    bf16_t *qi, *kw;
    __device__ __forceinline__ void operator()(const f32x4 (&acc)[2][2][4][2], const Unit& u, int wr, int wc, int fr, int fq) const {
        bf16_t* base; int ld, colt;
        if (u.pn < 4) { base = qi; ld = 1024; colt = u.pn * BM; } else { base = kw; ld = 256; colt = 0; }
        const int row0 = u.pm * BM + wr * 64 + fr, col0 = colt + wc * 32 + 8 * fq;
#pragma unroll
        for (int ai = 0; ai < 2; ++ai)
#pragma unroll
            for (int m = 0; m < 4; ++m) { bf16_t* rowp = base + (size_t)(row0 + ai * HALF + m * 16) * ld + col0;
#pragma unroll
                for (int bj = 0; bj < 2; ++bj) *(u32x4*)(rowp + bj * HALF) = pkh8(acc[ai][bj][m][0], acc[ai][bj][m][1]); }
    }
};
template <int MODE> struct EpiGate {
    static constexpr bool PERM = true, AFTER_DRAIN = false;
    const bf16_t* zG; bf16_t* out; const float* rs; const float* cs;
    __device__ __forceinline__ void operator()(const f32x4 (&acc)[2][2][4][2], const Unit& u, int wr, int wc, int fr, int fq) const {
        const int row0 = u.pm * BM + wr * 64 + fr, col0 = u.pn * BM + wc * 32 + 8 * fq;
        f32x4 cv[2][2];
        if (MODE == 0) {
#pragma unroll
            for (int bj = 0; bj < 2; ++bj)
#pragma unroll
                for (int n = 0; n < 2; ++n) cv[bj][n] = *(const f32x4*)(cs + col0 + bj * HALF + 4 * n); }
#pragma unroll
        for (int ai = 0; ai < 2; ++ai)
#pragma unroll
            for (int m = 0; m < 4; ++m) { const size_t row = (size_t)(row0 + ai * HALF + m * 16); const float r = MODE == 0 ? rs[row] : 1.0f;
#pragma unroll
                for (int bj = 0; bj < 2; ++bj) {
                    const u32x4 gw = *(const u32x4*)(zG + row * 4096 + MODE * 2048 + col0 + bj * HALF);
                    const f32x2 g0 = unpk(gw.x), g1 = unpk(gw.y), g2 = unpk(gw.z), g3 = unpk(gw.w);
                    f32x4 v0, v1;
                    if (MODE == 0) { v0 = i2f4(acc[ai][bj][m][0]) * cv[bj][0] * r; v1 = i2f4(acc[ai][bj][m][1]) * cv[bj][1] * r; } else { v0 = acc[ai][bj][m][0]; v1 = acc[ai][bj][m][1]; }
                    v0 = v0 * (f32x4){g0.x, g0.y, g1.x, g1.y}; v1 = v1 * (f32x4){g2.x, g2.y, g3.x, g3.y};
                    bf16_t* op = out + row * 2048 + col0 + bj * HALF;
                    if (MODE == 1) { const u32x4 pw = *(const u32x4*)op; const f32x2 p0 = unpk(pw.x), p1 = unpk(pw.y), p2 = unpk(pw.z), p3 = unpk(pw.w);
                        v0 += (f32x4){p0.x, p0.y, p1.x, p1.y}; v1 += (f32x4){p2.x, p2.y, p3.x, p3.y}; }
                    *(u32x4*)op = pkh8(v0, v1);
                    asm volatile("" ::: "memory"); } }
    }
};
struct EpiResid {
    static constexpr bool PERM = false, AFTER_DRAIN = false;
    const float* xi; float* xo; const float* gate;
    __device__ __forceinline__ void operator()(const f32x4 (&acc)[2][2][4][2], const Unit& u, int wr, int wc, int fr, int fq) const {
        const int row0 = u.pm * BM + wr * 64 + fr, col0 = u.pn * BM + wc * 32 + 4 * fq; const float* gp = gate + (size_t)(u.pm >> 4) * 12288 + col0;
        f32x4 gv[2][2];
#pragma unroll
        for (int bj = 0; bj < 2; ++bj)
#pragma unroll
            for (int n = 0; n < 2; ++n) gv[bj][n] = *(const f32x4*)(gp + bj * HALF + n * 16);
#pragma unroll
        for (int ai = 0; ai < 2; ++ai)
#pragma unroll
            for (int m = 0; m < 4; ++m) { const size_t off = (size_t)(row0 + ai * HALF + m * 16) * 2048 + col0;
#pragma unroll
                for (int bj = 0; bj < 2; ++bj)
#pragma unroll
                    for (int n = 0; n < 2; ++n) *(f32x4*)(xo + off + bj * HALF + n * 16) = *(const f32x4*)(xi + off + bj * HALF + n * 16) + gv[bj][n] * acc[ai][bj][m][n];
                asm volatile("" ::: "memory"); }
    }
};
struct EpiSwiGLU {
    static constexpr bool PERM = true, AFTER_DRAIN = false;
    bf16_t* act; const float* rs; const float* cs;
    __device__ __forceinline__ void operator()(const f32x4 (&acc)[2][2][4][2], const Unit& u, int wr, int wc, int fr, int fq) const {
        const int row0 = u.pm * BM + wr * 64 + fr, col0 = u.pn * HALF + wc * 32 + 8 * fq; const float* csp = cs + u.pn * BM + wc * 32 + 8 * fq;
        f32x4 cv[2][2];
#pragma unroll
        for (int bj = 0; bj < 2; ++bj)
#pragma unroll
            for (int n = 0; n < 2; ++n) cv[bj][n] = *(const f32x4*)(csp + bj * HALF + 4 * n);
#pragma unroll
        for (int ai = 0; ai < 2; ++ai)
#pragma unroll
            for (int m = 0; m < 4; ++m) { f32x4 o[2]; const int row = row0 + ai * HALF + m * 16; const float r = rs[row];
#pragma unroll
                for (int n = 0; n < 2; ++n) { const f32x4 g = i2f4(acc[ai][0][m][n]) * cv[0][n] * r, up = i2f4(acc[ai][1][m][n]) * cv[1][n] * r;
#pragma unroll
                    for (int j = 0; j < 4; ++j) o[n][j] = g[j] * sigm(g[j]) * up[j]; }
                *(u32x4*)(act + (size_t)row * 5632 + col0) = pkh8(o[0], o[1]); }
    }
};
template <class Epi, class Sched, bool ALIGN_EPI = false, bool SP2 = false, bool I8 = false>
__device__ __forceinline__ void gemm_phase(PG8_LAS unsigned char* lds, const Gemm g, const Sched& S, const Epi& E) {
    int tid_ = threadIdx.x; asm volatile("" : "+v"(tid_));
    const int tid = tid_, wid = __builtin_amdgcn_readfirstlane(tid >> 6), lane = tid & 63, wr = wid >> 2, wc = wid & 3, fr = lane & 15, fq = lane >> 4;
    const int K = g.K, nt = K / BK;
    unsigned voffA[2], voffB[2];
#pragma unroll
    for (int i = 0; i < 2; ++i) { int R, C; stage_rc(tid * 16 + i * 8192, R, C); const int Rb = Epi::PERM ? ((R & ~31) + perm32(R & 31)) : R;
        voffA[i] = (unsigned)(R * K + C) * 2u; voffB[i] = (unsigned)(Rb * K + C) * 2u; }
    const size_t kstep = (size_t)(BK * 2);
    const size_t hstep = (size_t)HALF * K * 2;
    const size_t tstep = 2 * hstep;
    const unsigned ldsw = (unsigned)wid * 1024u;
    const int aoff = lds_byte(wr * 64 + fr, fq * 8), boff = lds_byte(wc * 32 + fr, fq * 8);
#define PG8_SA(b, h) (((b) * 2 + (h)) * HTB)
#define PG8_SB(b, h) ((4 + (b) * 2 + (h)) * HTB)
#define PG8_STAGE(bufoff, gbase, voff) do { _Pragma("unroll") for (int _i = 0; _i < 2; ++_i) \
        __builtin_amdgcn_global_load_lds((const unsigned*)((const char*)(gbase) + (voff)[_i]), (PG8_LAS unsigned*)(lds + (bufoff) + ldsw + _i * 8192), 16, 0, 0); } while (0)
#define PG8_LDA(dst, b, h) do { _Pragma("unroll") for (int m = 0; m < 4; ++m) _Pragma("unroll") for (int k = 0; k < 2; ++k) dst[m][k] = *(const PG8_LAS bf16x8*)(lds + PG8_SA(b, h) + aoff + m * 2048 + k * 1024); } while (0)
#define PG8_LDB(dst, b, h) do { _Pragma("unroll") for (int n = 0; n < 2; ++n) _Pragma("unroll") for (int k = 0; k < 2; ++k) dst[n][k] = *(const PG8_LAS bf16x8*)(lds + PG8_SB(b, h) + boff + n * 2048 + k * 1024); } while (0)
#define PG8_MMA(ai, bj, At, Bt) do { __builtin_amdgcn_s_setprio(1); _Pragma("unroll") for (int m = 0; m < 4; ++m) _Pragma("unroll") for (int n = 0; n < 2; ++n) _Pragma("unroll") for (int k = 0; k < 2; ++k) { \
        if constexpr (I8) acc[ai][bj][m][n] = __builtin_bit_cast(f32x4, __builtin_amdgcn_mfma_i32_16x16x64_i8(__builtin_bit_cast(i32x4v, Bt[n][k]), __builtin_bit_cast(i32x4v, At[m][k]), __builtin_bit_cast(i32x4v, acc[ai][bj][m][n]), 0, 0, 0)); \
        else acc[ai][bj][m][n] = __builtin_amdgcn_mfma_f32_16x16x32_f16(Bt[n][k], At[m][k], acc[ai][bj][m][n], 0, 0, 0); } __builtin_amdgcn_s_setprio(0); } while (0)
#define PG8_WAIT_V(n) asm volatile("s_waitcnt vmcnt(" #n ")" ::: "memory")
#define PG8_WAIT_L(n) asm volatile("s_waitcnt lgkmcnt(" #n ")" ::: "memory")
#define PG8_BAR __builtin_amdgcn_s_barrier()
#define PG8_SCHED __builtin_amdgcn_sched_barrier(0)
    Unit cur, nxt; int ui = 0;
    if (!S.next(0, cur)) return;
    f32x4 acc[2][2][4][2];
#pragma unroll
    for (int a = 0; a < 2; ++a)
#pragma unroll
        for (int b = 0; b < 2; ++b)
#pragma unroll
            for (int m = 0; m < 4; ++m)
#pragma unroll
                for (int n = 0; n < 2; ++n) acc[a][b][m][n] = (f32x4){0.f, 0.f, 0.f, 0.f};
    bf16x8 At[4][2], B0[2][2], B1[2][2];
    const char* cA = (const char*)g.A + (size_t)cur.pm * tstep; const char* cB = (const char*)g.Bt + (size_t)cur.pn * tstep;
    S.a_ready(cur);
    if constexpr (SP2) {
        PG8_STAGE(PG8_SB(0, 0), cB, voffB); PG8_STAGE(PG8_SB(0, 1), cB + hstep, voffB); PG8_STAGE(PG8_SA(0, 0), cA, voffA); PG8_STAGE(PG8_SA(0, 1), cA + hstep, voffA);
        if (wr == 1) PG8_BAR;
        PG8_WAIT_V(2); PG8_BAR;
        PG8_STAGE(PG8_SB(1, 0), cB + kstep, voffB); PG8_STAGE(PG8_SA(1, 0), cA + kstep, voffA); PG8_STAGE(PG8_SB(1, 1), cB + hstep + kstep, voffB);
        PG8_WAIT_V(6); PG8_BAR;
    } else {
        PG8_STAGE(PG8_SB(0, 0), cB, voffB); PG8_STAGE(PG8_SA(0, 0), cA, voffA); PG8_STAGE(PG8_SB(0, 1), cB + hstep, voffB); PG8_STAGE(PG8_SA(0, 1), cA + hstep, voffA);
        if (wr == 1) PG8_BAR;
        PG8_WAIT_V(4); PG8_BAR;
        PG8_STAGE(PG8_SB(1, 0), cB + kstep, voffB); PG8_STAGE(PG8_SA(1, 0), cA + kstep, voffA); PG8_STAGE(PG8_SB(1, 1), cB + hstep + kstep, voffB);
        PG8_WAIT_V(6); PG8_BAR;
    }
    for (;;) {
        const bool has_next = S.next(ui + 1, nxt);
        const char* nA = has_next ? (const char*)g.A + (size_t)nxt.pm * tstep : cA; const char* nB = has_next ? (const char*)g.Bt + (size_t)nxt.pn * tstep : cB;
        for (int t = 0; t < nt; t += 2) {
            const bool last = (t == nt - 2);
            const char* a1 = cA + (size_t)(t + 1) * kstep;
            const char* a2 = last ? nA : cA + (size_t)(t + 2) * kstep; const char* b2 = last ? nB : cB + (size_t)(t + 2) * kstep;
            const char* a3 = a2 + kstep; const char* b3 = b2 + kstep;
            if (last && has_next) S.a_ready(nxt);
            if constexpr (SP2) {
            PG8_LDB(B0, 0, 0); PG8_LDB(B1, 0, 1); PG8_SCHED; PG8_LDA(At, 0, 0); PG8_STAGE(PG8_SA(1, 1), a1 + hstep, voffA);
            PG8_WAIT_V(8); PG8_WAIT_L(0); PG8_BAR; PG8_MMA(0, 0, At, B0); PG8_MMA(0, 1, At, B1); PG8_BAR; PG8_SCHED;
            PG8_LDA(At, 0, 1); PG8_STAGE(PG8_SB(0, 0), b2, voffB); PG8_STAGE(PG8_SB(0, 1), b2 + hstep, voffB); PG8_STAGE(PG8_SA(0, 0), a2, voffA);
            PG8_WAIT_V(8); PG8_WAIT_L(0); PG8_BAR; PG8_MMA(1, 0, At, B0); PG8_MMA(1, 1, At, B1); PG8_BAR; PG8_SCHED;
            PG8_LDB(B0, 1, 0); PG8_LDB(B1, 1, 1); PG8_SCHED; PG8_LDA(At, 1, 0); PG8_STAGE(PG8_SA(0, 1), a2 + hstep, voffA);
            PG8_WAIT_V(8); PG8_WAIT_L(0); PG8_BAR; PG8_MMA(0, 0, At, B0); PG8_MMA(0, 1, At, B1); PG8_BAR; PG8_SCHED;
            PG8_LDA(At, 1, 1); PG8_STAGE(PG8_SB(1, 0), b3, voffB); PG8_STAGE(PG8_SB(1, 1), b3 + hstep, voffB); PG8_STAGE(PG8_SA(1, 0), a3, voffA);
            PG8_WAIT_V(8); PG8_WAIT_L(0); PG8_BAR; PG8_MMA(1, 0, At, B0); PG8_MMA(1, 1, At, B1); PG8_BAR; PG8_SCHED;
            } else {
            PG8_LDB(B0, 0, 0); PG8_SCHED; PG8_LDA(At, 0, 0); PG8_STAGE(PG8_SA(1, 1), a1 + hstep, voffA);
            PG8_WAIT_L(8); PG8_BAR; PG8_WAIT_L(0); PG8_MMA(0, 0, At, B0); PG8_BAR; PG8_SCHED;
            PG8_LDB(B1, 0, 1); PG8_STAGE(PG8_SB(0, 0), b2, voffB);
            PG8_BAR; PG8_WAIT_L(0); PG8_MMA(0, 1, At, B1); PG8_BAR;
            PG8_LDA(At, 0, 1); PG8_STAGE(PG8_SA(0, 0), a2, voffA);
            PG8_BAR; PG8_WAIT_L(0); PG8_MMA(1, 0, At, B0); PG8_BAR; PG8_SCHED;
            PG8_STAGE(PG8_SB(0, 1), b2 + hstep, voffB);
            PG8_WAIT_V(6); PG8_BAR; PG8_MMA(1, 1, At, B1); PG8_BAR;
            PG8_LDB(B0, 1, 0); PG8_SCHED; PG8_LDA(At, 1, 0); PG8_STAGE(PG8_SA(0, 1), a2 + hstep, voffA);
            PG8_WAIT_L(8); PG8_BAR; PG8_WAIT_L(0); PG8_MMA(0, 0, At, B0); PG8_BAR; PG8_SCHED;
            PG8_LDB(B1, 1, 1); PG8_STAGE(PG8_SB(1, 0), b3, voffB);
            PG8_BAR; PG8_WAIT_L(0); PG8_MMA(0, 1, At, B1); PG8_BAR;
            PG8_LDA(At, 1, 1); PG8_STAGE(PG8_SA(1, 0), a3, voffA);
            PG8_BAR; PG8_WAIT_L(0); PG8_MMA(1, 0, At, B0); PG8_BAR; PG8_SCHED;
            PG8_STAGE(PG8_SB(1, 1), b3 + hstep, voffB);
            PG8_WAIT_V(6); PG8_BAR; PG8_MMA(1, 1, At, B1); PG8_BAR;
            }
        }
        if constexpr (ALIGN_EPI) { if (wr == 0) PG8_BAR; }
        if constexpr (!Epi::AFTER_DRAIN) { E(acc, cur, wr, wc, fr, fq); S.done(cur); }
        if (!has_next) break;
#pragma unroll
        for (int a = 0; a < 2; ++a)
#pragma unroll
            for (int b = 0; b < 2; ++b)
#pragma unroll
                for (int m = 0; m < 4; ++m)
#pragma unroll
                    for (int n = 0; n < 2; ++n) acc[a][b][m][n] = (f32x4){0.f, 0.f, 0.f, 0.f};
        cur = nxt; cA = nA; cB = nB; ++ui;
        if constexpr (ALIGN_EPI) { if (wr == 1) PG8_BAR; }
    }
    PG8_WAIT_V(0);
    if constexpr (!ALIGN_EPI) { if (wr == 0) PG8_BAR; }
    PG8_BAR;
    if constexpr (Epi::AFTER_DRAIN) { E.fused(acc, cur, wr, wc, fr, fq, lds, wid, lane); S.done(cur); }
#undef PG8_SA
#undef PG8_SB
#undef PG8_STAGE
#undef PG8_LDA
#undef PG8_LDB
#undef PG8_MMA
#undef PG8_WAIT_V
#undef PG8_WAIT_L
#undef PG8_BAR
#undef PG8_SCHED
}
}

constexpr int NB = 4, SEQ = 4096, M = NB * SEQ, D = 2048, DEPTH = 2;
constexpr int N_IN_SRC = 11088, NQ = 9984  , NF = 1280  ;
constexpr int NZA = 3584, NZB = 4608, NZG = 4096, NIN = 12288;
constexpr int KW_W = 64;
constexpr int DFF = 5632, NGU = 2 * DFF;
constexpr int NWAVES = 8;
constexpr float NORM_EPS = 1e-6f, NEG_INF = -1e30f;
constexpr int SC_BATCH = 8650752;

constexpr size_t MiB = 1u << 20;
constexpr size_t WS_CTL = 0, CTL_ZERO_BYTES = 1 * MiB;
constexpr size_t WS_MOD = 1 * MiB;
constexpr size_t WS_ROPE = 2 * MiB;
constexpr size_t WS_LUT = 2 * MiB + 768 * 1024;
constexpr size_t WS_LSE = 3 * MiB;
constexpr size_t WS_IDX = 4 * MiB;
constexpr size_t WS_W = 12 * MiB;
constexpr size_t WO_INQ = 0  , WO_INF = 24 * MiB  , WO_WUK = 32 * MiB  , WO_AUPQ = 36 * MiB  , WO_GU   = 48 * MiB, WO_DOWN = 92 * MiB, WO_OUT = 114 * MiB, WO_AUP = 122 * MiB, WO_BUP = 130 * MiB;
constexpr size_t WS_X = 144 * MiB;
constexpr size_t WS_H = 272 * MiB;
constexpr size_t WS_ZA = 336 * MiB;
constexpr size_t ZO_QLAT = 0, ZO_QI = 64 * MiB, ZO_CKV = 96 * MiB, ZO_KW = 104 * MiB;
constexpr size_t WS_ZB = 448 * MiB;
constexpr size_t WS_ZG = 592 * MiB;
constexpr size_t WS_H8 = 720 * MiB;
constexpr size_t WS_SCL = 2 * MiB + 512 * 1024;
constexpr size_t WS_END = 752 * MiB;
constexpr int CW_BAR = 4096;

constexpr int RING_BYTES = 131072;
constexpr int LDSCTL_OFF = RING_BYTES, MISC_OFF = LDSCTL_OFF + 320;
constexpr int SMALL_OFF = RING_BYTES + 1024;
constexpr int LDS_BYTES = 147456;

__device__ __forceinline__ unsigned off_b(unsigned row, unsigned ch) { return 256u * row + 16u * (ch ^ (((row & 3) << 2) | ((row >> 2) & 3))); }
__device__ __forceinline__ int rel_bucket_of(int n) {
    if (n < 16) return n;
    int b = 16;
    b += (n >= 22) + (n >= 30) + (n >= 40) + (n >= 54) + (n >= 73) + (n >= 99) + (n >= 134) + (n >= 182) + (n >= 246) + (n >= 332) + (n >= 450) + (n >= 609) + (n >= 825) + (n >= 1117) + (n >= 1513);
    return b;
}

struct Ptrs {
    const float *x, *c, *rel_bias, *w_ada, *b_ada, *norm1_g, *w_in, *kv_norm_g, *idx_ln_g, *idx_ln_b, *w_uk, *w_uv, *w_a_up, *w_b_up, *w_out, *norm2_g, *w_ff_gate, *w_ff_up, *w_ff_down, *final_g;
    float* out; unsigned char* ws;
};

__device__ __forceinline__ unsigned pkq4(float a, float b, float c, float d) {
    const int q0 = (int)__builtin_rintf(a), q1 = (int)__builtin_rintf(b), q2 = (int)__builtin_rintf(c), q3 = (int)__builtin_rintf(d);
    return (unsigned)(q0 & 255) | ((unsigned)(q1 & 255) << 8) | ((unsigned)(q2 & 255) << 16) | ((unsigned)q3 << 24); }
template <int MAP> __device__ __forceinline__ int map_row(int n, float& sc) {
    sc = 1.0f;
    if (MAP == 0) {
        if (n < 2304) return n - 1280;
        if (n < 2368) return 1024 + (n - 2304);
        sc = 0.03125f; return 1088 + (n - 2368);
    }
    return n;
}
template <int MAP> __device__ __forceinline__ void transpose_item(const float* W, int ldw, int k0, int n0, int nvalid, f16* WT, int K, LAS float* scr, int lane) {
    const int c4 = lane & 7, kr = lane >> 3; f32x4 v[8];
#pragma unroll
    for (int i = 0; i < 8; ++i) v[i] = (4 * c4 < nvalid) ? *(const f32x4*)(W + (size_t)(k0 + 8 * i + kr) * ldw + n0 + 4 * c4) : (f32x4){0.f, 0.f, 0.f, 0.f};
#pragma unroll
    for (int i = 0; i < 8; ++i) { LAS float* sp = scr + (8 * i + kr) * 33 + 4 * c4; sp[0] = v[i][0]; sp[1] = v[i][1]; sp[2] = v[i][2]; sp[3] = v[i][3]; }
    asm volatile("s_waitcnt lgkmcnt(0)" ::: "memory");
    const int c = lane & 7;
#pragma unroll
    for (int j = 0; j < 4; ++j) { const int n = (lane >> 3) + 8 * j; const LAS float* s = scr + (8 * c) * 33 + n;
        if (n < nvalid) { float sc; const int row = map_row<MAP>(n0 + n, sc);
            u32x4 o; o.x = pkh(s[0 * 33] * sc, s[1 * 33] * sc); o.y = pkh(s[2 * 33] * sc, s[3 * 33] * sc); o.z = pkh(s[4 * 33] * sc, s[5 * 33] * sc); o.w = pkh(s[6 * 33] * sc, s[7 * 33] * sc);
            *(u32x4*)(WT + (size_t)row * K + k0 + 8 * c) = o; } }
    asm volatile("s_waitcnt lgkmcnt(0)" ::: "memory");
}
__device__ __forceinline__ void quant_item(const float* W, int ldw, int n0, signed char* dst, int r0, float* sw, LAS unsigned char* lds, int tid) {
    LAS f16* T = (LAS f16*)lds; LAS float* pm = (LAS float*)(lds + SMALL_OFF);
#pragma unroll
    for (int hb = 0; hb < 2; ++hb) { f32x4 v[16];
#pragma unroll
        for (int i = 0; i < 16; ++i) { const int q = tid + 512 * (16 * hb + i), k = q >> 3, c4 = q & 7; v[i] = *(const f32x4*)(W + (size_t)k * ldw + n0 + 4 * c4); }
#pragma unroll
        for (int i = 0; i < 16; ++i) { const int q = tid + 512 * (16 * hb + i), k = q >> 3, c4 = q & 7; u32x2 w; w.x = pkh(v[i][0], v[i][1]); w.y = pkh(v[i][2], v[i][3]); *(LAS u32x2*)(T + k * 32 + 4 * c4) = w; } }
    __syncthreads();
    const int c2 = tid & 15, ks = tid >> 4; const LAS unsigned* tp = (const LAS unsigned*)(T + (64 * ks) * 32 + 2 * c2);
    float mx0 = 0.f, mx1 = 0.f;
#pragma unroll 16
    for (int j = 0; j < 64; ++j) { const f32x2 p = unpk(tp[j * 16]); mx0 = fmaxf(mx0, __builtin_fabsf(p.x)); mx1 = fmaxf(mx1, __builtin_fabsf(p.y)); }
    pm[ks * 32 + 2 * c2] = mx0; pm[ks * 32 + 2 * c2 + 1] = mx1;
    __syncthreads();
    mx0 = 0.f; mx1 = 0.f;
#pragma unroll
    for (int j = 0; j < 32; ++j) { mx0 = fmaxf(mx0, pm[j * 32 + 2 * c2]); mx1 = fmaxf(mx1, pm[j * 32 + 2 * c2 + 1]); }
    const float inv0 = mx0 > 0.f ? 127.0f / mx0 : 0.f, inv1 = mx1 > 0.f ? 127.0f / mx1 : 0.f;
    if (tid < 16) { sw[r0 + 2 * c2] = mx0 > 0.f ? mx0 * (1.0f / 127.0f) : 1.0f; sw[r0 + 2 * c2 + 1] = mx1 > 0.f ? mx1 * (1.0f / 127.0f) : 1.0f; }
    signed char* dp = dst + (size_t)(r0 + 2 * c2) * 2048 + 64 * ks;
#pragma unroll
    for (int i = 0; i < 4; ++i) { float a[16], b[16];
#pragma unroll
        for (int j = 0; j < 16; ++j) { const f32x2 p = unpk(tp[(16 * i + j) * 16]); a[j] = p.x * inv0; b[j] = p.y * inv1; }
        u32x4 oa, ob;
        oa.x = pkq4(a[0], a[1], a[2], a[3]); oa.y = pkq4(a[4], a[5], a[6], a[7]); oa.z = pkq4(a[8], a[9], a[10], a[11]); oa.w = pkq4(a[12], a[13], a[14], a[15]);
        ob.x = pkq4(b[0], b[1], b[2], b[3]); ob.y = pkq4(b[4], b[5], b[6], b[7]); ob.z = pkq4(b[8], b[9], b[10], b[11]); ob.w = pkq4(b[12], b[13], b[14], b[15]);
        *(u32x4*)(dp + 16 * i) = oa; *(u32x4*)(dp + 2048 + 16 * i) = ob; }
    __syncthreads();
}
__device__ __forceinline__ void minigemm_tile(const float* Asrc, int lda, const float* Bsrc, int ldb, f16* out, int ldo, float scale, LAS unsigned char* lds, int tid) {
    LAS float* As = (LAS float*)lds; LAS float* Bs = (LAS float*)(lds + 32768);
#pragma unroll
    for (int i = 0; i < 4; ++i) { const int q = tid + 512 * i, d = q >> 4, r4 = q & 15; *(LAS f32x4*)(As + d * 64 + 4 * r4) = *(const f32x4*)(Asrc + (size_t)d * lda + 4 * r4); }
#pragma unroll
    for (int i = 0; i < 4; ++i) { const int q = tid + 512 * i, col = q >> 5, d4 = q & 31; const f32x4 v = *(const f32x4*)(Bsrc + (size_t)col * ldb + 4 * d4);
        LAS float* bp = Bs + col * 129 + 4 * d4; bp[0] = v[0]; bp[1] = v[1]; bp[2] = v[2]; bp[3] = v[3]; }
    __syncthreads();
    const int tk = tid & 31, tc = tid >> 5;
    float a0[4] = {0.f, 0.f, 0.f, 0.f}, a1[4] = {0.f, 0.f, 0.f, 0.f};
#pragma unroll 8
    for (int d = 0; d < 128; ++d) { const f32x4 a = *(const LAS f32x4*)(As + d * 64 + 4 * tc); const float b0 = Bs[tk * 129 + d], b1 = Bs[(tk + 32) * 129 + d];
#pragma unroll
        for (int i = 0; i < 4; ++i) { a0[i] += a[i] * b0; a1[i] += a[i] * b1; } }
#pragma unroll
    for (int i = 0; i < 4; ++i) { f16* op = out + (size_t)(4 * tc + i) * ldo + tk; op[0] = (f16)(a0[i] * scale); op[32] = (f16)(a1[i] * scale); }
    __syncthreads();
}
template <int SEC  > __device__ __forceinline__ void p0_phase(const Ptrs& P, int l, LAS unsigned char* lds, int tid, int lane, int wave, int G, int bx) {
    __syncthreads();
    unsigned char* wsw = P.ws + WS_W;
    signed char* Winq = (signed char*)(wsw + WO_INQ); f16* Winf_t = (f16*)(wsw + WO_INF); signed char* Wguq = (signed char*)(wsw + WO_GU);
    float* sw_in = (float*)(P.ws + WS_SCL) + 16384; float* sw_gu = (float*)(P.ws + WS_SCL) + 32768; f16* Wdown_t = (f16*)(wsw + WO_DOWN); f16* Wout_t = (f16*)(wsw + WO_OUT); f16* Waup_t = (f16*)(wsw + WO_AUP); f16* Wbup_t = (f16*)(wsw + WO_BUP);
    const float* w_in = P.w_in + (size_t)l * D * N_IN_SRC; const float* w_uk = P.w_uk + (size_t)l * 8 * 128 * 256; const float* w_uv = P.w_uv + (size_t)l * 8 * 256 * 128;
    const float* w_a_up = P.w_a_up + (size_t)l * 1024 * D; const float* w_b_up = P.w_b_up + (size_t)l * 512 * D; const float* w_out = P.w_out + (size_t)l * D * D;
    const float* w_g = P.w_ff_gate + (size_t)l * D * DFF; const float* w_u = P.w_ff_up + (size_t)l * D * DFF; const float* w_d = P.w_ff_down + (size_t)l * DFF * D;
    if ((SEC & 1) && l == 0 && bx < 192) {
        LAS float* sc = (LAS float*)lds; LAS float* red = (LAS float*)(lds + 32768);
        for (int i = tid; i < NB * D; i += 512) { const float v = P.c[i]; sc[i] = v / (1.0f + __expf(-v)); }
        __syncthreads();
        float* mod = (float*)(P.ws + WS_MOD);
        for (int it = bx; it < 192; it += G) {
            const int ll = it / 96, col0 = (it % 96) * 128, c4 = lane & 31, kh = lane >> 5;
            const float* wsrc = P.w_ada + (size_t)ll * D * 12288 + col0 + 4 * c4;
            f32x4 a[4];
#pragma unroll
            for (int b = 0; b < 4; ++b) a[b] = (f32x4){0.f, 0.f, 0.f, 0.f};
#pragma unroll 8
            for (int kk = 0; kk < 128; ++kk) { const int k = wave * 256 + 2 * kk + kh; const f32x4 wv = *(const f32x4*)(wsrc + (size_t)k * 12288);
#pragma unroll
                for (int b = 0; b < 4; ++b) a[b] += wv * sc[b * D + k]; }
#pragma unroll
            for (int b = 0; b < 4; ++b) {
#pragma unroll
                for (int e = 0; e < 4; ++e) a[b][e] += __shfl_xor(a[b][e], 32);
                if (kh == 0) *(LAS f32x4*)(red + (wave * 4 + b) * 128 + 4 * c4) = a[b]; }
            __syncthreads();
            { const int b = tid >> 7, col = tid & 127; float s2 = 0.f;
#pragma unroll
              for (int w = 0; w < 8; ++w) s2 += red[(w * 4 + b) * 128 + col];
              mod[(size_t)(ll * 4 + b) * 12288 + col0 + col] = s2 + P.b_ada[(size_t)ll * 12288 + col0 + col]; }
            __syncthreads();
        }
    }
    if (SEC & 2)
    for (int it = bx; it < 1024; it += G) {
        const int h = it >> 7, rem = it & 127, n0 = (rem >> 2) * 64, c0 = (rem & 3) * 64;
        minigemm_tile(w_a_up + (size_t)(h * 128) * D + n0, D, w_uv + (size_t)(h * 256 + c0) * 128, 128, Waup_t + (size_t)n0 * D + h * 256 + c0, D, 1.0f, lds, tid);
    }
    constexpr int Q_QA = 32, Q_CKV = 8, Q_QKV = 144, Q_GATES = 128, Q_FF = 176, NQITEMS = Q_QA + Q_CKV + Q_QKV + Q_GATES + 2 * Q_FF;
    if (SEC & 4)
    for (int it = bx; it < NQITEMS; it += G) {
        int r = it; const float* Wsrc = w_in; int ldw = N_IN_SRC, n0, r0; signed char* dq = Winq; float* sq = sw_in;
        if (r < Q_QA) { n0 = 32 * r; r0 = 32 * r; }
        else if ((r -= Q_QA) < Q_CKV) { n0 = 1024 + 32 * r; r0 = 1024 + 32 * r; }
        else if ((r -= Q_CKV) < Q_QKV) { n0 = 2384 + 32 * r; r0 = 1280 + 32 * r; }
        else if ((r -= Q_QKV) < Q_GATES) { n0 = 6992 + 32 * r; r0 = 5888 + 32 * r; }
        else { r -= Q_GATES; const int up = r >= Q_FF; if (up) r -= Q_FF; Wsrc = up ? w_u : w_g; ldw = DFF; n0 = 32 * r; r0 = 256 * (n0 >> 7) + 128 * up + (n0 & 127); dq = Wguq; sq = sw_gu; }
        quant_item(Wsrc, ldw, n0, dq, r0, sq, lds, tid);
    }
    LAS float* scr = (LAS float*)(lds + wave * 16384);
    const int gw = bx * NWAVES + wave, NGW = G * NWAVES;
    constexpr int I_IDX = 32 * 35, I_B = 8 * 64, I_O = 32 * 64, I_D = 88 * 64;
    constexpr int NITEMS = I_IDX + I_B + I_O + I_D;
    if (SEC & 8)
    for (int it = gw; it < NITEMS; it += NGW) {
        int r = it;
        if (r < I_IDX) { const int kb = r / 35, nb = r % 35, n0 = 1280 + 32 * nb; const int nv = (2384 - n0) < 32 ? (2384 - n0) : 32; transpose_item<0>(w_in, N_IN_SRC, 64 * kb, n0, nv, Winf_t, D, scr, lane); continue; } r -= I_IDX;
        if (r < I_B) { transpose_item<1>(w_b_up, D, 64 * (r / 64), 32 * (r % 64), 32, Wbup_t, 512, scr, lane); continue; } r -= I_B;
        if (r < I_O) { transpose_item<1>(w_out, D, 64 * (r / 64), 32 * (r % 64), 32, Wout_t, D, scr, lane); continue; } r -= I_O;
        transpose_item<1>(w_d, D, 64 * (r / 64), 32 * (r % 64), 32, Wdown_t, DFF, scr, lane);
    }
    if (!(SEC & 16)) return;
    const int gt = bx * 512 + tid, NGT = G * 512;
    { u32x4* pz = (u32x4*)(Winf_t + (size_t)1104 * D); for (int i = gt; i < 176 * D / 8; i += NGT) pz[i] = (u32x4){0u, 0u, 0u, 0u}; }
    { f16* wukT = (f16*)(wsw + WO_WUK);
      for (int i = gt; i < 8 * 256 * 16; i += NGT) { const int c = i & 255, d8 = (i >> 8) & 15, h = i >> 12; const float* src = w_uk + (size_t)(h * 128 + 8 * d8) * 256 + c; float v[8];
#pragma unroll
          for (int j = 0; j < 8; ++j) v[j] = src[j * 256] * 0.08838834764831845f;
          *(u32x4*)(wukT + (size_t)(h * 256 + c) * 128 + 8 * d8) = pkh8((f32x4){v[0], v[1], v[2], v[3]}, (f32x4){v[4], v[5], v[6], v[7]}); } }
    if (l == 0) {
        f32x2* rope = (f32x2*)(P.ws + WS_ROPE);
        for (int e = gt; e < SEQ * 16; e += NGT) {
            const int pos = e >> 4, j = e & 15, a = j >> 2, b = j & 3;
            const double fa = a == 0 ? 1.0 : a == 1 ? 0.1 : a == 2 ? 0.01 : 0.001;
            const double fb = b == 0 ? 1.0 : b == 1 ? 0.5623413251903491 : b == 2 ? 0.31622776601683794 : 0.1778279410038923;
            const double ang = (double)pos * (fa * fb);
            const double q = __builtin_rint(ang * 0.15915494309189535);
            const double rr = __builtin_fma(-q, 2.4492935982947064e-16, __builtin_fma(-q, 6.283185307179586, ang));
            const float rf = (float)rr;
            rope[e] = (f32x2){cosf(rf), sinf(rf)};
        }
        unsigned char* lut = P.ws + WS_LUT;
        for (int n = gt; n < SEQ; n += NGT) lut[n] = (unsigned char)rel_bucket_of(n);
    }
}

template <bool F16OUT> __device__ __forceinline__ void norm_mod_phase(const float* x, const float* g, const float* shift, const float* scale, f16* out, signed char* out8, float* rs, int lane, int wave, int G, int bx) {
    const int gw = bx * NWAVES + wave, NGW = G * NWAVES;
    for (int blk = gw; blk < M / 8; blk += NGW) {
        const int row0 = blk * 8, b = row0 >> 12;
        f32x4 ca[8], cs[8];
#pragma unroll
        for (int j = 0; j < 8; ++j) { const int col = 4 * lane + 256 * j; const f32x4 gg = *(const f32x4*)(g + col), sc = *(const f32x4*)(scale + (size_t)b * 12288 + col); ca[j] = gg * (sc + 1.0f); cs[j] = *(const f32x4*)(shift + (size_t)b * 12288 + col); }
        for (int r = 0; r < 8; ++r) {
            const float* xr = x + (size_t)(row0 + r) * D + 4 * lane; f32x4 v[8]; float ss = 0.f;
#pragma unroll
            for (int j = 0; j < 8; ++j) { v[j] = *(const f32x4*)(xr + 256 * j); ss += (v[j].x * v[j].x + v[j].y * v[j].y) + (v[j].z * v[j].z + v[j].w * v[j].w); }
            const float rstd = 1.0f / sqrtf(wave_sum(ss) * (1.0f / D) + NORM_EPS);
            f16* orow = out + (size_t)(row0 + r) * D + 4 * lane; float mx = 0.f;
#pragma unroll
            for (int j = 0; j < 8; ++j) { const f32x4 o = v[j] * rstd * ca[j] + cs[j]; v[j] = o; mx = fmaxf(fmaxf(mx, fmaxf(__builtin_fabsf(o.x), __builtin_fabsf(o.y))), fmaxf(__builtin_fabsf(o.z), __builtin_fabsf(o.w)));
                if (F16OUT) { u32x2 w; w.x = pkh(o.x, o.y); w.y = pkh(o.z, o.w); *(u32x2*)(orow + 256 * j) = w; } }
#pragma unroll
            for (int o = 1; o < 64; o <<= 1) mx = fmaxf(mx, __shfl_xor(mx, o));
            const float inv = mx > 0.f ? 127.0f / mx : 0.f;
            if (lane == 0) rs[row0 + r] = mx > 0.f ? mx * (1.0f / 127.0f) : 1.0f;
            signed char* qrow = out8 + (size_t)(row0 + r) * D + 4 * lane;
#pragma unroll
            for (int j = 0; j < 8; ++j) *(unsigned*)(qrow + 256 * j) = pkq4(v[j].x * inv, v[j].y * inv, v[j].z * inv, v[j].w * inv);
        }
    }
}
__device__ __forceinline__ void final_norm_phase(float* xo, const float* g, int lane, int wave, int G, int bx) {
    const int gw = bx * NWAVES + wave, NGW = G * NWAVES;
    f32x4 cg[8];
#pragma unroll
    for (int j = 0; j < 8; ++j) cg[j] = *(const f32x4*)(g + 4 * lane + 256 * j);
    for (int row = gw; row < M; row += NGW) {
        float* xr = xo + (size_t)row * D + 4 * lane; f32x4 v[8]; float ss = 0.f;
#pragma unroll
        for (int j = 0; j < 8; ++j) { v[j] = *(const f32x4*)(xr + 256 * j); ss += (v[j].x * v[j].x + v[j].y * v[j].y) + (v[j].z * v[j].z + v[j].w * v[j].w); }
        const float rstd = 1.0f / sqrtf(wave_sum(ss) * (1.0f / D) + NORM_EPS);
#pragma unroll
        for (int j = 0; j < 8; ++j) *(f32x4*)(xr + 256 * j) = v[j] * rstd * cg[j];
    }
}

__device__ __forceinline__ void wrowq_phase(const f16* W, signed char* Wq, float* sw, int lane, int wave, int G, int bx) {
    const int gw = bx * NWAVES + wave, NGW = G * NWAVES;
    for (int row = gw; row < 2048; row += NGW) {
        const f16* wr = W + (size_t)row * 2048 + 8 * lane; float v[32]; float mx = 0.f;
#pragma unroll
        for (int j = 0; j < 4; ++j) { const u32x4 w = *(const u32x4*)(wr + 512 * j); const unsigned ww[4] = {w.x, w.y, w.z, w.w};
#pragma unroll
            for (int i = 0; i < 4; ++i) { const f32x2 p = unpk(ww[i]); v[8 * j + 2 * i] = p.x; v[8 * j + 2 * i + 1] = p.y; mx = fmaxf(mx, fmaxf(__builtin_fabsf(p.x), __builtin_fabsf(p.y))); } }
#pragma unroll
        for (int o = 1; o < 64; o <<= 1) mx = fmaxf(mx, __shfl_xor(mx, o));
        const float inv = mx > 0.f ? 127.0f / mx : 0.f;
        if (lane == 0) sw[row] = mx > 0.f ? mx * (1.0f / 127.0f) : 1.0f;
#pragma unroll
        for (int j = 0; j < 4; ++j) { u32x2 o; o.x = pkq4(v[8 * j] * inv, v[8 * j + 1] * inv, v[8 * j + 2] * inv, v[8 * j + 3] * inv); o.y = pkq4(v[8 * j + 4] * inv, v[8 * j + 5] * inv, v[8 * j + 6] * inv, v[8 * j + 7] * inv);
            *(u32x2*)(Wq + (size_t)row * 2048 + 8 * lane + 512 * j) = o; }
    }
}

__device__ __forceinline__ void qlat_phase(const f16* qa, const f16* wukT, f16* qlat, int lane, int wave, int G, int bx) {
    const int gw = bx * NWAVES + wave, NGW = G * NWAVES, l15 = lane & 15, g4 = lane >> 4;
    for (int it = gw; it < (M / 64) * 8; it += NGW) {
        const int h = it & 7, t0 = (it >> 3) * 64;
        f16x8 bq[4][4];
#pragma unroll
        for (int tt = 0; tt < 4; ++tt)
#pragma unroll
            for (int k = 0; k < 4; ++k) bq[tt][k] = *(const f16x8*)(qa + (size_t)(t0 + 16 * tt + l15) * 1024 + h * 128 + 32 * k + 8 * g4);
        const f16* wp = wukT + (size_t)(h * 256 + l15) * 128 + 8 * g4;
        f16* op = qlat + (size_t)(t0 + l15) * 2048 + h * 256 + 4 * g4;
#pragma unroll 4
        for (int ct = 0; ct < 16; ++ct) {
            f16x8 aw[4];
#pragma unroll
            for (int k = 0; k < 4; ++k) aw[k] = *(const f16x8*)(wp + (size_t)(16 * ct) * 128 + 32 * k);
#pragma unroll
            for (int tt = 0; tt < 4; ++tt) { f32x4 acc = {0.f, 0.f, 0.f, 0.f};
#pragma unroll
                for (int k = 0; k < 4; ++k) acc = __builtin_amdgcn_mfma_f32_16x16x32_f16(aw[k], bq[tt][k], acc, 0, 0, 0);
                u32x2 w; w.x = pkh(acc[0], acc[1]); w.y = pkh(acc[2], acc[3]); *(u32x2*)(op + (size_t)(16 * tt) * 2048 + 16 * ct) = w; }
        }
    }
}

__device__ __forceinline__ void zfix_phase(f16* ckv, f16* qi, f16* kw, const float* kvg, const float* lng, const float* lnb, const f32x2* rope, int lane, int wave, int G, int bx) {
    const int gw = bx * NWAVES + wave, NGW = G * NWAVES;
    const f32x4 g4 = *(const f32x4*)(kvg + 4 * lane); const float lg = lng[lane], lb = lnb[lane];
    for (int blk = gw; blk < M / 8; blk += NGW)
        for (int r = 0; r < 8; ++r) {
            const int row = blk * 8 + r, pos = row & (SEQ - 1);
            { f16* z = ckv + (size_t)row * 256 + 4 * lane; const u32x2 w = *(const u32x2*)z; const f32x2 a = unpk(w.x), b = unpk(w.y);
              const float ss = wave_sum((a.x * a.x + a.y * a.y) + (b.x * b.x + b.y * b.y)); const float rstd = 1.0f / sqrtf(ss * (1.0f / 256.0f) + NORM_EPS);
              u32x2 o; o.x = pkh(a.x * rstd * g4.x, a.y * rstd * g4.y); o.y = pkh(b.x * rstd * g4.z, b.y * rstd * g4.w); *(u32x2*)z = o; }
            { f16* z = qi + (size_t)row * 1024 + 16 * lane; const u32x4 w0 = *(const u32x4*)z, w1 = *(const u32x4*)(z + 8);
              const unsigned mine[8] = {w0.x, w0.y, w0.z, w0.w, w1.x, w1.y, w1.z, w1.w}; unsigned res[8]; const int seg = lane & 3;
#pragma unroll
              for (int i = 0; i < 8; ++i) { const unsigned oth = (unsigned)__shfl_xor((int)mine[i], 1); const f32x2 me = unpk(mine[i]), ot = unpk(oth);
                  const f32x2 cs0 = rope[pos * 16 + 2 * i], cs1 = rope[pos * 16 + 2 * i + 1];
                  float r0, r1;
                  if (seg == 0) { r0 = me.x * cs0.x - ot.x * cs0.y; r1 = me.y * cs1.x - ot.y * cs1.y; }
                  else          { r0 = ot.x * cs0.y + me.x * cs0.x; r1 = ot.y * cs1.y + me.y * cs1.x; }
                  res[i] = seg < 2 ? pkh(r0, r1) : mine[i]; }
              *(u32x4*)z = (u32x4){res[0], res[1], res[2], res[3]}; *(u32x4*)(z + 8) = (u32x4){res[4], res[5], res[6], res[7]}; }
            { f16* z = kw + (size_t)row * 256 + lane; const float xv = (float)z[0]; const float mu = wave_sum(xv) * (1.0f / 64.0f); const float dv = xv - mu; const float var = wave_sum(dv * dv) * (1.0f / 64.0f);
              const float y = dv * (1.0f / sqrtf(var + NORM_EPS)) * lg + lb; const float oth = __shfl_xor(y, 16); const f32x2 cs = rope[pos * 16 + (lane & 15)];
              float o = y; if (lane < 16) o = y * cs.x - oth * cs.y; else if (lane < 32) o = oth * cs.y + y * cs.x;
              z[0] = (f16)o; }
        }
}

__device__ __forceinline__ void battn_phase(const f16* zB, const float* rel_bias, const unsigned char* lut, f16* ob, float* lse, LAS unsigned char* lds, int tid, int lane, int wave, int G, int bx) {
    LAS unsigned char* Kimg = lds; LAS unsigned char* Vimg = lds + 65536; LAS float* tb = (LAS float*)(lds + SMALL_OFF);
    const int g4 = lane >> 4, q15 = lane & 15;
    for (int uid = bx; uid < NB * 3 * 4 * 32; uid += G) {
        const int s = uid & 31, j = (uid >> 5) & 3, grp = (uid >> 7) % 3, b = uid / 384;
        const int dsh = 2 * grp, r = s & ((1 << dsh) - 1), n = s >> dsh;
        const f16* zb = zB + (size_t)b * SEQ * NZB; const int colQ = (grp * 4 + j) * 128, colK = ((3 + grp) * 4 + j) * 128, colV = ((6 + grp) * 4 + j) * 128;
#pragma unroll
        for (int i = 0; i < 8; ++i) { const int cidx = tid + 512 * i, u = cidx >> 4, ch = cidx & 15, mk = (n - 1) * 128 + u;
            u32x4 kv = {0u, 0u, 0u, 0u}, vv = {0u, 0u, 0u, 0u};
            if (mk >= 0) { const f16* rp = zb + (size_t)((mk << dsh) + r) * NZB + ch * 8; kv = *(const u32x4*)(rp + colK); vv = *(const u32x4*)(rp + colV); }
            *(LAS u32x4*)(Kimg + off_b(u, ch)) = kv; *(LAS u32x4*)(Vimg + off_b(u, ch)) = vv; }
        if (tid <= 128) tb[tid] = rel_bias[(int)lut[tid << dsh] * 20 + 8 + grp * 4 + j];
        __syncthreads();
        const int iq = 16 * wave + q15, tq = ((n * 128 + iq) << dsh) + r;
        const f16* qp = zb + (size_t)tq * NZB + colQ + 8 * g4;
        f16x8 qf[4];
#pragma unroll
        for (int k = 0; k < 4; ++k) qf[k] = *(const f16x8*)(qp + 32 * k);
        const int kstart = 32 * (wave >> 1);
        const int back0 = iq + 128 - (kstart + 8 * g4); const unsigned bmax = n > 0 ? 128u : (unsigned)iq;
        f32x4 sreg[5][2]; float mx = NEG_INF;
#pragma unroll
        for (int T = 0; T < 5; ++T)
#pragma unroll
            for (int hf = 0; hf < 2; ++hf) {
                const int krow = kstart + 32 * T + 8 * (q15 >> 2) + 4 * hf + (q15 & 3);
                f32x4 acc = {0.f, 0.f, 0.f, 0.f};
#pragma unroll
                for (int k = 0; k < 4; ++k) { const f16x8 kf = *(const LAS f16x8*)(Kimg + off_b(krow, 4 * k + g4)); acc = __builtin_amdgcn_mfma_f32_16x16x32_f16(kf, qf[k], acc, 0, 0, 0); }
#pragma unroll
                for (int e = 0; e < 4; ++e) { const unsigned back = (unsigned)(back0 - (32 * T + 4 * hf + e));
                    const bool valid = back <= bmax; const unsigned bi = back < 128u ? back : 128u;
                    const float sv = valid ? acc[e] * 0.08838834764831845f + tb[bi] : NEG_INF; acc[e] = sv; mx = fmaxf(mx, sv); }
                sreg[T][hf] = acc; }
        mx = fmaxf(mx, __shfl_xor(mx, 16)); mx = fmaxf(mx, __shfl_xor(mx, 32));
        float den = 0.f; f16x8 pf[5];
#pragma unroll
        for (int T = 0; T < 5; ++T) { float p[8];
#pragma unroll
            for (int e = 0; e < 8; ++e) { p[e] = __expf(sreg[T][e >> 2][e & 3] - mx); den += p[e]; }
            const u32x4 w = pkh8((f32x4){p[0], p[1], p[2], p[3]}, (f32x4){p[4], p[5], p[6], p[7]}); pf[T] = __builtin_bit_cast(f16x8, w); }
        den += __shfl_xor(den, 16); den += __shfl_xor(den, 32);
        const float rden = 1.0f / den;
        f16* op = ob + ((size_t)grp * M + (size_t)b * SEQ + tq) * 512 + j * 128 + 4 * g4;
        const unsigned trq = (unsigned)(q15 >> 2), trp = (unsigned)(lane & 3);
#pragma unroll
        for (int c = 0; c < 8; ++c) { f32x4 acc = {0.f, 0.f, 0.f, 0.f};
#pragma unroll
            for (int T = 0; T < 5; ++T) {
                const unsigned r0 = (unsigned)(kstart + 32 * T + 8 * g4) + trq;
                const s16x4 t0 = __builtin_amdgcn_ds_read_tr16_b64_v4i16((LAS s16x4*)(Vimg + off_b(r0, 2 * c + (trp >> 1)) + 8 * (trp & 1)));
                const s16x4 t1 = __builtin_amdgcn_ds_read_tr16_b64_v4i16((LAS s16x4*)(Vimg + off_b(r0 + 4, 2 * c + (trp >> 1)) + 8 * (trp & 1)));
                const f16x8 vf = __builtin_bit_cast(f16x8, __builtin_shufflevector(t0, t1, 0, 1, 2, 3, 4, 5, 6, 7));
                acc = __builtin_amdgcn_mfma_f32_16x16x32_f16(vf, pf[T], acc, 0, 0, 0); }
            u32x2 w; w.x = pkh(acc[0] * rden, acc[1] * rden); w.y = pkh(acc[2] * rden, acc[3] * rden); *(u32x2*)(op + 16 * c) = w; }
        if (lane < 16) lse[((size_t)grp * M + (size_t)b * SEQ + tq) * 4 + j] = mx + __logf(den);
        __syncthreads();
    }
}

__device__ __forceinline__ void score_phase(const f16* qi, const f16* kw, float* S, LAS unsigned char* lds, int tid, int lane, int wave, int G, int bx) {
    const int wq = wave & 1, wk = wave >> 1, l31 = lane & 31, lh = lane >> 5;
    LAS f16* wS = (LAS f16*)(lds + SMALL_OFF);
    constexpr int UPB = 544, NU = NB * UPB;
    int staged = -1;
    for (int uid = (int)(((long)bx * NU) / G), uend = (int)(((long)(bx + 1) * NU) / G); uid < uend; ++uid) {
        const int b = uid / UPB; int rem = uid % UPB, i = 0;
        for (;;) { const int cnt = (i + 4) >> 2; if (rem < cnt) break; rem -= cnt; ++i; }
        const int qrow0 = b * SEQ + 64 * i;
        if (staged != b * 64 + i) {
            __syncthreads();
#pragma unroll
            for (int k = 0; k < 16; ++k) { const int id = tid + 512 * k, q = id >> 7, hc = id & 127, head = hc >> 3, c = hc & 7;
                const u32x4 v = *(const u32x4*)(qi + (size_t)(qrow0 + q) * 1024 + head * 64 + 8 * c);
                *(LAS u32x4*)(lds + (head * 64 + q) * 128 + ((c ^ (q & 7)) << 4)) = v; }
            if (tid < 128) *(LAS u32x4*)(wS + (tid >> 1) * 16 + 8 * (tid & 1)) = *(const u32x4*)(kw + (size_t)(qrow0 + (tid >> 1)) * 256 + KW_W + 8 * (tid & 1));
            __syncthreads();
            staged = b * 64 + i;
        }
        const int key0 = 256 * rem + 64 * wk, rl = ((i >> 1) + 1) * 128;
        if (key0 > 64 * i + 63 || key0 >= rl) continue;
        f16x8 kf[2][4];
#pragma unroll
        for (int tl = 0; tl < 2; ++tl) { const int kg = key0 + 32 * tl + l31; const f16* kp = kw + (size_t)(b * SEQ + (kg < SEQ ? kg : SEQ - 1)) * 256 + 8 * lh;
#pragma unroll
            for (int k = 0; k < 4; ++k) kf[tl][k] = *(const f16x8*)(kp + 16 * k); }
        f32x16 sc[2];
#pragma unroll
        for (int tl = 0; tl < 2; ++tl)
#pragma unroll
            for (int e = 0; e < 16; ++e) sc[tl][e] = 0.f;
        const int ql = 32 * wq + l31; const LAS unsigned char* qb_ = lds + ql * 128;
#pragma nounroll
        for (int hp = 0; hp < 8; ++hp) {
            f16x8 qf[2][4]; float wh[2];
#pragma unroll
            for (int j = 0; j < 2; ++j) {
#pragma unroll
                for (int k = 0; k < 4; ++k) qf[j][k] = *(const LAS f16x8*)(qb_ + (2 * hp + j) * 8192 + (((2 * k + lh) ^ (ql & 7)) << 4));
                wh[j] = (float)wS[ql * 16 + 2 * hp + j]; }
            f32x16 a[2][2];
#pragma unroll
            for (int j = 0; j < 2; ++j)
#pragma unroll
                for (int tl = 0; tl < 2; ++tl)
#pragma unroll
                    for (int e = 0; e < 16; ++e) a[j][tl][e] = 0.f;
#pragma unroll
            for (int k = 0; k < 4; ++k)
#pragma unroll
                for (int j = 0; j < 2; ++j)
#pragma unroll
                    for (int tl = 0; tl < 2; ++tl) a[j][tl] = __builtin_amdgcn_mfma_f32_32x32x16_f16(kf[tl][k], qf[j][k], a[j][tl], 0, 0, 0);
#pragma unroll
            for (int j = 0; j < 2; ++j)
#pragma unroll
                for (int tl = 0; tl < 2; ++tl) { typedef int i32x16 __attribute__((ext_vector_type(16)));
                    const i32x16 zi = {0, 0, 0, 0, 0, 0, 0, 0, 0, 0, 0, 0, 0, 0, 0, 0};
                    const f32x16 r = __builtin_bit_cast(f32x16, __builtin_elementwise_max(__builtin_bit_cast(i32x16, a[j][tl]), zi));
                    sc[tl] += r * wh[j]; }
        }
        const int t = 64 * i + ql, qb = t >> 7;
        float* sp = S + (size_t)b * SC_BATCH + (size_t)16384 * (qb * (qb + 1) / 2) + (size_t)(t & 127) * rl + key0 + 4 * lh;
#pragma unroll
        for (int tl = 0; tl < 2; ++tl)
#pragma unroll
            for (int a4 = 0; a4 < 4; ++a4) *(f32x4*)(sp + 32 * tl + 8 * a4) = (f32x4){sc[tl][4 * a4], sc[tl][4 * a4 + 1], sc[tl][4 * a4 + 2], sc[tl][4 * a4 + 3]};
    }
}

__device__ __forceinline__ unsigned ord_key(float x) { const unsigned u = __builtin_bit_cast(unsigned, x); return u ^ ((unsigned)((int)u >> 31) | 0x80000000u); }
__device__ __forceinline__ int wave_total(int v) {
    v += __builtin_amdgcn_update_dpp(0, v, 0x111, 0xf, 0xf, true);
    v += __builtin_amdgcn_update_dpp(0, v, 0x112, 0xf, 0xf, true);
    v += __builtin_amdgcn_update_dpp(0, v, 0x114, 0xf, 0xf, true);
    v += __builtin_amdgcn_update_dpp(0, v, 0x118, 0xf, 0xf, true);
    v += __builtin_amdgcn_update_dpp(0, v, 0x142, 0xa, 0xf, true);
    v += __builtin_amdgcn_update_dpp(0, v, 0x143, 0xc, 0xf, true);
    return __builtin_amdgcn_readlane(v, 63);
}
template <int NCH> __device__ __forceinline__ void select_row(const float* src, int n, u16* orow, int lane) {
    unsigned key[4 * NCH];
#pragma unroll
    for (int j = 0; j < NCH; ++j) { const int base = 256 * j + 4 * lane; const f32x4 v = *(const f32x4*)(src + base);
#pragma unroll
        for (int e = 0; e < 4; ++e) key[4 * j + e] = ord_key(v[e]) & (unsigned)((base + e - n) >> 31); }
    unsigned tau = 0u;
    for (int bit = 31; bit >= 0; --bit) { const unsigned cand = tau | (1u << bit); int cnt = 0;
#pragma unroll
        for (int m = 0; m < 4 * NCH; ++m) cnt += (key[m] >= cand) ? 1 : 0;
        cnt = wave_total(cnt);
        if (cnt >= 256) { tau = cand; if (cnt == 256) break; } }
    int cgt = 0;
#pragma unroll
    for (int m = 0; m < 4 * NCH; ++m) cgt += (key[m] > tau) ? 1 : 0;
    cgt = wave_total(cgt);
    const int need = 256 - cgt; int og = 0, oe = 0;
    asm volatile("" : "+v"(tau));
#pragma unroll
    for (int m = 0; m < 4 * NCH; ++m) {
        const unsigned kidx = (unsigned)(256 * (m >> 2) + 4 * lane + (m & 3));
        const bool isg = key[m] > tau, ise = key[m] == tau;
        const unsigned long long bg = __ballot(isg), be = __ballot(ise);
        const unsigned lo_g = __builtin_amdgcn_mbcnt_hi((unsigned)(bg >> 32), __builtin_amdgcn_mbcnt_lo((unsigned)bg, 0u));
        const unsigned lo_e = __builtin_amdgcn_mbcnt_hi((unsigned)(be >> 32), __builtin_amdgcn_mbcnt_lo((unsigned)be, 0u));
        if (isg) orow[og + (int)lo_g] = (u16)kidx;
        else if (ise && (oe + (int)lo_e) < need) orow[cgt + oe + (int)lo_e] = (u16)kidx;
        og += __popcll(bg); oe += __popcll(be);
        __builtin_amdgcn_sched_barrier(0);
    }
}
__device__ __forceinline__ void select_one(const float* S, u16* idx, int row, int lane) {
    const int b = row >> 12, t = row & (SEQ - 1), qb = t >> 7, n = t + 1;
    u16* orow = idx + (size_t)row * 256;
    if (n <= 256) { u32x2 w; const int k = 4 * lane;
        w.x = (unsigned)(k < n ? k : 0xFFFF) | ((unsigned)(k + 1 < n ? k + 1 : 0xFFFF) << 16); w.y = (unsigned)(k + 2 < n ? k + 2 : 0xFFFF) | ((unsigned)(k + 3 < n ? k + 3 : 0xFFFF) << 16);
        *(u32x2*)(orow + k) = w; return; }
    const float* src = S + (size_t)b * SC_BATCH + (size_t)16384 * (qb * (qb + 1) / 2) + (size_t)(t & 127) * ((qb + 1) * 128);
    const int nch = (n + 255) >> 8;
    if (nch <= 2) select_row<2>(src, n, orow, lane); else if (nch <= 4) select_row<4>(src, n, orow, lane); else if (nch <= 6) select_row<6>(src, n, orow, lane);
    else if (nch <= 8) select_row<8>(src, n, orow, lane); else if (nch <= 10) select_row<10>(src, n, orow, lane); else if (nch <= 12) select_row<12>(src, n, orow, lane);
    else if (nch <= 14) select_row<14>(src, n, orow, lane); else select_row<16>(src, n, orow, lane);
}
__device__ __forceinline__ void bmerge_phase(const f16* ob, const float* lse, f16* yb, int lane, int wave, int G, int bx) {
    const int gw = bx * NWAVES + wave, NGW = G * NWAVES; const int js = lane >> 4, e0 = (lane & 15) * 8;
    for (int row = gw; row < M; row += NGW) {
        const float l0 = lse[((size_t)0 * M + row) * 4 + js], l1 = lse[((size_t)1 * M + row) * 4 + js], l2 = lse[((size_t)2 * M + row) * 4 + js];
        const float mx = fmaxf(l0, fmaxf(l1, l2)); float w0 = __expf(l0 - mx), w1 = __expf(l1 - mx), w2 = __expf(l2 - mx); const float inv = 1.0f / (w0 + w1 + w2); w0 *= inv; w1 *= inv; w2 *= inv;
        const size_t o = (size_t)row * 512 + js * 128 + e0;
        const u32x4 a = *(const u32x4*)(ob + o), bq = *(const u32x4*)(ob + (size_t)M * 512 + o), cq = *(const u32x4*)(ob + (size_t)2 * M * 512 + o);
        const unsigned aw[4] = {a.x, a.y, a.z, a.w}, bw[4] = {bq.x, bq.y, bq.z, bq.w}, cw[4] = {cq.x, cq.y, cq.z, cq.w}; unsigned rw[4];
#pragma unroll
        for (int i = 0; i < 4; ++i) { const f32x2 x0 = unpk(aw[i]), x1 = unpk(bw[i]), x2 = unpk(cw[i]); rw[i] = pkh(w0 * x0.x + w1 * x1.x + w2 * x2.x, w0 * x0.y + w1 * x1.y + w2 * x2.y); }
        *(u32x4*)(yb + o) = (u32x4){rw[0], rw[1], rw[2], rw[3]};
    }
}

template <int MODE  > __device__ __forceinline__ void dsa_phase(const float* Ssc, const f16* qlat, const f16* ckv, u16* idx, const float* rel_bias, const unsigned char* lut, signed char* olat, float* ors, LAS unsigned char* lds, int tid, int lane, int wave, int G, int bx) {
    LAS unsigned char* lutS = lds + SMALL_OFF; LAS float* biasS = (LAS float*)(lds + SMALL_OFF + 4096);
    for (int i = tid; i < SEQ / 4; i += 512) ((LAS unsigned*)lutS)[i] = ((const unsigned*)lut)[i];
    if (tid < 256) biasS[tid] = rel_bias[(tid >> 3) * 20 + (tid & 7)];
    __syncthreads();
    LAS unsigned char* kv = lds + wave * 16384;
    const int g4 = lane >> 4, head = lane & 15, hq = head & 7, l31 = lane & 31, lh = lane >> 5;
    const unsigned trq = (unsigned)(head >> 2), trp = (unsigned)(lane & 3);
    int tok0, tstride, ntok; const bool paired = G == 256;
    if (paired) { const int bsel = (bx & 7) >> 1, wib = (((bx & 7) & 1) + 2 * (bx >> 3)) * NWAVES + wave; tok0 = bsel * SEQ + wib; tstride = 512; ntok = 8; }
    else { tok0 = bx * NWAVES + wave; tstride = G * NWAVES; ntok = tok0 < M ? (M - tok0 + tstride - 1) / tstride : 0; }
#define DSA_TOK(it) (paired ? (((it) & 1) ? (tok0 & ~(SEQ - 1)) + SEQ - 1 - ((tok0 & (SEQ - 1)) + ((it) >> 1) * 512) : tok0 + ((it) >> 1) * 512) : tok0 + (it) * tstride)
    if (MODE == 0) {
        for (int it = 0; it < ntok; ++it) select_one(Ssc, idx, DSA_TOK(it), lane);
        __builtin_amdgcn_fence(__ATOMIC_SEQ_CST, "workgroup"); asm volatile("s_waitcnt vmcnt(0)" ::: "memory");
    }
    const int nsteps = ntok * 8;
    if (nsteps == 0) return;
    u32x4 GR[16]; f32x4 oacc[16]; f16x8 qf[8];
    float mrun = NEG_INF, lrun = 0.f, bvc[8];
    u16x8 my8n; int idxn;
#define DSA_ROW(st) DSA_TOK((st) >> 3)
#define DSA_IDX(st, m8, ix) do { const int st_ = (st) < nsteps ? (st) : nsteps - 1; const u16* ir_ = idx + (size_t)DSA_ROW(st_) * 256 + 32 * (st_ & 7); \
        m8 = *(const u16x8*)(ir_ + 8 * g4); ix = (int)ir_[l31]; } while (0)
#define DSA_GATHER(st, ix) do { const int st_ = (st) < nsteps ? (st) : nsteps - 1; const f16* zb_ = ckv + (size_t)(DSA_ROW(st_) >> 12) * SEQ * 256 + 8 * l31; \
        _Pragma("unroll") for (int p_ = 0; p_ < 16; ++p_) { const int ia_ = __builtin_amdgcn_readlane((ix), 2 * p_), ib_ = __builtin_amdgcn_readlane((ix), 2 * p_ + 1); int ir_ = lh ? ib_ : ia_; ir_ = ir_ == 0xFFFF ? 0 : ir_; GR[p_] = *(const u32x4*)(zb_ + (size_t)ir_ * 256); } } while (0)
#define DSA_BIAS(st, m8, bv) do { const int st_ = (st) < nsteps ? (st) : nsteps - 1; const int t_ = DSA_ROW(st_) & (SEQ - 1); int bk_[8]; \
        _Pragma("unroll") for (int e_ = 0; e_ < 8; ++e_) { const int k_ = (int)m8[e_]; const int d_ = k_ == 0xFFFF ? 0 : t_ - k_; bk_[e_] = (int)lutS[d_]; } \
        _Pragma("unroll") for (int e_ = 0; e_ < 8; ++e_) { const float b_ = biasS[bk_[e_] * 8 + hq]; bv[e_] = (int)m8[e_] == 0xFFFF ? NEG_INF : b_; } } while (0)
    { u16x8 m0; int ix0; DSA_IDX(0, m0, ix0); if (MODE != 1) DSA_GATHER(0, ix0); DSA_BIAS(0, m0, bvc); DSA_IDX(1, my8n, idxn); }
    for (int st = 0; st < nsteps; ++st) {
        const int row = DSA_ROW(st), ch = st & 7;
        if (ch == 0) {
            const f16* zq = qlat + (size_t)row * 2048;
#pragma unroll
            for (int s = 0; s < 8; ++s) { const u32x4 w = *(const u32x4*)(zq + hq * 256 + 32 * s + 8 * g4); qf[s] = head < 8 ? __builtin_bit_cast(f16x8, w) : (f16x8){0, 0, 0, 0, 0, 0, 0, 0}; }
#pragma unroll
            for (int c = 0; c < 16; ++c) oacc[c] = (f32x4){0.f, 0.f, 0.f, 0.f};
            mrun = NEG_INF; lrun = 0.f;
        }
        if (MODE != 1) {
#pragma unroll
            for (int p = 0; p < 16; ++p) *(LAS u32x4*)(kv + (l31 >> 4) * 8192 + off_b((unsigned)(2 * p + lh), (unsigned)(lane & 15))) = GR[p];
            DSA_GATHER(st + 1, idxn);
        }
        u16x8 my8nn; int idxnn; DSA_IDX(st + 2, my8nn, idxnn);
        float bvn[8]; DSA_BIAS(st + 1, my8n, bvn);
        if (MODE != 2) {
        f32x4 stl[2];
#pragma unroll
        for (int hf = 0; hf < 2; ++hf) { const unsigned krow = 8u * (unsigned)(head >> 2) + 4u * hf + (unsigned)(head & 3); f32x4 acc = {0.f, 0.f, 0.f, 0.f};
#pragma unroll
            for (int s = 0; s < 8; ++s) { const f16x8 kf = *(const LAS f16x8*)(kv + (s >> 2) * 8192 + off_b(krow, 4u * (s & 3) + (unsigned)g4)); acc = __builtin_amdgcn_mfma_f32_16x16x32_f16(kf, qf[s], acc, 0, 0, 0); }
            stl[hf] = acc; }
        float sv[8], cmax = NEG_INF;
#pragma unroll
        for (int e = 0; e < 8; ++e) { sv[e] = stl[e >> 2][e & 3] + bvc[e]; cmax = fmaxf(cmax, sv[e]); }
        if (__any(cmax > mrun + 6.0f)) {
            cmax = fmaxf(cmax, __shfl_xor(cmax, 16)); cmax = fmaxf(cmax, __shfl_xor(cmax, 32));
            const float mnew = fmaxf(mrun, cmax), alpha = __expf(mrun - mnew);
            lrun *= alpha; mrun = mnew;
            if (ch != 0) {
#pragma unroll
                for (int c = 0; c < 16; ++c) oacc[c] = oacc[c] * alpha; }
        }
        float p[8], ps = 0.f;
#pragma unroll
        for (int e = 0; e < 8; ++e) { p[e] = __expf(sv[e] - mrun); ps += p[e]; }
        lrun += ps;
        const f16x8 pf = __builtin_bit_cast(f16x8, pkh8((f32x4){p[0], p[1], p[2], p[3]}, (f32x4){p[4], p[5], p[6], p[7]}));
#pragma unroll
        for (int ct = 0; ct < 16; ++ct) {
            const unsigned r0 = 8u * (unsigned)g4 + trq, cch = 2u * (ct & 7) + (trp >> 1);
            LAS unsigned char* img = kv + (ct >> 3) * 8192;
            const s16x4 t0 = __builtin_amdgcn_ds_read_tr16_b64_v4i16((LAS s16x4*)(img + off_b(r0, cch) + 8 * (trp & 1)));
            const s16x4 t1 = __builtin_amdgcn_ds_read_tr16_b64_v4i16((LAS s16x4*)(img + off_b(r0 + 4, cch) + 8 * (trp & 1)));
            const f16x8 vf = __builtin_bit_cast(f16x8, __builtin_shufflevector(t0, t1, 0, 1, 2, 3, 4, 5, 6, 7));
            oacc[ct] = __builtin_amdgcn_mfma_f32_16x16x32_f16(vf, pf, oacc[ct], 0, 0, 0); }
        if (ch == 7) {
            lrun += __shfl_xor(lrun, 16); lrun += __shfl_xor(lrun, 32);
            const float rl = 1.0f / lrun; float mx = 0.f;
#pragma unroll
            for (int ct = 0; ct < 16; ++ct) { oacc[ct] = oacc[ct] * rl; mx = fmaxf(fmaxf(mx, fmaxf(__builtin_fabsf(oacc[ct][0]), __builtin_fabsf(oacc[ct][1]))), fmaxf(__builtin_fabsf(oacc[ct][2]), __builtin_fabsf(oacc[ct][3]))); }
            if (head >= 8) mx = 0.f;
#pragma unroll
            for (int o = 1; o < 64; o <<= 1) mx = fmaxf(mx, __shfl_xor(mx, o));
            const float inv = mx > 0.f ? 127.0f / mx : 0.f;
            if (lane == 0) ors[row] = mx > 0.f ? mx * (1.0f / 127.0f) : 1.0f;
            if (head < 8) { signed char* op = olat + (size_t)row * 2048 + head * 256 + 4 * g4;
#pragma unroll
                for (int ct = 0; ct < 16; ++ct) *(unsigned*)(op + 16 * ct) = pkq4(oacc[ct][0] * inv, oacc[ct][1] * inv, oacc[ct][2] * inv, oacc[ct][3] * inv); }
        }
        }
        my8n = my8nn; idxn = idxnn;
#pragma unroll
        for (int e = 0; e < 8; ++e) bvc[e] = bvn[e];
    }
#undef DSA_ROW
#undef DSA_IDX
#undef DSA_GATHER
#undef DSA_BIAS
#undef DSA_TOK
}
#define XB_TMO      128
#define XB_XCNT(j)  (256  + 64 * (j))
#define XB_XSUB(j)  (1280 + 64 * (j))
#define XB_XGEN(j)  (2304 + 64 * (j))
#define XB_TOP      3328
#define XB_TOPGEN   3392
#define XCD_BAR_WORDS 3456
#define XB_SPIN_CAP (1u << 18)

__device__ __forceinline__ unsigned xb_ld(unsigned* p)              { return __hip_atomic_load(p, __ATOMIC_RELAXED, __HIP_MEMORY_SCOPE_AGENT); }
__device__ __forceinline__ unsigned xb_add(unsigned* p, unsigned v) { return __hip_atomic_fetch_add(p, v, __ATOMIC_RELAXED, __HIP_MEMORY_SCOPE_AGENT); }
__device__ __forceinline__ unsigned xb_xcc_id() { return (unsigned)__builtin_amdgcn_s_getreg((3 << 11) | 20) & 0xFu; }
#define XB_SPIN(cond, bar) do { unsigned _sp = 0; while (cond) { __builtin_amdgcn_s_sleep(1); \
    if ((++_sp & 255u) == 0u) { if (xb_ld(&(bar)[XB_TMO])) break; if (_sp > XB_SPIN_CAP) { atomicAdd(&(bar)[XB_TMO], 1u); break; } } } } while (0)

struct XcdBarrier {
    unsigned* bar; unsigned x;
    volatile LAS unsigned* st;
};

__device__ __forceinline__ XcdBarrier xcd_barrier_post(unsigned* bar, volatile LAS unsigned* st) {
    XcdBarrier b; b.bar = bar; b.x = xb_xcc_id(); b.st = st;
    if (threadIdx.x == 0) (void)xb_add(&bar[XB_XCNT(b.x)], 1u);
    return b;
}
__device__ __forceinline__ void xcd_barrier_complete(unsigned* bar, unsigned x, unsigned& nloc, unsigned& nx) {
    const unsigned G = gridDim.x * gridDim.y * gridDim.z;
    unsigned sum, cnt, mine, sp = 0u;
    for (;;) {
        sum = 0u; cnt = 0u; mine = 0u;
#pragma unroll
        for (unsigned j = 0; j < 16; ++j) { const unsigned c = xb_ld(&bar[XB_XCNT(j)]); sum += c; cnt += (c > 0u) ? 1u : 0u; mine = (j == x) ? c : mine; }
        if (sum == G) break;
        __builtin_amdgcn_s_sleep(1);
        if ((++sp & 255u) == 0u) { if (xb_ld(&bar[XB_TMO])) break; if (sp > XB_SPIN_CAP) { atomicAdd(&bar[XB_TMO], 1u); break; } }
    }
    nloc = mine > 0u ? mine : 1u; nx = cnt > 0u ? cnt : 1u;
}

__device__ __forceinline__ void xcd_barrier(const XcdBarrier& b) {
    asm volatile("s_waitcnt vmcnt(0)" ::: "memory");
    __syncthreads();
    if (threadIdx.x == 0) {
        unsigned* bar = b.bar;
        __builtin_amdgcn_s_waitcnt(0);
        unsigned nloc = b.st[0], nx = b.st[1];
        if (nloc == 0u) { xcd_barrier_complete(bar, b.x, nloc, nx); b.st[0] = nloc; b.st[1] = nx; }
        const unsigned old = xb_add(&bar[XB_XSUB(b.x)], 1u);
        const unsigned gen = old / nloc;
        if (old + 1u == (gen + 1u) * nloc) {
            __builtin_amdgcn_fence(__ATOMIC_RELEASE, "agent");
            asm volatile("s_waitcnt vmcnt(0)" ::: "memory");
            const unsigned og = xb_add(&bar[XB_TOP], 1u);
            const unsigned tg = og / nx;
            if (og + 1u == (tg + 1u) * nx) xb_add(&bar[XB_TOPGEN], 1u);
            else XB_SPIN(xb_ld(&bar[XB_TOPGEN]) == tg, bar);
            __builtin_amdgcn_fence(__ATOMIC_ACQUIRE, "agent");
            xb_add(&bar[XB_XGEN(b.x)], 1u);
            asm volatile("s_waitcnt vmcnt(0)" ::: "memory");
        } else {
            XB_SPIN(xb_ld(&bar[XB_XGEN(b.x)]) == gen, bar);
            __builtin_amdgcn_fence(__ATOMIC_ACQUIRE, "agent");
            asm volatile("s_waitcnt vmcnt(0)" ::: "memory");
        }
    }
    __syncthreads();
}

#ifndef MK_PER_PHASE
#define MK_PER_PHASE 0
#endif
constexpr int N_PHASES = 12 * DEPTH + 1;
struct Args { const float* in[20]; float* out; unsigned char* ws; int ph_lo, ph_hi; };
#ifndef REPMASK
#define REPMASK 0
#endif
#ifndef ONLY_PHASE
#define ONLY_PHASE -1
#endif
#define IN(k) ((ONLY_PHASE < 0 || ((k) == 12 * DEPTH ? 12 : (k) % 12) == ONLY_PHASE) && lo <= (k) && (k) < hi)
#define SEAM(k) do { if (IN(k) && IN((k) + 1)) { XcdBarrier bb = bar; asm volatile("" : "+s"(bb.bar), "+s"(bb.x)); xcd_barrier(bb); if ((REPMASK >> 12) & 1) xcd_barrier(bb); } } while (0)
#define CAS __attribute__((address_space(4)))
#define PH_IDS int tid = tid0; asm volatile("" : "+v"(tid)); const int lane = tid & 63, wave = __builtin_amdgcn_readfirstlane(tid >> 6); (void)lane; (void)wave; \
    int G = (int)gridDim.x, bx = (int)blockIdx.x; asm volatile("" : "+s"(G), "+s"(bx)); \
    const CAS Args* ap = (const CAS Args*)__builtin_amdgcn_kernarg_segment_ptr(); asm volatile("" : "+s"(ap)); unsigned char* ws = ap->ws
#define W_INQ ((const pg8::bf16_t*)(ws + WS_W + WO_INQ))
#define W_INF_T ((f16*)(ws + WS_W + WO_INF))
#define B_H8 ((signed char*)(ws + WS_H8))
#define B_RS ((float*)(ws + WS_SCL))
#define B_SWIN ((const float*)(ws + WS_SCL) + 16384)
#define B_SWGU ((const float*)(ws + WS_SCL) + 32768)
#define B_SWA ((float*)(ws + WS_SCL) + 45056)
#define B_ORS ((float*)(ws + WS_SCL) + 49152)
#define W_AUPQ ((signed char*)(ws + WS_W + WO_AUPQ))
#define W_GUQ ((const pg8::bf16_t*)(ws + WS_W + WO_GU))
#define W_DOWN_T ((f16*)(ws + WS_W + WO_DOWN))
#define W_OUT_T ((f16*)(ws + WS_W + WO_OUT))
#define W_AUP_T ((f16*)(ws + WS_W + WO_AUP))
#define W_BUP_T ((f16*)(ws + WS_W + WO_BUP))
#define B_XA ((float*)(ws + WS_X))
#define B_H ((f16*)(ws + WS_H))
#define B_OB ((f16*)(ws + WS_H))
#define B_YB ((f16*)(ws + WS_H + 48 * MiB))
#define B_QLAT ((f16*)(ws + WS_ZA + ZO_QLAT))
#define B_QI ((f16*)(ws + WS_ZA + ZO_QI))
#define B_CKV ((f16*)(ws + WS_ZA + ZO_CKV))
#define B_KW ((f16*)(ws + WS_ZA + ZO_KW))
#define B_QA ((f16*)(ws + WS_X))
#define W_UKT ((const f16*)(ws + WS_W + WO_WUK))
#define B_ZB ((f16*)(ws + WS_ZB))
#define B_ZG ((f16*)(ws + WS_ZG))
#define B_SC ((float*)(ws + WS_ZB))
#define B_OLAT ((signed char*)(ws + WS_X))
#define B_MERGED ((f16*)(ws + WS_ZB + 64 * MiB))
#define B_ACT ((f16*)(ws + WS_ZA))
#define B_LSE ((float*)(ws + WS_LSE))
#define B_IDX ((u16*)(ws + WS_IDX))
#define B_ROPE ((const f32x2*)(ws + WS_ROPE))
#define B_LUT ((const unsigned char*)(ws + WS_LUT))
#define B_MOD ((const float*)(ws + WS_MOD) + (size_t)l * NB * 12288)
#define X_IN (l == 0 ? ap->in[0] : (const float*)ap->out)
#ifndef REPMASK
#define REPMASK 0
#endif
#define RUN(k, ...) do { { PH_IDS; __VA_ARGS__ } if ((REPMASK >> (k)) & 1) { PH_IDS; __VA_ARGS__ } } while (0)
template <int l> __device__ __forceinline__ void layer_body(LAS unsigned char* lds, const int tid0, const int lo, const int hi, const XcdBarrier& bar) {
    const int pb = 12 * l;
    if (IN(pb + 0)) { RUN(0, Ptrs P;
        P.x = ap->in[0]; P.c = ap->in[1]; P.rel_bias = ap->in[2]; P.w_ada = ap->in[3]; P.b_ada = ap->in[4]; P.norm1_g = ap->in[5]; P.w_in = ap->in[6]; P.kv_norm_g = ap->in[7];
        P.idx_ln_g = ap->in[8]; P.idx_ln_b = ap->in[9]; P.w_uk = ap->in[10]; P.w_uv = ap->in[11]; P.w_a_up = ap->in[12]; P.w_b_up = ap->in[13]; P.w_out = ap->in[14]; P.norm2_g = ap->in[15];
        P.w_ff_gate = ap->in[16]; P.w_ff_up = ap->in[17]; P.w_ff_down = ap->in[18]; P.final_g = ap->in[19]; P.out = ap->out; P.ws = ws;
        p0_phase<31>(P, l, lds, tid, lane, wave, G, bx);
        if ((REPMASK >> 20) & 1) p0_phase<1>(P, l, lds, tid, lane, wave, G, bx);
        if ((REPMASK >> 21) & 1) p0_phase<2>(P, l, lds, tid, lane, wave, G, bx);
        if ((REPMASK >> 22) & 1) p0_phase<4>(P, l, lds, tid, lane, wave, G, bx);
        if ((REPMASK >> 23) & 1) p0_phase<8>(P, l, lds, tid, lane, wave, G, bx););
        if (l == 0) SEAM(pb + 0); }
    if (IN(pb + 1)) { RUN(1, norm_mod_phase<true>(X_IN, ap->in[5] + (size_t)l * D, B_MOD, B_MOD + D, B_H, B_H8, B_RS, lane, wave, G, bx);); SEAM(pb + 1); }
    if (IN(pb + 2)) { RUN(2,
        { pg8::Gemm g{(const pg8::bf16_t*)B_H8, W_INQ, M, NQ, D / 2}; pg8::StaticOrder S; S.init(M, NQ, G, bx); pg8::EpiInQ E{B_QA, B_CKV, B_ZB, B_ZG, B_RS, B_SWIN};
          pg8::gemm_phase<pg8::EpiInQ, pg8::StaticOrder, true, true, true>(lds, g, S, E); }
        __syncthreads();
        { int tb2 = tid; asm volatile("" : "+v"(tb2)); (void)tb2; pg8::Gemm g{B_H, W_INF_T, M, NF, D}; pg8::StaticOrder S; S.init(M, NF, G, G == 256 ? ((bx + 64) & 255) : bx);
          pg8::EpiInF E{B_QI, B_KW}; pg8::gemm_phase<pg8::EpiInF, pg8::StaticOrder, true, true, false>(lds, g, S, E); }
        __syncthreads();); SEAM(pb + 2); }
    if (IN(pb + 3)) { if ((REPMASK >> 14) & 1) { PH_IDS; zfix_phase((f16*)(ws + WS_X + 64 * MiB), (f16*)(ws + WS_X + 64 * MiB) + 8 * MiB, (f16*)(ws + WS_X + 64 * MiB) + 16 * MiB, ap->in[7] + (size_t)l * 256, ap->in[8] + (size_t)l * 64, ap->in[9] + (size_t)l * 64, B_ROPE, lane, wave, G, bx); }
        { PH_IDS; qlat_phase(B_QA, W_UKT, B_QLAT, lane, wave, G, bx); }
        { PH_IDS; wrowq_phase(W_AUP_T, W_AUPQ, B_SWA, lane, wave, G, bx); }
        { PH_IDS; zfix_phase(B_CKV, B_QI, B_KW, ap->in[7] + (size_t)l * 256, ap->in[8] + (size_t)l * 64, ap->in[9] + (size_t)l * 64, B_ROPE, lane, wave, G, bx); }
        RUN(3, battn_phase(B_ZB, ap->in[2], B_LUT, B_OB, B_LSE, lds, tid, lane, wave, G, bx);); SEAM(pb + 3); }
    if (IN(pb + 4)) { RUN(4, score_phase(B_QI, B_KW, B_SC, lds, tid, lane, wave, G, bx);); SEAM(pb + 4); }
    if (IN(pb + 5)) { RUN(13, bmerge_phase(B_OB, B_LSE, B_YB, lane, wave, G, bx););
        RUN(5, dsa_phase<0>(B_SC, B_QLAT, B_CKV, B_IDX, ap->in[2], B_LUT, B_OLAT, B_ORS, lds, tid, lane, wave, G, bx););
        if ((REPMASK >> 15) & 1) { PH_IDS; dsa_phase<1>(B_SC, B_QLAT, B_CKV, B_IDX, ap->in[2], B_LUT, (signed char*)(ws + WS_X + 64 * MiB), (float*)(ws + WS_X + 100 * MiB), lds, tid, lane, wave, G, bx); }
        if ((REPMASK >> 16) & 1) { PH_IDS; dsa_phase<2>(B_SC, B_QLAT, B_CKV, B_IDX, ap->in[2], B_LUT, (signed char*)(ws + WS_X + 64 * MiB), (float*)(ws + WS_X + 100 * MiB), lds, tid, lane, wave, G, bx); }
        SEAM(pb + 5); }
    if (IN(pb + 7)) { RUN(7,
        { pg8::Gemm g{(const pg8::bf16_t*)B_OLAT, (const pg8::bf16_t*)W_AUPQ, M, D, D / 2}; pg8::StaticOrder S; S.init(M, D, G, bx); pg8::EpiGate<0> E{B_ZG, B_MERGED, B_ORS, B_SWA};
          pg8::gemm_phase<pg8::EpiGate<0>, pg8::StaticOrder, true, true, true>(lds, g, S, E); }
        __syncthreads();
        { int tb2 = tid; asm volatile("" : "+v"(tb2)); (void)tb2; pg8::Gemm g{B_YB, W_BUP_T, M, D, 512}; pg8::StaticOrder S; S.init(M, D, G, bx); pg8::EpiGate<1> E{B_ZG, B_MERGED, nullptr, nullptr};
          pg8::gemm_phase<pg8::EpiGate<1>, pg8::StaticOrder, true, true>(lds, g, S, E); }
        __syncthreads();); SEAM(pb + 7); }
    if (IN(pb + 8)) { RUN(8, pg8::Gemm g{B_MERGED, W_OUT_T, M, D, D}; pg8::StaticOrder S; S.init(M, D, G, bx); pg8::EpiResid E{X_IN, B_XA, B_MOD + 2 * D};
        pg8::gemm_phase<pg8::EpiResid, pg8::StaticOrder, true, true>(lds, g, S, E);); SEAM(pb + 8); }
    if (IN(pb + 9)) { RUN(9, norm_mod_phase<false>(B_XA, ap->in[15] + (size_t)l * D, B_MOD + 3 * D, B_MOD + 4 * D, B_H, B_H8, B_RS, lane, wave, G, bx);); SEAM(pb + 9); }
    if (IN(pb + 10)) { RUN(10, pg8::Gemm g{(const pg8::bf16_t*)B_H8, W_GUQ, M, NGU, D / 2}; pg8::StaticOrder S; S.init(M, NGU, G, bx); pg8::EpiSwiGLU E{B_ACT, B_RS, B_SWGU};
        pg8::gemm_phase<pg8::EpiSwiGLU, pg8::StaticOrder, true, true, true>(lds, g, S, E);); SEAM(pb + 10); }
    if (IN(pb + 11)) { RUN(11, pg8::Gemm g{B_ACT, W_DOWN_T, M, D, DFF}; pg8::StaticOrder S; S.init(M, D, G, bx); pg8::EpiResid E{B_XA, ap->out, B_MOD + 5 * D};
        pg8::gemm_phase<pg8::EpiResid, pg8::StaticOrder, true, true>(lds, g, S, E);); SEAM(pb + 11); }
}
__global__ void __launch_bounds__(NWAVES * 64, 2) fwd(Args args) {
    extern __shared__ __attribute__((aligned(16))) unsigned char lds_raw[];
    LAS unsigned char* lds = (LAS unsigned char*)lds_raw;
    const int tid0 = threadIdx.x;
    for (int u = tid0; u < (LDS_BYTES - LDSCTL_OFF) / 4; u += NWAVES * 64) ((LAS unsigned*)(lds + LDSCTL_OFF))[u] = 0u;
    __syncthreads();
    const int lo = args.ph_lo, hi = args.ph_hi;
    XcdBarrier bar; bar.bar = (unsigned*)(args.ws + WS_CTL) + CW_BAR; bar.x = 0; bar.st = nullptr;
    if (hi - lo > 1) bar = xcd_barrier_post((unsigned*)(args.ws + WS_CTL) + CW_BAR, (volatile LAS unsigned*)(lds + MISC_OFF) + 8);
    layer_body<0>(lds, tid0, lo, hi, bar);
    layer_body<1>(lds, tid0, lo, hi, bar);
    if (IN(12 * DEPTH)) { PH_IDS; final_norm_phase(ap->out, ap->in[19], lane, wave, G, bx); }
#undef IN
#undef SEAM
}

extern "C" void kernel_launch(void* const* d_in, const int* in_sizes, int n_in, void* d_out, int out_size, void* d_ws, size_t ws_size, hipStream_t stream) {
    static int grid = 0;
    if (grid == 0) {
        if (n_in != 20 || in_sizes[0] != M * D || out_size != M * D || ws_size < WS_END) { fprintf(stderr, "kernel_launch: built for 20 inputs, x/out of %d floats, >= %zu bytes of workspace; got n_in %d, in0 %d, out %d, ws %zu; nothing launched\n", M * D, (size_t)WS_END, n_in, n_in > 0 ? in_sizes[0] : -1, out_size, ws_size); grid = -1; return; }
        int dev = 0, cus = 0, per_cu = 0;
        if (hipGetDevice(&dev) != hipSuccess || hipDeviceGetAttribute(&cus, hipDeviceAttributeMultiprocessorCount, dev) != hipSuccess) { fprintf(stderr, "kernel_launch: device query failed\n"); grid = -1; return; }
        if (hipFuncSetAttribute((const void*)fwd, hipFuncAttributeMaxDynamicSharedMemorySize, LDS_BYTES) != hipSuccess) { fprintf(stderr, "kernel_launch: hipFuncSetAttribute failed\n"); grid = -1; return; }
        if (hipOccupancyMaxActiveBlocksPerMultiprocessor(&per_cu, (const void*)fwd, NWAVES * 64, LDS_BYTES) != hipSuccess || per_cu < 1)
            fprintf(stderr, "kernel_launch: note: occupancy query reports %d workgroups per CU\n", per_cu);
        (void)hipGetLastError();
        grid = cus;
    }
    if (grid < 0) return;
    if (hipMemsetAsync((char*)d_ws + WS_CTL, 0, CTL_ZERO_BYTES, stream) != hipSuccess) { fprintf(stderr, "kernel_launch: memset failed\n"); return; }
    Args a{};
    for (int i = 0; i < 20; ++i) a.in[i] = (const float*)d_in[i];
    a.out = (float*)d_out; a.ws = (unsigned char*)d_ws;
#if MK_PER_PHASE
    for (int p = 0; p < N_PHASES; ++p) { a.ph_lo = p; a.ph_hi = p + 1; hipLaunchKernelGGL(fwd, dim3(grid), dim3(NWAVES * 64), LDS_BYTES, stream, a); }
#else
    a.ph_lo = 0; a.ph_hi = N_PHASES;
    hipLaunchKernelGGL(fwd, dim3(grid), dim3(NWAVES * 64), LDS_BYTES, stream, a);
#endif
    const hipError_t le = hipPeekAtLastError();
    if (le != hipSuccess) fprintf(stderr, "kernel_launch: launch failed: %s\n", hipGetErrorName(le));
}
```
